# Optimizing an MI355X kernel written in HIP

```python
import math
import jax, jax.numpy as jnp
from jax import lax
import numpy as np

D_MODEL = 1024
BATCH = 8
SEQ = 2048
DEPTH = 4

A_HEAD_DIM = 64
A_HEADS = D_MODEL // A_HEAD_DIM
D_A = A_HEADS * A_HEAD_DIM
LORA_W = 64
LORA_A = 64
RWKV_GN_EPS = 64e-5
POOL_WINDOWS = (2, 4, 8, 16)
POOL_GROUPS = 4
D_B = 3 * D_MODEL // 4
POOL_CH = D_B // POOL_GROUPS
C_HEAD_DIM = 64
D_C = 3 * D_MODEL // 4
C_HEADS = D_C // C_HEAD_DIM
DILATION_GROUPS = ((128, 1), (512, 4), (2048, 16))
C_HEADS_PER_GROUP = C_HEADS // len(DILATION_GROUPS)
D_C_OUT = C_HEADS_PER_GROUP * C_HEAD_DIM
ROPE_THETA = 10000.0
Q_BLOCK = 128
N_SHIFT = 3 * D_A + 2 * LORA_W + 2 * LORA_A
SPLIT_SIZES = (N_SHIFT, D_A, D_B, D_B, D_C, D_C, D_C, D_C_OUT, D_MODEL, D_MODEL, D_MODEL)
N_IN = sum(SPLIT_SIZES)
DEEPNORM_ALPHA = (2 * DEPTH) ** 0.25
DEEPNORM_BETA = (8 * DEPTH) ** -0.25
LN_EPS = 1e-5

kernel_name = "hybrid_rwkv7_pool_dilated_attn_encoder"


def _split(t, sizes):
    out, start = [], 0
    for s in sizes:
        out.append(t[..., start:start + s])
        start += s
    return out


def _normalize(t, eps):
    t = t.astype(jnp.float32)
    mu = jnp.mean(t, axis=-1, keepdims=True)
    var = jnp.mean(jnp.square(t - mu), axis=-1, keepdims=True)
    return (t - mu) * lax.rsqrt(var + eps)


def _orient(t):
    return jnp.concatenate([t[:1], jnp.flip(t[1:], axis=2)], axis=0)


def rwkv7_branch(u, z, mu, w0, w_up, a0, a_up, k_k, k_a, r_k, gn_g, gn_b):
    f32 = jnp.float32
    u = u.astype(f32)
    B, S, _ = u.shape
    prev = jnp.pad(u, ((0, 0), (1, 0), (0, 0)))[:, :-1]
    nxt = jnp.pad(u, ((0, 0), (0, 1), (0, 0)))[:, 1:]
    u = u + mu[0] * (prev - u) + mu[1] * (nxt - u)
    r, k, v, wd_f, wd_b, ad_f, ad_b = _split(u, (D_A, D_A, D_A, LORA_W, LORA_W, LORA_A, LORA_A))
    wd = jnp.stack([wd_f, wd_b])
    ad = jnp.stack([ad_f, ad_b])
    w_log = -jax.nn.softplus(-(w0[:, None, None, :] + jnp.einsum('zbsl,zld->zbsd', jnp.tanh(wd), w_up))) - 0.5
    decay = jnp.exp(-jnp.exp(w_log))
    a = jax.nn.sigmoid(a0[:, None, None, :] + jnp.einsum('zbsl,zld->zbsd', ad, a_up))
    heads = lambda t: t.reshape(*t.shape[:-1], A_HEADS, A_HEAD_DIM)
    kk = heads(k * k_k)
    kk = kk * lax.rsqrt(jnp.sum(kk * kk, axis=-1, keepdims=True) + 1e-12)
    k_dir = heads(k[None] * (1.0 + (a - 1.0) * k_a))
    a_h = heads(a)
    r_h, v_h = heads(r), heads(v)
    both = lambda t: jnp.broadcast_to(t[None], (2,) + t.shape)
    inputs = (both(r_h), heads(decay), k_dir, both(v_h), both(-kk), kk[None] * a_h)
    xs = tuple(jnp.moveaxis(_orient(t), 2, 0) for t in inputs)

    def step(state, inp):
        r_t, w_t, k_t, v_t, nkk_t, b_t = inp
        sa = jnp.einsum('zbhij,zbhj->zbhi', state, nkk_t)
        state = state * w_t[..., None, :] + sa[..., None] * b_t[..., None, :] + v_t[..., None] * k_t[..., None, :]
        return state, jnp.einsum('zbhij,zbhj->zbhi', state, r_t)

    state0 = jnp.zeros((2, B, A_HEADS, A_HEAD_DIM, A_HEAD_DIM), f32)
    _, ys = lax.scan(step, state0, xs)
    y = _orient(jnp.moveaxis(ys, 0, 2))
    y = y[0] + y[1]
    y = _normalize(y, RWKV_GN_EPS).reshape(B, S, D_A) * gn_g + gn_b
    bonus = jnp.sum(r_h * heads(k) * r_k, axis=-1, keepdims=True) * v_h
    y = y + bonus.reshape(B, S, D_A)
    return y * jax.nn.silu(z.astype(f32))


def pool_branch(p, z, w_g, b_g, scale):
    f32 = jnp.float32
    B, S, _ = p.shape
    pg = p.astype(f32).reshape(B, S, POOL_GROUPS, POOL_CH)
    csum = jnp.pad(jnp.cumsum(pg, axis=1), ((0, 0), (1, 0), (0, 0), (0, 0)))
    half = jnp.array([w // 2 for w in POOL_WINDOWS], dtype=jnp.int32)
    pos = jnp.arange(S, dtype=jnp.int32)[:, None]
    lo = jnp.clip(pos - half[None, :], 0, S - 1)
    hi = jnp.clip(pos + half[None, :], 0, S - 1)
    g_idx = jnp.arange(POOL_GROUPS, dtype=jnp.int32)[None, :]
    window_sum = csum[:, hi + 1, g_idx] - csum[:, lo, g_idx]
    count = (hi - lo + 1).astype(f32)[..., None]
    mixed = window_sum / count - pg
    y = jnp.einsum('bsgc,gcd->bsgd', mixed, w_g).reshape(B, S, D_B) + b_g
    return y * scale * jax.nn.silu(z.astype(f32))


def rope_tables(S):
    inv = jnp.power(ROPE_THETA, -jnp.arange(0, C_HEAD_DIM, 2, dtype=jnp.float32) / C_HEAD_DIM)
    ang = jnp.arange(S, dtype=jnp.float32)[:, None] * inv[None, :]
    ang = jnp.concatenate([ang, ang], axis=-1)
    return jnp.cos(ang), jnp.sin(ang)


def apply_rope(t, cos, sin):
    t1, t2 = jnp.split(t, 2, axis=-1)
    rot = jnp.concatenate([-t2, t1], axis=-1)
    return t * cos[None, :, None, :] + rot * sin[None, :, None, :]


def dilated_band_attention(q, k, v, dilation, half_span):
    f32 = jnp.float32
    B, S, H, Dh = q.shape
    L = S // dilation
    n = half_span // dilation
    qb = math.gcd(Q_BLOCK, L)
    nb = L // qb
    kw = qb + 2 * n
    sub = lambda t: t.reshape(B, L, dilation, H, Dh).transpose(0, 2, 3, 1, 4)
    qs = sub(q).reshape(B, dilation, H, nb, qb, Dh)
    pad = ((0, 0), (0, 0), (0, 0), (n, n), (0, 0))
    ks = jnp.pad(sub(k), pad)
    vs = jnp.pad(sub(v), pad)
    kidx = jnp.arange(nb)[:, None] * qb + jnp.arange(kw)[None, :]
    kb = ks[:, :, :, kidx]
    vb = vs[:, :, :, kidx]
    s = jnp.einsum('bdhnqc,bdhnkc->bdhnqk', qs.astype(f32), kb.astype(f32)) * (Dh ** -0.5)
    rel = jnp.arange(kw)[None, :] - n - jnp.arange(qb)[:, None]
    key_pos = kidx[:, None, :] - n
    valid = (jnp.abs(rel)[None] <= n) & (key_pos >= 0) & (key_pos < L)
    s = jnp.where(valid, s, -jnp.inf)
    m = jnp.max(s, axis=-1, keepdims=True)
    e = jnp.exp(s - m)
    den = jnp.sum(e, axis=-1, keepdims=True)
    o = jnp.einsum('bdhnqk,bdhnkc->bdhnqc', e / den, vb.astype(f32))
    lse = (m + jnp.log(den))[..., 0]
    o = o.reshape(B, dilation, H, L, Dh).transpose(0, 3, 1, 2, 4).reshape(B, S, H, Dh)
    lse = lse.reshape(B, dilation, H, L).transpose(0, 3, 1, 2).reshape(B, S, H)
    return o, lse


def attention_branch(q, k, v, z, cos, sin):
    B, S, _ = q.shape
    hd = lambda t: t.reshape(B, S, C_HEADS, C_HEAD_DIM)
    q = apply_rope(hd(q), cos, sin)
    k = apply_rope(hd(k), cos, sin)
    v = hd(v)
    outs, lses = [], []
    for g, (window, dilation) in enumerate(DILATION_GROUPS):
        sl = slice(g * C_HEADS_PER_GROUP, (g + 1) * C_HEADS_PER_GROUP)
        o, lse = dilated_band_attention(q[:, :, sl], k[:, :, sl], v[:, :, sl], dilation, window // 2)
        outs.append(o)
        lses.append(lse)
    wts = jax.nn.softmax(jnp.stack(lses), axis=0)
    o = jnp.sum(wts[..., None] * jnp.stack(outs), axis=0).reshape(B, S, D_C_OUT)
    return o * jax.nn.silu(z.astype(jnp.float32))


def setup_inputs(seed: int = 0) -> dict:
    key = jax.random.key(seed)
    ks = jax.random.split(key, 24)
    f32 = jnp.float32
    L = DEPTH
    nrm = lambda kk, shape, s: jax.random.normal(kk, shape, f32) * s
    return {
        "x": nrm(ks[0], (BATCH, SEQ, D_MODEL), 1.0),
        "w_in": nrm(ks[1], (L, D_MODEL, N_IN), D_MODEL ** -0.5),
        "b_in": nrm(ks[2], (L, N_IN), 0.02),
        "rwkv_mu": jax.random.uniform(ks[3], (L, 2, N_SHIFT), f32, 0.0, 0.5),
        "rwkv_w0": jax.random.uniform(ks[4], (L, 2, D_A), f32, -6.0, 1.0),
        "rwkv_w_up": nrm(ks[5], (L, 2, LORA_W, D_A), 0.1),
        "rwkv_a0": nrm(ks[6], (L, 2, D_A), 0.5),
        "rwkv_a_up": nrm(ks[7], (L, 2, LORA_A, D_A), 0.1),
        "rwkv_k_k": 0.85 + nrm(ks[8], (L, D_A), 0.05),
        "rwkv_k_a": 1.0 + nrm(ks[9], (L, D_A), 0.05),
        "rwkv_r_k": nrm(ks[10], (L, A_HEADS, A_HEAD_DIM), 0.1),
        "rwkv_gn_g": 1.0 + nrm(ks[11], (L, D_A), 0.05),
        "rwkv_gn_b": nrm(ks[12], (L, D_A), 0.02),
        "pool_w": nrm(ks[13], (L, POOL_GROUPS, POOL_CH, POOL_CH), POOL_CH ** -0.5),
        "pool_b": nrm(ks[14], (L, D_B), 0.02),
        "pool_scale": 1.0 + nrm(ks[15], (L, D_B), 0.05),
        "proj_a": nrm(ks[16], (L, D_A, D_MODEL), DEEPNORM_BETA * D_A ** -0.5),
        "proj_b": nrm(ks[17], (L, D_B, D_MODEL), DEEPNORM_BETA * D_B ** -0.5),
        "proj_c": nrm(ks[18], (L, D_C_OUT, D_MODEL), DEEPNORM_BETA * D_C_OUT ** -0.5),
        "w_out": nrm(ks[19], (L, D_MODEL, D_MODEL), DEEPNORM_BETA * D_MODEL ** -0.5),
        "ln_g": 1.0 + nrm(ks[20], (L, D_MODEL), 0.05),
        "ln_b": nrm(ks[21], (L, D_MODEL), 0.02),
    }


def reference(x, w_in, b_in, rwkv_mu, rwkv_w0, rwkv_w_up, rwkv_a0, rwkv_a_up, rwkv_k_k, rwkv_k_a,
              rwkv_r_k, rwkv_gn_g, rwkv_gn_b, pool_w, pool_b, pool_scale, proj_a, proj_b, proj_c,
              w_out, ln_g, ln_b):
    S = x.shape[1]
    cos, sin = rope_tables(S)
    for l in range(DEPTH):
        h = jnp.einsum('bsd,dn->bsn', x, w_in[l]) + b_in[l]
        (u_a, z_a, p_b, z_b, q_c, k_c, v_c, z_c, g_a, g_b, g_c) = _split(h, SPLIT_SIZES)
        o_a = rwkv7_branch(u_a, z_a, rwkv_mu[l], rwkv_w0[l], rwkv_w_up[l], rwkv_a0[l], rwkv_a_up[l],
                           rwkv_k_k[l], rwkv_k_a[l], rwkv_r_k[l], rwkv_gn_g[l], rwkv_gn_b[l])
        o_b = pool_branch(p_b, z_b, pool_w[l], pool_b[l], pool_scale[l])
        o_c = attention_branch(q_c, k_c, v_c, z_c, cos, sin)
        merged = (jax.nn.sigmoid(g_a) * jnp.einsum('bsc,cd->bsd', o_a, proj_a[l])
                  + jax.nn.sigmoid(g_b) * jnp.einsum('bsc,cd->bsd', o_b, proj_b[l])
                  + jax.nn.sigmoid(g_c) * jnp.einsum('bsc,cd->bsd', o_c, proj_c[l]))
        out = jnp.einsum('bsd,de->bse', merged, w_out[l])
        x = (_normalize(DEEPNORM_ALPHA * x + out, LN_EPS) * ln_g[l] + ln_b[l]).astype(x.dtype)
    return x
```

```cpp
#include <hip/hip_runtime.h>
#include <hip/hip_cooperative_groups.h>
#include <cstdio>
namespace cg = cooperative_groups;

#ifndef MK_MULTI
#define MK_MULTI 1
#endif

typedef unsigned short bf16_t;
typedef short bf16x8 __attribute__((ext_vector_type(8)));
typedef short bf16x4 __attribute__((ext_vector_type(4)));
typedef float f32x4 __attribute__((ext_vector_type(4)));
typedef unsigned u32x4 __attribute__((ext_vector_type(4)));
typedef unsigned u32x2 __attribute__((ext_vector_type(2)));
#define LAS __attribute__((address_space(3)))

constexpr int T_TOK = 16384, SEQ = 2048, NB = 8, DM = 1024, DEPTH = 4;
constexpr int NE = 7168, NL = 4352, NIN = 11520;
constexpr int E_PB = 3328, E_Q = 4096, E_K = 4864, E_V = 5632, E_ZB = 6400;
constexpr int L_ZA = 0, L_ZC = 1024, L_GA = 1280;

constexpr size_t OFF_WIN = 0;
constexpr size_t OFF_LORA = OFF_WIN + (size_t)NIN * 1024 * 2;
constexpr size_t OFF_POOLW = OFF_LORA + (size_t)4096 * 256 * 2;
constexpr size_t OFF_PROJ = OFF_POOLW + (size_t)768 * 768 * 2;
constexpr size_t OFF_WOUT = OFF_PROJ + (size_t)1024 * 2048 * 2;
constexpr size_t OFF_BIASP = OFF_WOUT + (size_t)1024 * 1024 * 2;
constexpr size_t OFF_ROPE = OFF_BIASP + (size_t)NIN * 4;
constexpr size_t OFF_XB = OFF_ROPE + (size_t)SEQ * 64 * 4;
constexpr size_t OFF_A = OFF_XB + (size_t)T_TOK * 1024 * 2;
constexpr size_t OFF_B = OFF_A + (size_t)T_TOK * NE * 2;
constexpr size_t OFF_RN = OFF_B + (size_t)T_TOK * 3072 * 2;
constexpr size_t OFF_C = OFF_RN + (size_t)T_TOK * 16 * 4;
constexpr size_t OFF_D = OFF_C + (size_t)T_TOK * NL * 2;
constexpr size_t OFF_LIN = OFF_D;
constexpr size_t OFF_MIX = OFF_LIN + (size_t)T_TOK * 256 * 2;
constexpr size_t OFF_VT = OFF_MIX + (size_t)T_TOK * 768 * 2;
constexpr size_t OFF_AO = OFF_VT + (size_t)T_TOK * 768 * 2;
constexpr size_t OFF_LSE = OFF_AO + (size_t)T_TOK * 768 * 2;
constexpr size_t OFF_O = OFF_LSE + (size_t)T_TOK * 12 * 4;
constexpr size_t WS_TOTAL = OFF_O + (size_t)T_TOK * 2048 * 2;

struct Params {
    const float* x; const float* w_in; const float* b_in; const float* mu; const float* w0; const float* w_up; const float* a0; const float* a_up;
    const float* k_k; const float* k_a; const float* r_k; const float* gn_g; const float* gn_b; const float* pool_w; const float* pool_b; const float* pool_scale;
    const float* proj_a; const float* proj_b; const float* proj_c; const float* w_out; const float* ln_g; const float* ln_b;
    float* out; unsigned char* ws; int ph_lo, ph_hi;
};

__device__ __forceinline__ float bf2f(bf16_t v) { return __uint_as_float(((unsigned)v) << 16); }
__device__ __forceinline__ float bflo(unsigned w) { return __uint_as_float(w << 16); }
__device__ __forceinline__ float bfhi(unsigned w) { return __uint_as_float(w & 0xffff0000u); }
__device__ __forceinline__ unsigned cvt_pk_bf16(float lo, float hi) { unsigned r; asm volatile("v_cvt_pk_bf16_f32 %0, %1, %2" : "=v"(r) : "v"(lo), "v"(hi)); return r; }
__device__ __forceinline__ bf16_t f2bf(float f) { return (bf16_t)(cvt_pk_bf16(f, 0.f) & 0xffffu); }
__device__ __forceinline__ float sigmoidf_(float v) { return 1.0f / (1.0f + __expf(-v)); }
__device__ __forceinline__ float siluf_(float v) { return v / (1.0f + __expf(-v)); }
__device__ __forceinline__ void unpack8(u32x4 w, float* f) {
    f[0] = bflo(w.x); f[1] = bfhi(w.x); f[2] = bflo(w.y); f[3] = bfhi(w.y); f[4] = bflo(w.z); f[5] = bfhi(w.z); f[6] = bflo(w.w); f[7] = bfhi(w.w);
}
__device__ __forceinline__ u32x4 pack8(const float* f) {
    u32x4 w; w.x = cvt_pk_bf16(f[0], f[1]); w.y = cvt_pk_bf16(f[2], f[3]); w.z = cvt_pk_bf16(f[4], f[5]); w.w = cvt_pk_bf16(f[6], f[7]); return w;
}

namespace pg8 {
constexpr int BM = 256, BK = 64, HALF = 128, HTB = HALF * BK * 2, STAGE_BYTES = 8 * HTB, NXCD = 8, WGM = 8;
__device__ __forceinline__ int lds_byte(int r, int c) { const int st = (r >> 4) * 2 + (c >> 5), rr = r & 15, cc = c & 31, ob = rr * 64 + cc * 2; return st * 1024 + (ob ^ (((ob >> 9) & 1) << 5)); }
__device__ __forceinline__ void stage_rc(int b, int& R, int& C) { const int st = b / 1024, sb = b % 1024, swz = sb ^ (((sb >> 9) & 1) << 5); R = (st >> 1) * 16 + swz / 64; C = (st & 1) * 32 + (swz % 64) / 2; }
__device__ __forceinline__ int perm32(int rho) { const int n = rho >> 4, i = rho & 15; return 8 * (i >> 2) + 4 * n + (i & 3); }

struct Unit { int pm, pn, koff, nt, tag; };
struct Gemm { const bf16_t* A; const bf16_t* Bt; int M, N, ld; };

struct StaticOrder {
    int nM, nN, nwg, G, c, nt;
    __device__ void init(int M, int N, int K, int G_, int c_) { nM = M / BM; nN = N / BM; nwg = nM * nN; G = G_; c = c_; nt = K / BK; }
    __device__ bool next(int i, Unit& u) const {
        const long L = (long)i * G + c; if (L >= nwg) return false;
        int wgid = (int)L; { const int q = nwg / NXCD, r = nwg % NXCD, xcd = wgid % NXCD, off = wgid / NXCD; wgid = (xcd < r ? xcd * (q + 1) : r * (q + 1) + (xcd - r) * q) + off; }
        const int nig = WGM * nN, gid = wgid / nig, fm = gid * WGM, gsz = (nM - fm) < WGM ? (nM - fm) : WGM;
        u.pm = fm + ((wgid % nig) % gsz); u.pn = (wgid % nig) / gsz; u.koff = 0; u.nt = nt; u.tag = 0; return true;
    }
};
struct MergeOrder {
    int G, c;
    __device__ void init(int G_, int c_) { G = G_; c = c_; }
    __device__ bool next(int i, Unit& u) const {
        const int ti = i / 3, br = i - ti * 3; const long L = (long)ti * G + c; if (L >= 256) return false;
        u.pm = (int)(L >> 2); u.pn = (int)(L & 3); u.tag = br;
        u.koff = br == 0 ? 0 : (br == 1 ? 1024 : 1792); u.nt = br == 0 ? 16 : (br == 1 ? 12 : 4); return true;
    }
};

template <class Epi, class Sched>
__device__ __forceinline__ void gemm_phase(const int tid, LAS unsigned char* lds, const Gemm g, const Sched& S, const Epi& E) {
    const int wid = __builtin_amdgcn_readfirstlane(tid >> 6), lane = tid & 63, wr = wid >> 2, wc = wid & 3, fr = lane & 15, fq = lane >> 4;
    const int K = g.ld;
    unsigned voffA[2], voffB[2];
#pragma unroll
    for (int i = 0; i < 2; ++i) { int R, C; stage_rc(tid * 16 + i * 8192, R, C); const int Rb = Epi::PERM ? ((R & ~31) + perm32(R & 31)) : R;
        voffA[i] = (unsigned)(R * K + C) * 2u; voffB[i] = (unsigned)(Rb * K + C) * 2u; }
    const size_t kstep = (size_t)(BK * 2);
    const size_t hstep = (size_t)HALF * K * 2;
    const size_t tstep = 2 * hstep;
    const unsigned ldsw = (unsigned)wid * 1024u;
    const int aoff = lds_byte(wr * 64 + fr, fq * 8), boff = lds_byte(wc * 32 + fr, fq * 8);
#define PG8_SA(b, h) (((b) * 2 + (h)) * HTB)
#define PG8_SB(b, h) ((4 + (b) * 2 + (h)) * HTB)
#define PG8_STAGE(bufoff, gbase, voff) do { _Pragma("unroll") for (int _i = 0; _i < 2; ++_i) \
        __builtin_amdgcn_global_load_lds((const unsigned*)((const char*)(gbase) + (voff)[_i]), (LAS unsigned*)(lds + (bufoff) + ldsw + _i * 8192), 16, 0, 0); } while (0)
#define PG8_LDA(dst, b, h) do { _Pragma("unroll") for (int m = 0; m < 4; ++m) _Pragma("unroll") for (int k = 0; k < 2; ++k) dst[m][k] = *(const LAS bf16x8*)(lds + PG8_SA(b, h) + aoff + m * 2048 + k * 1024); } while (0)
#define PG8_LDB(dst, b, h) do { _Pragma("unroll") for (int n = 0; n < 2; ++n) _Pragma("unroll") for (int k = 0; k < 2; ++k) dst[n][k] = *(const LAS bf16x8*)(lds + PG8_SB(b, h) + boff + n * 2048 + k * 1024); } while (0)
#define PG8_MMA(ai, bj, At, Bt) do { __builtin_amdgcn_s_setprio(1); _Pragma("unroll") for (int m = 0; m < 4; ++m) _Pragma("unroll") for (int n = 0; n < 2; ++n) _Pragma("unroll") for (int k = 0; k < 2; ++k) \
        acc[ai][bj][m][n] = __builtin_amdgcn_mfma_f32_16x16x32_bf16(Bt[n][k], At[m][k], acc[ai][bj][m][n], 0, 0, 0); __builtin_amdgcn_s_setprio(0); } while (0)
#define PG8_WAIT_V(n) asm volatile("s_waitcnt vmcnt(" #n ")" ::: "memory")
#define PG8_WAIT_L(n) asm volatile("s_waitcnt lgkmcnt(" #n ")" ::: "memory")
#define PG8_BAR __builtin_amdgcn_s_barrier()
#define PG8_SCHED __builtin_amdgcn_sched_barrier(0)
    Unit cur, nxt; int ui = 0;
    if (!S.next(0, cur)) return;
    f32x4 acc[2][2][4][2];
#pragma unroll
    for (int a = 0; a < 2; ++a)
#pragma unroll
        for (int b = 0; b < 2; ++b)
#pragma unroll
            for (int m = 0; m < 4; ++m)
#pragma unroll
                for (int n = 0; n < 2; ++n) acc[a][b][m][n] = (f32x4){0.f, 0.f, 0.f, 0.f};
    bf16x8 At[4][2], B0[2][2], B1[2][2];
    const char* cA = (const char*)g.A + (size_t)cur.pm * tstep + (size_t)cur.koff * 2; const char* cB = (const char*)g.Bt + (size_t)cur.pn * tstep + (size_t)cur.koff * 2;
    PG8_STAGE(PG8_SB(0, 0), cB, voffB); PG8_STAGE(PG8_SA(0, 0), cA, voffA); PG8_STAGE(PG8_SB(0, 1), cB + hstep, voffB); PG8_STAGE(PG8_SA(0, 1), cA + hstep, voffA);
    if (wr == 1) PG8_BAR;
    PG8_WAIT_V(4); PG8_BAR;
    PG8_STAGE(PG8_SB(1, 0), cB + kstep, voffB); PG8_STAGE(PG8_SA(1, 0), cA + kstep, voffA); PG8_STAGE(PG8_SB(1, 1), cB + hstep + kstep, voffB);
    PG8_WAIT_V(6); PG8_BAR;
    for (;;) {
        const bool has_next = S.next(ui + 1, nxt);
        const char* nA = has_next ? (const char*)g.A + (size_t)nxt.pm * tstep + (size_t)nxt.koff * 2 : cA; const char* nB = has_next ? (const char*)g.Bt + (size_t)nxt.pn * tstep + (size_t)nxt.koff * 2 : cB;
        const int nt = cur.nt;
        for (int t = 0; t < nt; t += 2) {
            const bool last = (t == nt - 2);
            const char* a1 = cA + (size_t)(t + 1) * kstep;
            const char* a2 = last ? nA : cA + (size_t)(t + 2) * kstep; const char* b2 = last ? nB : cB + (size_t)(t + 2) * kstep;
            const char* a3 = a2 + kstep; const char* b3 = b2 + kstep;
            PG8_LDB(B0, 0, 0); PG8_SCHED; PG8_LDA(At, 0, 0); PG8_STAGE(PG8_SA(1, 1), a1 + hstep, voffA);
            PG8_WAIT_L(8); PG8_BAR; PG8_WAIT_L(0); PG8_MMA(0, 0, At, B0); PG8_BAR; PG8_SCHED;
            PG8_LDB(B1, 0, 1); PG8_STAGE(PG8_SB(0, 0), b2, voffB);
            PG8_BAR; PG8_WAIT_L(0); PG8_MMA(0, 1, At, B1); PG8_BAR;
            PG8_LDA(At, 0, 1); PG8_STAGE(PG8_SA(0, 0), a2, voffA);
            PG8_BAR; PG8_WAIT_L(0); PG8_MMA(1, 0, At, B0); PG8_BAR; PG8_SCHED;
            PG8_STAGE(PG8_SB(0, 1), b2 + hstep, voffB);
            PG8_WAIT_V(6); PG8_BAR; PG8_MMA(1, 1, At, B1); PG8_BAR;
            PG8_LDB(B0, 1, 0); PG8_SCHED; PG8_LDA(At, 1, 0); PG8_STAGE(PG8_SA(0, 1), a2 + hstep, voffA);
            PG8_WAIT_L(8); PG8_BAR; PG8_WAIT_L(0); PG8_MMA(0, 0, At, B0); PG8_BAR; PG8_SCHED;
            PG8_LDB(B1, 1, 1); PG8_STAGE(PG8_SB(1, 0), b3, voffB);
            PG8_BAR; PG8_WAIT_L(0); PG8_MMA(0, 1, At, B1); PG8_BAR;
            PG8_LDA(At, 1, 1); PG8_STAGE(PG8_SA(1, 0), a3, voffA);
            PG8_BAR; PG8_WAIT_L(0); PG8_MMA(1, 0, At, B0); PG8_BAR; PG8_SCHED;
            PG8_STAGE(PG8_SB(1, 1), b3 + hstep, voffB);
            PG8_WAIT_V(6); PG8_BAR; PG8_MMA(1, 1, At, B1); PG8_BAR;
        }
        E(acc, cur, wr, wc, fr, fq);
        if (!has_next) break;
#pragma unroll
        for (int a = 0; a < 2; ++a)
#pragma unroll
            for (int b = 0; b < 2; ++b)
#pragma unroll
                for (int m = 0; m < 4; ++m)
#pragma unroll
                    for (int n = 0; n < 2; ++n) acc[a][b][m][n] = (f32x4){0.f, 0.f, 0.f, 0.f};
        cur = nxt; cA = nA; cB = nB; ++ui;
    }
    PG8_WAIT_V(0);
    if (wr == 0) PG8_BAR;
    PG8_BAR;
#undef PG8_SA
#undef PG8_SB
#undef PG8_STAGE
#undef PG8_LDA
#undef PG8_LDB
#undef PG8_MMA
#undef PG8_WAIT_V
#undef PG8_WAIT_L
#undef PG8_BAR
#undef PG8_SCHED
}

struct EpiBias {
    static constexpr bool PERM = true;
    bf16_t* O; int ldc; const float* bias;
    __device__ __forceinline__ void operator()(const f32x4 (&acc)[2][2][4][2], const Unit& u, int wr, int wc, int fr, int fq) const {
        const int row0 = u.pm * BM + wr * 64 + fr, col0 = u.pn * BM + wc * 32 + 8 * fq;
        f32x4 bv[2][2];
#pragma unroll
        for (int bj = 0; bj < 2; ++bj)
#pragma unroll
            for (int n = 0; n < 2; ++n) bv[bj][n] = *(const f32x4*)(bias + col0 + bj * HALF + 4 * n);
#pragma unroll
        for (int ai = 0; ai < 2; ++ai)
#pragma unroll
            for (int m = 0; m < 4; ++m) { bf16_t* rowp = O + (size_t)(row0 + ai * HALF + m * 16) * ldc + col0;
#pragma unroll
                for (int bj = 0; bj < 2; ++bj) { f32x4 v0 = acc[ai][bj][m][0] + bv[bj][0], v1 = acc[ai][bj][m][1] + bv[bj][1];
                    u32x4 w; w.x = cvt_pk_bf16(v0[0], v0[1]); w.y = cvt_pk_bf16(v0[2], v0[3]); w.z = cvt_pk_bf16(v1[0], v1[1]); w.w = cvt_pk_bf16(v1[2], v1[3]);
                    *(u32x4*)(rowp + bj * HALF) = w; } }
    }
};
struct EpiLora {
    static constexpr bool PERM = true;
    bf16_t* EA; const float* w0; const float* a0;
    __device__ __forceinline__ void operator()(const f32x4 (&acc)[2][2][4][2], const Unit& u, int wr, int wc, int fr, int fq) const {
        const int row0 = u.pm * BM + wr * 64 + fr, colt = u.pn * BM, seg = colt >> 10, col0 = (colt & 1023) + wc * 32 + 8 * fq;
        const float* bp = (seg < 2 ? w0 + seg * 1024 : a0 + (seg - 2) * 1024) + col0;
        const float sc = seg < 2 ? 0.60653065971f : 1.0f;
        bf16_t* base = EA + (size_t)seg * T_TOK * 1024;
        f32x4 bv[2][2];
#pragma unroll
        for (int bj = 0; bj < 2; ++bj)
#pragma unroll
            for (int n = 0; n < 2; ++n) bv[bj][n] = *(const f32x4*)(bp + bj * HALF + 4 * n);
#pragma unroll
        for (int ai = 0; ai < 2; ++ai)
#pragma unroll
            for (int m = 0; m < 4; ++m) { bf16_t* rowp = base + (size_t)(row0 + ai * HALF + m * 16) * 1024 + col0;
#pragma unroll
                for (int bj = 0; bj < 2; ++bj) { f32x4 v0 = acc[ai][bj][m][0] + bv[bj][0], v1 = acc[ai][bj][m][1] + bv[bj][1];
#pragma unroll
                    for (int j = 0; j < 4; ++j) { v0[j] = sc * sigmoidf_(v0[j]); v1[j] = sc * sigmoidf_(v1[j]); }
                    u32x4 w; w.x = cvt_pk_bf16(v0[0], v0[1]); w.y = cvt_pk_bf16(v0[2], v0[3]); w.z = cvt_pk_bf16(v1[0], v1[1]); w.w = cvt_pk_bf16(v1[2], v1[3]);
                    *(u32x4*)(rowp + bj * HALF) = w; } }
    }
};
struct EpiPool {
    static constexpr bool PERM = true;
    bf16_t* O; const bf16_t* HE; const float* pb; const float* ps;
    __device__ __forceinline__ void operator()(const f32x4 (&acc)[2][2][4][2], const Unit& u, int wr, int wc, int fr, int fq) const {
        const int row0 = u.pm * BM + wr * 64 + fr, col0 = u.pn * BM + wc * 32 + 8 * fq;
        f32x4 bv[2][2], sv[2][2];
#pragma unroll
        for (int bj = 0; bj < 2; ++bj)
#pragma unroll
            for (int n = 0; n < 2; ++n) { bv[bj][n] = *(const f32x4*)(pb + col0 + bj * HALF + 4 * n); sv[bj][n] = *(const f32x4*)(ps + col0 + bj * HALF + 4 * n); }
#pragma unroll
        for (int ai = 0; ai < 2; ++ai)
#pragma unroll
            for (int m = 0; m < 4; ++m) { const size_t row = (size_t)(row0 + ai * HALF + m * 16);
#pragma unroll
                for (int bj = 0; bj < 2; ++bj) { const int c = col0 + bj * HALF;
                    float z[8]; unpack8(*(const u32x4*)(HE + row * NE + E_ZB + c), z);
                    f32x4 v0 = (acc[ai][bj][m][0] + bv[bj][0]) * sv[bj][0], v1 = (acc[ai][bj][m][1] + bv[bj][1]) * sv[bj][1];
#pragma unroll
                    for (int j = 0; j < 4; ++j) { v0[j] *= siluf_(z[j]); v1[j] *= siluf_(z[4 + j]); }
                    u32x4 w; w.x = cvt_pk_bf16(v0[0], v0[1]); w.y = cvt_pk_bf16(v0[2], v0[3]); w.z = cvt_pk_bf16(v1[0], v1[1]); w.w = cvt_pk_bf16(v1[2], v1[3]);
                    *(u32x4*)(O + row * 2048 + 1024 + c) = w; } }
    }
};
struct EpiMerge {
    static constexpr bool PERM = true;
    float* MRG; bf16_t* MRGb; const bf16_t* HL;
    __device__ __forceinline__ void operator()(const f32x4 (&acc)[2][2][4][2], const Unit& u, int wr, int wc, int fr, int fq) const {
        const int row0 = u.pm * BM + wr * 64 + fr, col0 = u.pn * BM + wc * 32 + 8 * fq, br = u.tag;
#pragma unroll
        for (int ai = 0; ai < 2; ++ai)
#pragma unroll
            for (int m = 0; m < 4; ++m) { const size_t row = (size_t)(row0 + ai * HALF + m * 16);
#pragma unroll
                for (int bj = 0; bj < 2; ++bj) { const int c = col0 + bj * HALF;
                    float gt[8]; unpack8(*(const u32x4*)(HL + row * NL + L_GA + br * 1024 + c), gt);
                    f32x4 v0 = acc[ai][bj][m][0], v1 = acc[ai][bj][m][1];
#pragma unroll
                    for (int j = 0; j < 4; ++j) { v0[j] *= sigmoidf_(gt[j]); v1[j] *= sigmoidf_(gt[4 + j]); }
                    float* mp = MRG + row * 1024 + c;
                    if (br > 0) { v0 += *(const f32x4*)mp; v1 += *(const f32x4*)(mp + 4); }
                    if (br < 2) { *(f32x4*)mp = v0; *(f32x4*)(mp + 4) = v1; }
                    else { u32x4 w; w.x = cvt_pk_bf16(v0[0], v0[1]); w.y = cvt_pk_bf16(v0[2], v0[3]); w.z = cvt_pk_bf16(v1[0], v1[1]); w.w = cvt_pk_bf16(v1[2], v1[3]);
                        *(u32x4*)(MRGb + row * 1024 + c) = w; } } }
    }
};
struct EpiOut {
    static constexpr bool PERM = false;
    float* PRE; const float* xres; float alpha;
    __device__ __forceinline__ void operator()(const f32x4 (&acc)[2][2][4][2], const Unit& u, int wr, int wc, int fr, int fq) const {
        const int row0 = u.pm * BM + wr * 64 + fr, col0 = u.pn * BM + wc * 32 + 4 * fq;
#pragma unroll
        for (int ai = 0; ai < 2; ++ai)
#pragma unroll
            for (int m = 0; m < 4; ++m) { const size_t ro = (size_t)(row0 + ai * HALF + m * 16) * 1024 + col0;
#pragma unroll
                for (int bj = 0; bj < 2; ++bj)
#pragma unroll
                    for (int n = 0; n < 2; ++n) { const f32x4 xr = *(const f32x4*)(xres + ro + bj * HALF + n * 16);
                        *(f32x4*)(PRE + ro + bj * HALF + n * 16) = acc[ai][bj][m][n] + xr * alpha; } }
    }
};
}

__device__ __forceinline__ int early_orig(int e) { return e < 3328 ? e : (e < 4096 ? 4352 + (e - 3328) : (e < 6400 ? 5888 + (e - 4096) : 5120 + (e - 6400))); }
__device__ __forceinline__ int late_orig(int c) { return c < 1024 ? 3328 + c : (c < 1280 ? 8192 + (c - 1024) : 8448 + (c - 1280)); }
__device__ __forceinline__ int my_orig(int n) { return n < NE ? early_orig(n) : late_orig(n - NE); }

__device__ __forceinline__ void convert_tile(const int t, const float* src, int src_ld, bf16_t* dst, int dst_ld, float* lds) {
    const int c = t & 63, r0 = t >> 6;
#pragma unroll
    for (int i = 0; i < 8; ++i) { const int k = r0 + 8 * i; lds[k * 65 + c] = src ? src[(size_t)k * src_ld + c] : 0.f; }
    __syncthreads();
#pragma unroll
    for (int i = 0; i < 8; ++i) { const int n = r0 + 8 * i; dst[(size_t)n * dst_ld + c] = f2bf(lds[c * 65 + n]); }
    __syncthreads();
}

__device__ __forceinline__ void convert_weights(const int tid, const int bid, const Params& P, int l, float* lds) {
    unsigned char* ws = P.ws;
    bf16_t* WIN = (bf16_t*)(ws + OFF_WIN); bf16_t* LORA = (bf16_t*)(ws + OFF_LORA); bf16_t* POOLW = (bf16_t*)(ws + OFF_POOLW);
    bf16_t* PROJ = (bf16_t*)(ws + OFF_PROJ); bf16_t* WOUT = (bf16_t*)(ws + OFF_WOUT); float* BIASP = (float*)(ws + OFF_BIASP);
    const float* w_in = P.w_in + (size_t)l * 1024 * NIN;
    constexpr int N_WIN = 180 * 16, N_LORA = 64 * 4, N_POOL = 12 * 12, N_PROJ = 16 * 32, N_WOUT = 16 * 16;
    constexpr int NTILES = N_WIN + N_LORA + N_POOL + N_PROJ + N_WOUT;
    for (int tile = bid; tile < NTILES; tile += gridDim.x) {
        int t = tile;
        if (t < N_WIN) { const int nt = t >> 4, kt = t & 15; const int n0 = nt * 64, k0 = kt * 64;
            convert_tile(tid, w_in + (size_t)k0 * NIN + my_orig(n0), NIN, WIN + (size_t)n0 * 1024 + k0, 1024, lds); continue; }
        t -= N_WIN;
        if (t < N_LORA) { const int nt = t >> 2, kt = t & 3; const int n0 = nt * 64, seg = n0 >> 10, ch = n0 & 1023;
            const float* src = nullptr;
            if (kt == seg) src = (seg < 2 ? P.w_up + ((size_t)(l * 2 + seg) * 64) * 1024 : P.a_up + ((size_t)(l * 2 + seg - 2) * 64) * 1024) + ch;
            convert_tile(tid, src, 1024, LORA + (size_t)n0 * 256 + kt * 64, 256, lds); continue; }
        t -= N_LORA;
        if (t < N_POOL) { const int nt = t / 12, kt = t % 12; const int n0 = nt * 64, k0 = kt * 64, gn = n0 / 192, gk = k0 / 192;
            const float* src = nullptr;
            if (gn == gk) src = P.pool_w + ((size_t)(l * 4 + gn) * 192 + (k0 - 192 * gk)) * 192 + (n0 - 192 * gn);
            convert_tile(tid, src, 192, POOLW + (size_t)n0 * 768 + k0, 768, lds); continue; }
        t -= N_POOL;
        if (t < N_PROJ) { const int nt = t >> 5, kt = t & 31; const int n0 = nt * 64, k0 = kt * 64;
            const float* src = k0 < 1024 ? P.proj_a + ((size_t)l * 1024 + k0) * 1024 + n0
                             : (k0 < 1792 ? P.proj_b + ((size_t)l * 768 + (k0 - 1024)) * 1024 + n0 : P.proj_c + ((size_t)l * 256 + (k0 - 1792)) * 1024 + n0);
            convert_tile(tid, src, 1024, PROJ + (size_t)n0 * 2048 + k0, 2048, lds); continue; }
        t -= N_PROJ;
        { const int nt = t >> 4, kt = t & 15; const int n0 = nt * 64, k0 = kt * 64;
            convert_tile(tid, P.w_out + ((size_t)l * 1024 + k0) * 1024 + n0, 1024, WOUT + (size_t)n0 * 1024 + k0, 1024, lds); }
    }
    for (int i = bid * 512 + tid; i < NIN; i += gridDim.x * 512) BIASP[i] = P.b_in[(size_t)l * NIN + my_orig(i)];
}

__device__ __forceinline__ void phase_prepass(const int tid, const int bid, const Params& P, float* lds) {
    unsigned char* ws = P.ws;
    bf16_t* XB = (bf16_t*)(ws + OFF_XB); float* ROPE = (float*)(ws + OFF_ROPE);
    const size_t gtid = (size_t)bid * 512 + tid, gsz = (size_t)gridDim.x * 512;
    for (size_t i = gtid; i < (size_t)T_TOK * 1024 / 4; i += gsz) { const f32x4 v = *(const f32x4*)(P.x + i * 4);
        u32x2 w; w.x = cvt_pk_bf16(v[0], v[1]); w.y = cvt_pk_bf16(v[2], v[3]); *(u32x2*)(XB + i * 4) = w; }
    for (size_t i = gtid; i < (size_t)SEQ * 32; i += gsz) { const int pos = (int)(i >> 5), fi = (int)(i & 31);
        double inv = 1.0; for (int j = 0; j < fi; ++j) inv *= 0.7498942093324559;
        const double ang = (double)pos * inv; const double n = rint(ang * 0.15915494309189535); const double r = ang - n * 6.283185307179586476925287;
        const double r2 = r * r; double sn = 1.0, cs = 1.0;
        for (int kk = 25; kk >= 3; kk -= 2) sn = 1.0 - sn * r2 / (double)(kk * (kk - 1));
        sn *= r;
        for (int kk = 24; kk >= 2; kk -= 2) cs = 1.0 - cs * r2 / (double)(kk * (kk - 1));
        ROPE[i * 2] = (float)cs; ROPE[i * 2 + 1] = (float)sn; }
    convert_weights(tid, bid, P, 0, lds);
}

__device__ __forceinline__ void phase_prep(const int tid, const int bid, const Params& P, int l, float* ldsf) {
    unsigned char* ws = P.ws;
    bf16_t* HE = (bf16_t*)(ws + OFF_A); bf16_t* RKV = (bf16_t*)(ws + OFF_B); float* RN = (float*)(ws + OFF_RN);
    bf16_t* LIN = (bf16_t*)(ws + OFF_LIN); bf16_t* MIX = (bf16_t*)(ws + OFF_MIX); bf16_t* VT = (bf16_t*)(ws + OFF_VT); const float* ROPE = (const float*)(ws + OFF_ROPE);
    const float* mu0 = P.mu + (size_t)l * 2 * 3328; const float* mu1 = mu0 + 3328; const float* kk_w = P.k_k + (size_t)l * 1024;
    const size_t gtid = (size_t)bid * 512 + tid, gsz = (size_t)gridDim.x * 512;
    for (size_t u = gtid; u < (size_t)T_TOK * 416; u += gsz) {
        const int tok = (int)(u / 416), cg8 = (int)(u % 416), c = cg8 * 8, pos = tok & (SEQ - 1);
        const bf16_t* hp = HE + (size_t)tok * NE + c;
        float cu[8], pv[8], nx[8];
        unpack8(*(const u32x4*)hp, cu);
        if (pos > 0) unpack8(*(const u32x4*)(hp - NE), pv); else { for (int j = 0; j < 8; ++j) pv[j] = 0.f; }
        if (pos < SEQ - 1) unpack8(*(const u32x4*)(hp + NE), nx); else { for (int j = 0; j < 8; ++j) nx[j] = 0.f; }
        const f32x4 m0a = *(const f32x4*)(mu0 + c), m0b = *(const f32x4*)(mu0 + c + 4), m1a = *(const f32x4*)(mu1 + c), m1b = *(const f32x4*)(mu1 + c + 4);
        float o[8];
#pragma unroll
        for (int j = 0; j < 8; ++j) { const float a0 = j < 4 ? m0a[j] : m0b[j - 4], a1 = j < 4 ? m1a[j] : m1b[j - 4]; o[j] = cu[j] + a0 * (pv[j] - cu[j]) + a1 * (nx[j] - cu[j]); }
        if (c < 3072) {
            *(u32x4*)(RKV + (size_t)tok * 3072 + c) = pack8(o);
            float ss = 0.f;
            if (c >= 1024 && c < 2048) { const f32x4 ka = *(const f32x4*)(kk_w + (c - 1024)), kb = *(const f32x4*)(kk_w + (c - 1024) + 4);
#pragma unroll
                for (int j = 0; j < 8; ++j) { const float t = o[j] * (j < 4 ? ka[j] : kb[j - 4]); ss += t * t; } }
            ss += __shfl_xor(ss, 1); ss += __shfl_xor(ss, 2); ss += __shfl_xor(ss, 4);
            if (c >= 1024 && c < 2048 && (cg8 & 7) == 0) RN[(size_t)tok * 16 + ((c - 1024) >> 6)] = rsqrtf(ss + 1e-12f);
        } else {
            float ss = 0.f; ss += __shfl_xor(ss, 1); ss += __shfl_xor(ss, 2); ss += __shfl_xor(ss, 4);
            (void)ss;
            if (c < 3200) {
#pragma unroll
                for (int j = 0; j < 8; ++j) { const float ax = fabsf(o[j]); const float e = __expf(-2.f * ax); const float th = (1.f - e) / (1.f + e); o[j] = o[j] < 0.f ? -th : th; } }
            *(u32x4*)(LIN + (size_t)tok * 256 + (c - 3072)) = pack8(o);
        }
    }
    for (size_t u = gtid; u < (size_t)T_TOK * 96; u += gsz) {
        const int tok = (int)(u / 96), c = (int)(u % 96) * 8, pos = tok & (SEQ - 1), g = c / 192, half = 1 << g;
        const int lo = max(pos - half, 0), hi = min(pos + half, SEQ - 1);
        const bf16_t* hp = HE + (size_t)(tok - pos) * NE + E_PB + c;
        float s[8], me[8], t8[8];
#pragma unroll
        for (int j = 0; j < 8; ++j) s[j] = 0.f;
        for (int p = lo; p <= hi; ++p) { unpack8(*(const u32x4*)(hp + (size_t)p * NE), t8);
#pragma unroll
            for (int j = 0; j < 8; ++j) s[j] += t8[j]; }
        unpack8(*(const u32x4*)(hp + (size_t)pos * NE), me);
        const float ic = 1.0f / (float)(hi - lo + 1);
#pragma unroll
        for (int j = 0; j < 8; ++j) s[j] = s[j] * ic - me[j];
        *(u32x4*)(MIX + (size_t)tok * 768 + c) = pack8(s);
    }
    for (size_t u = gtid; u < (size_t)T_TOK * 96; u += gsz) {
        const int tok = (int)(u / 96), r = (int)(u % 96), hd24 = r >> 2, jq = r & 3, pos = tok & (SEQ - 1);
        bf16_t* p1 = HE + (size_t)tok * NE + E_Q + hd24 * 64 + jq * 8; bf16_t* p2 = p1 + 32;
        float x1[8], x2[8], o1[8], o2[8];
        unpack8(*(const u32x4*)p1, x1); unpack8(*(const u32x4*)p2, x2);
        const float* rp = ROPE + ((size_t)pos * 32 + jq * 8) * 2;
#pragma unroll
        for (int j = 0; j < 8; j += 2) { const f32x4 cs = *(const f32x4*)(rp + j * 2);
            o1[j] = x1[j] * cs[0] - x2[j] * cs[1]; o2[j] = x2[j] * cs[0] + x1[j] * cs[1];
            o1[j + 1] = x1[j + 1] * cs[2] - x2[j + 1] * cs[3]; o2[j + 1] = x2[j + 1] * cs[2] + x1[j + 1] * cs[3]; }
        *(u32x4*)p1 = pack8(o1); *(u32x4*)p2 = pack8(o2);
    }
    bf16_t* lt = (bf16_t*)ldsf;
    for (int tile = bid; tile < NB * 12 * 32; tile += gridDim.x) {
        const int pt = tile & 31, bh = tile >> 5, hd = bh % 12, b = bh / 12, dsh = 2 * (hd >> 2), p0 = pt * 64;
        const int t = tid;
        { const int tk = t >> 3, c8 = (t & 7) * 8;
            const u32x4 w = *(const u32x4*)(HE + ((size_t)b * SEQ + p0 + tk) * NE + E_V + hd * 64 + c8);
            unsigned* lp = (unsigned*)(lt + tk * 66 + c8); lp[0] = w.x; lp[1] = w.y; lp[2] = w.z; lp[3] = w.w; }
        __syncthreads();
        { const int dh = t >> 3, j8 = (t & 7) * 8;
            bf16_t* vrow = VT + ((size_t)(b * 12 + hd) * 64 + dh) * SEQ;
#pragma unroll
            for (int j = 0; j < 8; ++j) { const int pos = p0 + j8 + j; const int pp = ((pos & ((1 << dsh) - 1)) << (11 - dsh)) + (pos >> dsh); vrow[pp] = lt[(j8 + j) * 66 + dh]; } }
        __syncthreads();
    }
}

__device__ __forceinline__ void attn_item(const bf16_t* HE, const bf16_t* VT, bf16_t* AO, float* LSE, int item, int lane) {
    const int ti = item & 127, bh = item >> 7, hd = bh % 12, b = bh / 12;
    const int dsh = 2 * (hd >> 2), L = SEQ >> dsh, tpr = L >> 4;
    const int res = ti / tpr, m0 = (ti % tpr) << 4;
    const int fr = lane & 15, fq = lane >> 4;
    const size_t tokb = (size_t)b * SEQ + res;
    const bf16_t* qp = HE + (tokb + ((size_t)(m0 + fr) << dsh)) * NE + E_Q + hd * 64 + fq * 8;
    const bf16x8 qf0 = *(const bf16x8*)qp, qf1 = *(const bf16x8*)(qp + 32);
    float sv[10][4];
    float mx = -1e30f;
#pragma unroll
    for (int kt = 0; kt < 10; ++kt) {
        const int mk = m0 - 64 + 16 * kt + fr; const int mkc = min(max(mk, 0), L - 1);
        const bf16_t* kp = HE + (tokb + ((size_t)mkc << dsh)) * NE + E_K + hd * 64 + fq * 8;
        const bf16x8 kf0 = *(const bf16x8*)kp, kf1 = *(const bf16x8*)(kp + 32);
        f32x4 acc = {0.f, 0.f, 0.f, 0.f};
        acc = __builtin_amdgcn_mfma_f32_16x16x32_bf16(kf0, qf0, acc, 0, 0, 0);
        acc = __builtin_amdgcn_mfma_f32_16x16x32_bf16(kf1, qf1, acc, 0, 0, 0);
#pragma unroll
        for (int r = 0; r < 4; ++r) { const int mkk = m0 - 64 + 16 * kt + 4 * fq + r; const int dd = mkk - (m0 + fr);
            const bool valid = (mkk >= 0) && (mkk < L) && (dd <= 64) && (dd >= -64);
            const float s = valid ? acc[r] * 0.125f : -1e30f; sv[kt][r] = s; mx = fmaxf(mx, s); }
    }
    mx = fmaxf(mx, __shfl_xor(mx, 16)); mx = fmaxf(mx, __shfl_xor(mx, 32));
    float den = 0.f;
#pragma unroll
    for (int kt = 0; kt < 10; ++kt)
#pragma unroll
        for (int r = 0; r < 4; ++r) { const float p = __expf(sv[kt][r] - mx); sv[kt][r] = p; den += p; }
    den += __shfl_xor(den, 16); den += __shfl_xor(den, 32);
    f32x4 o[4];
#pragma unroll
    for (int nb = 0; nb < 4; ++nb) o[nb] = (f32x4){0.f, 0.f, 0.f, 0.f};
    const bf16_t* vbase = VT + ((size_t)(b * 12 + hd) * 64 + fr) * SEQ + (size_t)res * L;
#pragma unroll
    for (int pr = 0; pr < 5; ++pr) {
        union { bf16x8 v; unsigned u[4]; } af;
        af.u[0] = cvt_pk_bf16(sv[2 * pr][0], sv[2 * pr][1]); af.u[1] = cvt_pk_bf16(sv[2 * pr][2], sv[2 * pr][3]);
        af.u[2] = cvt_pk_bf16(sv[2 * pr + 1][0], sv[2 * pr + 1][1]); af.u[3] = cvt_pk_bf16(sv[2 * pr + 1][2], sv[2 * pr + 1][3]);
        const int mkb = m0 - 64 + 32 * pr + 4 * fq; const int k0 = (mkb >= 0 && mkb + 3 < L) ? mkb : 0; const int k1 = (mkb + 16 >= 0 && mkb + 19 < L) ? mkb + 16 : 0;
#pragma unroll
        for (int nb = 0; nb < 4; ++nb) {
            union { bf16x8 v; u32x2 h[2]; } bfr;
            bfr.h[0] = *(const u32x2*)(vbase + (size_t)nb * 16 * SEQ + k0); bfr.h[1] = *(const u32x2*)(vbase + (size_t)nb * 16 * SEQ + k1);
            o[nb] = __builtin_amdgcn_mfma_f32_16x16x32_bf16(af.v, bfr.v, o[nb], 0, 0, 0);
        }
    }
#pragma unroll
    for (int r = 0; r < 4; ++r) { const float dq = __shfl(den, 4 * fq + r); const float inv = 1.0f / dq;
        bf16_t* op = AO + (tokb + ((size_t)(m0 + 4 * fq + r) << dsh)) * 768 + hd * 64 + fr;
#pragma unroll
        for (int nb = 0; nb < 4; ++nb) op[nb * 16] = f2bf(o[nb][r] * inv); }
    if (fq == 0) LSE[(tokb + ((size_t)(m0 + fr) << dsh)) * 12 + hd] = mx + __logf(den);
}

#define DPPR(n) " row_ror:" #n " row_mask:0xf bank_mask:0xf\n"
#define SCAN_SA(sa, tmp, N, s) asm volatile( \
    "s_nop 1\n" \
    "v_mul_f32 %0, %2, %6\n" "v_mul_f32 %1, %3, %7\n" "v_fmac_f32 %0, %4, %8\n" "v_fmac_f32 %1, %5, %9\n" \
    "v_fmac_f32_dpp %0, %2, %10" DPPR(4) "v_fmac_f32_dpp %1, %3, %11" DPPR(4) "v_fmac_f32_dpp %0, %4, %12" DPPR(4) "v_fmac_f32_dpp %1, %5, %13" DPPR(4) \
    "v_fmac_f32_dpp %0, %2, %14" DPPR(8) "v_fmac_f32_dpp %1, %3, %15" DPPR(8) "v_fmac_f32_dpp %0, %4, %16" DPPR(8) "v_fmac_f32_dpp %1, %5, %17" DPPR(8) \
    "v_fmac_f32_dpp %0, %2, %18" DPPR(12) "v_fmac_f32_dpp %1, %3, %19" DPPR(12) "v_fmac_f32_dpp %0, %4, %20" DPPR(12) "v_fmac_f32_dpp %1, %5, %21" DPPR(12) \
    "v_add_f32 %0, %0, %1\n" "s_nop 1\n" \
    "v_add_f32_dpp %0, %0, %0 quad_perm:[1,0,3,2] row_mask:0xf bank_mask:0xf\n" "s_nop 1\n" \
    "v_add_f32_dpp %0, %0, %0 quad_perm:[2,3,0,1] row_mask:0xf bank_mask:0xf\n" \
    : "=&v"(sa), "=&v"(tmp) : "v"(N[0]), "v"(N[1]), "v"(N[2]), "v"(N[3]), \
      "v"(s[0]), "v"(s[1]), "v"(s[2]), "v"(s[3]), "v"(s[4]), "v"(s[5]), "v"(s[6]), "v"(s[7]), "v"(s[8]), "v"(s[9]), "v"(s[10]), "v"(s[11]), "v"(s[12]), "v"(s[13]), "v"(s[14]), "v"(s[15]))
#define SCAN_UPD(ym, s0, s1, s2, s3, W, Kd, Bv, R, vv, sa) asm volatile( \
    "s_nop 1\n" \
    "v_mul_f32 %1, %5, %1\n" "v_mul_f32_dpp %2, %5, %2" DPPR(4) "v_mul_f32_dpp %3, %5, %3" DPPR(8) "v_mul_f32_dpp %4, %5, %4" DPPR(12) \
    "v_fmac_f32 %1, %6, %9\n" "v_fmac_f32_dpp %2, %6, %9" DPPR(4) "v_fmac_f32_dpp %3, %6, %9" DPPR(8) "v_fmac_f32_dpp %4, %6, %9" DPPR(12) \
    "v_fmac_f32 %1, %7, %10\n" "v_fmac_f32_dpp %2, %7, %10" DPPR(4) "v_fmac_f32_dpp %3, %7, %10" DPPR(8) "v_fmac_f32_dpp %4, %7, %10" DPPR(12) \
    "v_mul_f32 %0, %8, %1\n" "v_fmac_f32_dpp %0, %8, %2" DPPR(4) "v_fmac_f32_dpp %0, %8, %3" DPPR(8) "v_fmac_f32_dpp %0, %8, %4" DPPR(12) \
    : "=&v"(ym), "+v"(s0), "+v"(s1), "+v"(s2), "+v"(s3) : "v"(W), "v"(Kd), "v"(Bv), "v"(R), "v"(vv), "v"(sa))

constexpr int SC_CH = 16;
constexpr int SC_STEP_F = 6 * 64;
__device__ __forceinline__ void phase_scan(const int tid, const int bid, const Params& P, int l, float* ldsf) {
    unsigned char* ws = P.ws;
    const bf16_t* RKV = (const bf16_t*)(ws + OFF_B); const float* RN = (const float*)(ws + OFF_RN); const bf16_t* EA = (const bf16_t*)(ws + OFF_C);
    float* Y = (float*)(ws + OFF_A);
    const int lane = tid & 63, wid = tid >> 6;
    for (int st = bid; st < 256; st += gridDim.x) {
        const int dir = st >> 7, bt = (st >> 4) & 7, hh = st & 15;
        const bf16_t* Ee = EA + (size_t)dir * T_TOK * 1024; const bf16_t* Aa = EA + (size_t)(2 + dir) * T_TOK * 1024;
        const int lt = tid - 256, lc = lt & 63, lsg = lt >> 6;
        float kkc = 0.f, kac = 0.f;
        if (tid >= 256) { kkc = P.k_k[(size_t)l * 1024 + hh * 64 + lc]; kac = P.k_a[(size_t)l * 1024 + hh * 64 + lc]; }
        float s[16];
#pragma unroll
        for (int j = 0; j < 16; ++j) s[j] = 0.f;
        const int voff = 16 * (lane & 3) + 4 * ((lane >> 2) & 3);
        const int vrow = 16 * wid + (lane >> 2);
        float* yp = Y + (size_t)dir * T_TOK * 1024 + (size_t)bt * SEQ * 1024 + hh * 64 + vrow;
        __syncthreads();
        for (int c = -1; c < SEQ / SC_CH; ++c) {
            if (tid >= 256) {
                if (c + 1 < SEQ / SC_CH) {
                    float* buf = ldsf + ((c + 1) & 1) * (SC_CH * SC_STEP_F);
#pragma unroll
                    for (int i = 0; i < 4; ++i) {
                        const int ts = lsg + 4 * i, t = (c + 1) * SC_CH + ts, pos = dir ? (SEQ - 1 - t) : t;
                        const size_t tok = (size_t)bt * SEQ + pos; const int ch = hh * 64 + lc;
                        const float r = bf2f(RKV[tok * 3072 + ch]), k = bf2f(RKV[tok * 3072 + 1024 + ch]), v = bf2f(RKV[tok * 3072 + 2048 + ch]);
                        const float rn = RN[tok * 16 + hh], e = bf2f(Ee[tok * 1024 + ch]), a = bf2f(Aa[tok * 1024 + ch]);
                        const float kk = k * kkc * rn;
                        float* bp = buf + ts * SC_STEP_F + lc;
                        bp[0] = kk; bp[64] = __expf(-e); bp[128] = k * (1.f + (a - 1.f) * kac); bp[192] = -kk * a; bp[256] = r; bp[320] = v;
                    }
                }
            } else if (c >= 0) {
                const float* buf = ldsf + (c & 1) * (SC_CH * SC_STEP_F);
#pragma unroll 2
                for (int ts = 0; ts < SC_CH; ++ts) {
                    const float* bp = buf + ts * SC_STEP_F;
                    const f32x4 N = *(const f32x4*)(bp + voff), W = *(const f32x4*)(bp + 64 + voff), Kd = *(const f32x4*)(bp + 128 + voff),
                                Bv = *(const f32x4*)(bp + 192 + voff), R = *(const f32x4*)(bp + 256 + voff);
                    const float vv = bp[320 + vrow];
                    float sa, tmp, y0, y1, y2, y3;
                    SCAN_SA(sa, tmp, N, s);
                    SCAN_UPD(y0, s[0], s[4], s[8], s[12], W[0], Kd[0], Bv[0], R[0], vv, sa);
                    SCAN_UPD(y1, s[1], s[5], s[9], s[13], W[1], Kd[1], Bv[1], R[1], vv, sa);
                    SCAN_UPD(y2, s[2], s[6], s[10], s[14], W[2], Kd[2], Bv[2], R[2], vv, sa);
                    SCAN_UPD(y3, s[3], s[7], s[11], s[15], W[3], Kd[3], Bv[3], R[3], vv, sa);
                    float y = (y0 + y1) + (y2 + y3);
                    asm volatile("s_nop 1\n v_add_f32_dpp %0, %0, %0 quad_perm:[1,0,3,2] row_mask:0xf bank_mask:0xf\n s_nop 1\n v_add_f32_dpp %0, %0, %0 quad_perm:[2,3,0,1] row_mask:0xf bank_mask:0xf" : "+v"(y));
                    const int t = c * SC_CH + ts, pos = dir ? (SEQ - 1 - t) : t;
                    if ((lane & 3) == 0) yp[(size_t)pos * 1024] = y;
                }
            }
            __syncthreads();
        }
    }
}

__device__ __forceinline__ void phase_post(const int tid, const int bid, const Params& P, int l) {
    unsigned char* ws = P.ws;
    const float* Y = (const float*)(ws + OFF_A); const bf16_t* RKV = (const bf16_t*)(ws + OFF_B); const bf16_t* HL = (const bf16_t*)(ws + OFF_C);
    const bf16_t* AO = (const bf16_t*)(ws + OFF_AO); const float* LSE = (const float*)(ws + OFF_LSE); bf16_t* O = (bf16_t*)(ws + OFF_O);
    const float* gg = P.gn_g + (size_t)l * 1024; const float* gb = P.gn_b + (size_t)l * 1024; const float* rk = P.r_k + (size_t)l * 1024;
    const size_t gtid = (size_t)bid * 512 + tid, gsz = (size_t)gridDim.x * 512;
    for (size_t u = gtid; u < (size_t)T_TOK * 256; u += gsz) {
        const size_t tok = u >> 8; const int c = (int)(u & 255) * 4;
        const f32x4 ya = *(const f32x4*)(Y + tok * 1024 + c), yb = *(const f32x4*)(Y + (size_t)T_TOK * 1024 + tok * 1024 + c);
        const f32x4 y = ya + yb;
        const u32x2 rw = *(const u32x2*)(RKV + tok * 3072 + c), kw = *(const u32x2*)(RKV + tok * 3072 + 1024 + c), vw = *(const u32x2*)(RKV + tok * 3072 + 2048 + c);
        const f32x4 rkv = *(const f32x4*)(rk + c);
        const float r4[4] = {bflo(rw.x), bfhi(rw.x), bflo(rw.y), bfhi(rw.y)}, k4[4] = {bflo(kw.x), bfhi(kw.x), bflo(kw.y), bfhi(kw.y)}, v4[4] = {bflo(vw.x), bfhi(vw.x), bflo(vw.y), bfhi(vw.y)};
        float s1 = y[0] + y[1] + y[2] + y[3], bd = r4[0] * k4[0] * rkv[0] + r4[1] * k4[1] * rkv[1] + r4[2] * k4[2] * rkv[2] + r4[3] * k4[3] * rkv[3];
#pragma unroll
        for (int m = 1; m < 16; m <<= 1) { s1 += __shfl_xor(s1, m); bd += __shfl_xor(bd, m); }
        const float mean = s1 * (1.f / 64.f);
        float s2 = 0.f;
#pragma unroll
        for (int j = 0; j < 4; ++j) { const float d = y[j] - mean; s2 += d * d; }
#pragma unroll
        for (int m = 1; m < 16; m <<= 1) s2 += __shfl_xor(s2, m);
        const float rstd = rsqrtf(s2 * (1.f / 64.f) + 64e-5f);
        const f32x4 g4 = *(const f32x4*)(gg + c), b4 = *(const f32x4*)(gb + c);
        const u32x2 zw = *(const u32x2*)(HL + tok * NL + L_ZA + c);
        const float z4[4] = {bflo(zw.x), bfhi(zw.x), bflo(zw.y), bfhi(zw.y)};
        float o[4];
#pragma unroll
        for (int j = 0; j < 4; ++j) o[j] = ((y[j] - mean) * rstd * g4[j] + b4[j] + bd * v4[j]) * siluf_(z4[j]);
        u32x2 w; w.x = cvt_pk_bf16(o[0], o[1]); w.y = cvt_pk_bf16(o[2], o[3]);
        *(u32x2*)(O + tok * 2048 + c) = w;
    }
    for (size_t u = gtid; u < (size_t)T_TOK * 64; u += gsz) {
        const size_t tok = u >> 6; const int r = (int)(u & 63), hs = r >> 4, d4 = (r & 15) * 4;
        const float l0 = LSE[tok * 12 + hs], l1 = LSE[tok * 12 + 4 + hs], l2 = LSE[tok * 12 + 8 + hs];
        const float lm = fmaxf(l0, fmaxf(l1, l2)); const float e0 = __expf(l0 - lm), e1 = __expf(l1 - lm), e2 = __expf(l2 - lm); const float inv = 1.f / (e0 + e1 + e2);
        const u32x2 a0 = *(const u32x2*)(AO + tok * 768 + hs * 64 + d4), a1 = *(const u32x2*)(AO + tok * 768 + (4 + hs) * 64 + d4), a2 = *(const u32x2*)(AO + tok * 768 + (8 + hs) * 64 + d4);
        const u32x2 zw = *(const u32x2*)(HL + tok * NL + L_ZC + hs * 64 + d4);
        float o[4];
        o[0] = (e0 * bflo(a0.x) + e1 * bflo(a1.x) + e2 * bflo(a2.x)) * inv * siluf_(bflo(zw.x));
        o[1] = (e0 * bfhi(a0.x) + e1 * bfhi(a1.x) + e2 * bfhi(a2.x)) * inv * siluf_(bfhi(zw.x));
        o[2] = (e0 * bflo(a0.y) + e1 * bflo(a1.y) + e2 * bflo(a2.y)) * inv * siluf_(bflo(zw.y));
        o[3] = (e0 * bfhi(a0.y) + e1 * bfhi(a1.y) + e2 * bfhi(a2.y)) * inv * siluf_(bfhi(zw.y));
        u32x2 w; w.x = cvt_pk_bf16(o[0], o[1]); w.y = cvt_pk_bf16(o[2], o[3]);
        *(u32x2*)(O + tok * 2048 + 1792 + hs * 64 + d4) = w;
    }
}

__device__ __forceinline__ void phase_ln(const int tid, const int bid, const Params& P, int l) {
    unsigned char* ws = P.ws;
    const float* PRE = (const float*)(ws + OFF_A); bf16_t* XB = (bf16_t*)(ws + OFF_XB);
    const float* g = P.ln_g + (size_t)l * 1024; const float* bb = P.ln_b + (size_t)l * 1024;
    const int lane = tid & 63, wid = tid >> 6;
    for (int row = bid * 8 + wid; row < T_TOK; row += gridDim.x * 8) {
        const float* pr = PRE + (size_t)row * 1024;
        f32x4 v[4]; float s = 0.f;
#pragma unroll
        for (int i = 0; i < 4; ++i) { v[i] = *(const f32x4*)(pr + i * 256 + lane * 4); s += v[i][0] + v[i][1] + v[i][2] + v[i][3]; }
#pragma unroll
        for (int m = 1; m < 64; m <<= 1) s += __shfl_xor(s, m);
        const float mean = s * (1.f / 1024.f); float s2 = 0.f;
#pragma unroll
        for (int i = 0; i < 4; ++i)
#pragma unroll
            for (int j = 0; j < 4; ++j) { const float d = v[i][j] - mean; s2 += d * d; }
#pragma unroll
        for (int m = 1; m < 64; m <<= 1) s2 += __shfl_xor(s2, m);
        const float rstd = rsqrtf(s2 * (1.f / 1024.f) + 1e-5f);
#pragma unroll
        for (int i = 0; i < 4; ++i) { const int c = i * 256 + lane * 4; const f32x4 g4 = *(const f32x4*)(g + c), b4 = *(const f32x4*)(bb + c);
            f32x4 o; for (int j = 0; j < 4; ++j) o[j] = (v[i][j] - mean) * rstd * g4[j] + b4[j];
            *(f32x4*)(P.out + (size_t)row * 1024 + c) = o;
            u32x2 w; w.x = cvt_pk_bf16(o[0], o[1]); w.y = cvt_pk_bf16(o[2], o[3]); *(u32x2*)(XB + (size_t)row * 1024 + c) = w; }
    }
}

constexpr int N_PH = 1 + 9 * DEPTH;
__global__ void __launch_bounds__(512, 2) fwd_kernel(Params P) {
    extern __shared__ __attribute__((aligned(16))) unsigned char shm[];
    LAS unsigned char* lds = (LAS unsigned char*)shm; float* ldsf = (float*)shm;
    const int G = (int)gridDim.x;
    for (int ph = P.ph_lo; ph < P.ph_hi; ++ph) {
        int tid = threadIdx.x; asm volatile("" : "+v"(tid));
        int c = blockIdx.x; asm volatile("" : "+s"(c));
        unsigned char* ws = P.ws; asm volatile("" : "+s"(ws));
        if (ph == 0) { phase_prepass(tid, c, P, ldsf); }
        else {
            const int l = (ph - 1) / 9, k = (ph - 1) % 9;
            switch (k) {
            case 0: {
                pg8::Gemm g{(const bf16_t*)(ws + OFF_XB), (const bf16_t*)(ws + OFF_WIN), T_TOK, NE, 1024};
                pg8::StaticOrder S; S.init(T_TOK, NE, 1024, G, c);
                pg8::EpiBias E{(bf16_t*)(ws + OFF_A), NE, (const float*)(ws + OFF_BIASP)};
                pg8::gemm_phase(tid, lds, g, S, E); } break;
            case 1: phase_prep(tid, c, P, l, ldsf); break;
            case 2: {
                { pg8::Gemm g{(const bf16_t*)(ws + OFF_LIN), (const bf16_t*)(ws + OFF_LORA), T_TOK, 4096, 256};
                  pg8::StaticOrder S; S.init(T_TOK, 4096, 256, G, c);
                  pg8::EpiLora E{(bf16_t*)(ws + OFF_C), P.w0 + (size_t)l * 2048, P.a0 + (size_t)l * 2048};
                  pg8::gemm_phase(tid, lds, g, S, E); }
                { pg8::Gemm g{(const bf16_t*)(ws + OFF_MIX), (const bf16_t*)(ws + OFF_POOLW), T_TOK, 768, 768};
                  pg8::StaticOrder S; S.init(T_TOK, 768, 768, G, G - 1 - c);
                  pg8::EpiPool E{(bf16_t*)(ws + OFF_O), (const bf16_t*)(ws + OFF_A), P.pool_b + (size_t)l * 768, P.pool_scale + (size_t)l * 768};
                  pg8::gemm_phase(tid, lds, g, S, E); }
                { const int lane = tid & 63, wid = tid >> 6;
                  for (int item = c * 8 + wid; item < NB * 12 * 128; item += G * 8)
                      attn_item((const bf16_t*)(ws + OFF_A), (const bf16_t*)(ws + OFF_VT), (bf16_t*)(ws + OFF_AO), (float*)(ws + OFF_LSE), item, lane); }
                } break;
            case 3: phase_scan(tid, c, P, l, ldsf); break;
            case 4: {
                pg8::Gemm g{(const bf16_t*)(ws + OFF_XB), (const bf16_t*)(ws + OFF_WIN) + (size_t)NE * 1024, T_TOK, NL, 1024};
                pg8::StaticOrder S; S.init(T_TOK, NL, 1024, G, c);
                pg8::EpiBias E{(bf16_t*)(ws + OFF_C), NL, (const float*)(ws + OFF_BIASP) + NE};
                pg8::gemm_phase(tid, lds, g, S, E); } break;
            case 5: phase_post(tid, c, P, l); break;
            case 6: {
                pg8::Gemm g{(const bf16_t*)(ws + OFF_O), (const bf16_t*)(ws + OFF_PROJ), T_TOK, 1024, 2048};
                pg8::MergeOrder S; S.init(G, c);
                pg8::EpiMerge E{(float*)(ws + OFF_B), (bf16_t*)(ws + OFF_D), (const bf16_t*)(ws + OFF_C)};
                pg8::gemm_phase(tid, lds, g, S, E); } break;
            case 7: {
                pg8::Gemm g{(const bf16_t*)(ws + OFF_D), (const bf16_t*)(ws + OFF_WOUT), T_TOK, 1024, 1024};
                pg8::StaticOrder S; S.init(T_TOK, 1024, 1024, G, c);
                pg8::EpiOut E{(float*)(ws + OFF_A), l == 0 ? P.x : (const float*)P.out, 1.681792830507429f};
                pg8::gemm_phase(tid, lds, g, S, E); } break;
            case 8: phase_ln(tid, c, P, l); if (l + 1 < DEPTH) convert_weights(tid, c, P, l + 1, ldsf); break;
            }
        }
#if !MK_MULTI
        if (ph + 1 < P.ph_hi) cg::this_grid().sync();
#endif
    }
}

extern "C" void kernel_launch(void* const* d_in, const int* in_sizes, int n_in, void* d_out, int out_size, void* d_ws, size_t ws_size, hipStream_t stream) {
    constexpr size_t kDynLds = 131072;
    static int grid_blocks = 0;
    if (!grid_blocks) {
        hipFuncSetAttribute((const void*)fwd_kernel, hipFuncAttributeMaxDynamicSharedMemorySize, (int)kDynLds);
        int dev = 0, cus = 0, per_cu = 0;
        hipGetDevice(&dev);
        hipDeviceGetAttribute(&cus, hipDeviceAttributeMultiprocessorCount, dev);
        hipOccupancyMaxActiveBlocksPerMultiprocessor(&per_cu, fwd_kernel, 512, kDynLds);
        if (per_cu < 1) per_cu = 1;
        grid_blocks = cus * per_cu;
        if (grid_blocks > 256) grid_blocks = 256;
        if (ws_size < WS_TOTAL) fprintf(stderr, "workspace too small: %zu < %zu\n", ws_size, (size_t)WS_TOTAL);
    }
    Params p{};
    p.x = (const float*)d_in[0]; p.w_in = (const float*)d_in[1]; p.b_in = (const float*)d_in[2]; p.mu = (const float*)d_in[3]; p.w0 = (const float*)d_in[4];
    p.w_up = (const float*)d_in[5]; p.a0 = (const float*)d_in[6]; p.a_up = (const float*)d_in[7]; p.k_k = (const float*)d_in[8]; p.k_a = (const float*)d_in[9];
    p.r_k = (const float*)d_in[10]; p.gn_g = (const float*)d_in[11]; p.gn_b = (const float*)d_in[12]; p.pool_w = (const float*)d_in[13]; p.pool_b = (const float*)d_in[14];
    p.pool_scale = (const float*)d_in[15]; p.proj_a = (const float*)d_in[16]; p.proj_b = (const float*)d_in[17]; p.proj_c = (const float*)d_in[18]; p.w_out = (const float*)d_in[19];
    p.ln_g = (const float*)d_in[20]; p.ln_b = (const float*)d_in[21];
    p.out = (float*)d_out; p.ws = (unsigned char*)d_ws;
#if MK_MULTI
    for (int ph = 0; ph < N_PH; ++ph) { p.ph_lo = ph; p.ph_hi = ph + 1;
        hipLaunchKernelGGL(fwd_kernel, dim3(grid_blocks), dim3(512), kDynLds, stream, p); }
#else
    p.ph_lo = 0; p.ph_hi = N_PH;
    void* args[] = {&p};
    hipError_t e = hipLaunchCooperativeKernel((void*)fwd_kernel, dim3(grid_blocks), dim3(512), args, kDynLds, stream);
    if (e != hipSuccess) fprintf(stderr, "cooperative launch failed: %s (grid %d)\n", hipGetErrorString(e), grid_blocks);
#endif
}
```

```cpp
#include <hip/hip_runtime.h>
#include <hip/hip_cooperative_groups.h>
#include <cstdio>
namespace cg = cooperative_groups;

#ifndef MK_REP
#define MK_REP -1
#endif
#ifndef MK_SUB
#define MK_SUB -1
#endif
#ifndef MK_MULTI
#define MK_MULTI 0
#endif

typedef unsigned short bf16_t;
typedef short bf16x8 __attribute__((ext_vector_type(8)));
typedef short bf16x4 __attribute__((ext_vector_type(4)));
typedef float f32x4 __attribute__((ext_vector_type(4)));
typedef unsigned u32x4 __attribute__((ext_vector_type(4)));
typedef unsigned u32x2 __attribute__((ext_vector_type(2)));
typedef float f32x2 __attribute__((ext_vector_type(2)));
#define LAS __attribute__((address_space(3)))

constexpr int T_TOK = 16384, SEQ = 2048, NB = 8, DM = 1024, DEPTH = 4;
constexpr int NE = 7168, NL = 4352, NIN = 11520;
constexpr int E_PB = 3328, E_Q = 4096, E_K = 4864, E_V = 5632, E_ZB = 6400;
constexpr int L_ZA = 0, L_ZC = 1024, L_GA = 1280;

constexpr size_t OFF_WIN = 0;
constexpr size_t OFF_LORA = OFF_WIN + (size_t)NIN * 1024 * 2;
constexpr size_t OFF_POOLW = OFF_LORA + (size_t)4096 * 256 * 2;
constexpr size_t OFF_PROJ = OFF_POOLW + (size_t)768 * 768 * 2;
constexpr size_t OFF_WOUT = OFF_PROJ + (size_t)1024 * 2048 * 2;
constexpr size_t OFF_BIASP = OFF_WOUT + (size_t)1024 * 1024 * 2;
constexpr size_t OFF_ROPE = OFF_BIASP + (size_t)NIN * 4;
constexpr size_t OFF_XB = OFF_ROPE + (size_t)SEQ * 64 * 4;
constexpr size_t OFF_A = OFF_XB + (size_t)T_TOK * 1024 * 2;
constexpr size_t OFF_HL = OFF_A;
constexpr size_t OFF_Y = OFF_A + (size_t)T_TOK * NL * 2;
constexpr size_t OFF_B = OFF_A + (size_t)T_TOK * NE * 2;
constexpr size_t OFF_RN = OFF_B + (size_t)T_TOK * 3072 * 2;
constexpr size_t OFF_C = OFF_RN + (size_t)T_TOK * 16 * 4;
constexpr size_t OFF_D = OFF_C + (size_t)T_TOK * NL * 2;
constexpr size_t OFF_LIN = OFF_D;
constexpr size_t OFF_MIX = OFF_LIN + (size_t)T_TOK * 256 * 2;
constexpr size_t OFF_VT = OFF_MIX + (size_t)T_TOK * 768 * 2;
constexpr size_t OFF_AO = OFF_VT + (size_t)T_TOK * 768 * 2;
constexpr size_t OFF_LSE = OFF_AO + (size_t)T_TOK * 768 * 2;
constexpr size_t OFF_O = OFF_LSE + (size_t)T_TOK * 12 * 4;
constexpr size_t OFF_QKH = OFF_O + (size_t)T_TOK * 2048 * 2;
constexpr size_t OFF_BAR = OFF_QKH + (size_t)T_TOK * 1536 * 2;
constexpr size_t WS_TOTAL = OFF_BAR + 16384;

struct Params {
    const float* x; const float* w_in; const float* b_in; const float* mu; const float* w0; const float* w_up; const float* a0; const float* a_up;
    const float* k_k; const float* k_a; const float* r_k; const float* gn_g; const float* gn_b; const float* pool_w; const float* pool_b; const float* pool_scale;
    const float* proj_a; const float* proj_b; const float* proj_c; const float* w_out; const float* ln_g; const float* ln_b;
    float* out; unsigned char* ws; int ph_lo, ph_hi;
};

__device__ __forceinline__ float bf2f(bf16_t v) { return __uint_as_float(((unsigned)v) << 16); }
__device__ __forceinline__ float bflo(unsigned w) { return __uint_as_float(w << 16); }
__device__ __forceinline__ float bfhi(unsigned w) { return __uint_as_float(w & 0xffff0000u); }
__device__ __forceinline__ unsigned cvt_pk_bf16(float lo, float hi) { unsigned r; asm volatile("v_cvt_pk_bf16_f32 %0, %1, %2" : "=v"(r) : "v"(lo), "v"(hi)); return r; }
__device__ __forceinline__ bf16_t f2bf(float f) { return (bf16_t)(cvt_pk_bf16(f, 0.f) & 0xffffu); }
__device__ __forceinline__ float sigmoidf_(float v) { return __builtin_amdgcn_rcpf(1.0f + __expf(-v)); }
__device__ __forceinline__ float siluf_(float v) { return v * __builtin_amdgcn_rcpf(1.0f + __expf(-v)); }
__device__ __forceinline__ float bperm(float v, int srclane) { return __builtin_bit_cast(float, __builtin_amdgcn_ds_bpermute(srclane << 2, __builtin_bit_cast(int, v))); }
constexpr int DPP_QP1 = 0xB1, DPP_QP2 = 0x4E, DPP_ROR4 = 0x124, DPP_ROR8 = 0x128;
template <int CTRL> __device__ __forceinline__ float dppf(float v) {
    return __builtin_bit_cast(float, __builtin_amdgcn_update_dpp(0, __builtin_bit_cast(int, v), CTRL, 0xf, 0xf, true));
}
__device__ __forceinline__ void unpack8(u32x4 w, float* f) {
    f[0] = bflo(w.x); f[1] = bfhi(w.x); f[2] = bflo(w.y); f[3] = bfhi(w.y); f[4] = bflo(w.z); f[5] = bfhi(w.z); f[6] = bflo(w.w); f[7] = bfhi(w.w);
}
__device__ __forceinline__ u32x4 pack8(const float* f) {
    u32x4 w; w.x = cvt_pk_bf16(f[0], f[1]); w.y = cvt_pk_bf16(f[2], f[3]); w.z = cvt_pk_bf16(f[4], f[5]); w.w = cvt_pk_bf16(f[6], f[7]); return w;
}

namespace pg8 {
constexpr int BM = 256, BK = 64, HALF = 128, HTB = HALF * BK * 2, STAGE_BYTES = 8 * HTB, NXCD = 8, WGM = 8;
__device__ __forceinline__ int lds_byte(int r, int c) { const int st = (r >> 4) * 2 + (c >> 5), rr = r & 15, cc = c & 31, ob = rr * 64 + cc * 2; return st * 1024 + (ob ^ (((ob >> 9) & 1) << 5)); }
__device__ __forceinline__ void stage_rc(int b, int& R, int& C) { const int st = b / 1024, sb = b % 1024, swz = sb ^ (((sb >> 9) & 1) << 5); R = (st >> 1) * 16 + swz / 64; C = (st & 1) * 32 + (swz % 64) / 2; }
__device__ __forceinline__ int perm32(int rho) { const int n = rho >> 4, i = rho & 15; return 8 * (i >> 2) + 4 * n + (i & 3); }

struct Unit { int pm, pn, koff, nt, tag; };
struct Gemm { const bf16_t* A; const bf16_t* Bt; int M, N, ld; };

struct StaticOrder {
    int nM, nN, nwg, G, c, nt;
    __device__ void init(int M, int N, int K, int G_, int c_) { nM = M / BM; nN = N / BM; nwg = nM * nN; G = G_; c = c_; nt = K / BK; }
    __device__ bool next(int i, Unit& u) const {
        const long L = (long)i * G + c; if (L >= nwg) return false;
        int wgid = (int)L; { const int q = nwg / NXCD, r = nwg % NXCD, xcd = wgid % NXCD, off = wgid / NXCD; wgid = (xcd < r ? xcd * (q + 1) : r * (q + 1) + (xcd - r) * q) + off; }
        const int nig = WGM * nN, gid = wgid / nig, fm = gid * WGM, gsz = (nM - fm) < WGM ? (nM - fm) : WGM;
        u.pm = fm + ((wgid % nig) % gsz); u.pn = (wgid % nig) / gsz; u.koff = 0; u.nt = nt; u.tag = 0; return true;
    }
};
struct MergeOrder {
    int G, c;
    __device__ void init(int G_, int c_) { G = G_; c = c_; }
    __device__ bool next(int i, Unit& u) const {
        const int ti = i / 3, br = i - ti * 3; const int cx = (G == 256) ? ((c & 7) * 32 + (c >> 3)) : c;
        const long L = (long)ti * G + cx; if (L >= 512) return false;
        u.pm = (int)(L >> 2); u.pn = (int)(L & 3); u.tag = br;
        u.koff = br == 0 ? 0 : (br == 1 ? 1024 : 1792); u.nt = br == 0 ? 16 : (br == 1 ? 12 : 4); return true;
    }
};

template <class Epi, class Sched, bool HM = false>
__device__ __forceinline__ void gemm_phase(const int tid, LAS unsigned char* lds, const Gemm g, const Sched& S, const Epi& E) {
    const int wid = __builtin_amdgcn_readfirstlane(tid >> 6), lane = tid & 63, wr = wid >> 2, wc = wid & 3, fr = lane & 15, fq = lane >> 4;
    const int K = g.ld;
    unsigned voffA[2], voffB[2];
#pragma unroll
    for (int i = 0; i < 2; ++i) { int R, C; stage_rc(tid * 16 + i * 8192, R, C); const int Rb = Epi::PERM ? ((R & ~31) + perm32(R & 31)) : R;
        voffA[i] = (unsigned)(R * K + C) * 2u; voffB[i] = (unsigned)(Rb * K + C) * 2u; }
    const size_t kstep = (size_t)(BK * 2);
    const size_t hstep = (size_t)HALF * K * 2;
    const size_t tstep = 2 * hstep;
    const size_t astep = HM ? hstep : tstep;
    const size_t h1 = HM ? 0 : hstep;
    const unsigned ldsw = (unsigned)wid * 1024u;
    const int aoff = lds_byte(wr * 64 + fr, fq * 8), boff = lds_byte(wc * 32 + fr, fq * 8);
#define PG8_SA(b, h) (((b) * 2 + (h)) * HTB)
#define PG8_SB(b, h) ((4 + (b) * 2 + (h)) * HTB)
#define PG8_STAGE(bufoff, gbase, voff) do { _Pragma("unroll") for (int _i = 0; _i < 2; ++_i) \
        __builtin_amdgcn_global_load_lds((const unsigned*)((const char*)(gbase) + (voff)[_i]), (LAS unsigned*)(lds + (bufoff) + ldsw + _i * 8192), 16, 0, 0); } while (0)
#define PG8_LDA(dst, b, h) do { _Pragma("unroll") for (int m = 0; m < 4; ++m) _Pragma("unroll") for (int k = 0; k < 2; ++k) dst[m][k] = *(const LAS bf16x8*)(lds + PG8_SA(b, h) + aoff + m * 2048 + k * 1024); } while (0)
#define PG8_LDB(dst, b, h) do { _Pragma("unroll") for (int n = 0; n < 2; ++n) _Pragma("unroll") for (int k = 0; k < 2; ++k) dst[n][k] = *(const LAS bf16x8*)(lds + PG8_SB(b, h) + boff + n * 2048 + k * 1024); } while (0)
#define PG8_MMA(ai, bj, At, Bt) do { __builtin_amdgcn_s_setprio(1); _Pragma("unroll") for (int m = 0; m < 4; ++m) _Pragma("unroll") for (int n = 0; n < 2; ++n) _Pragma("unroll") for (int k = 0; k < 2; ++k) \
        acc[ai][bj][m][n] = __builtin_amdgcn_mfma_f32_16x16x32_bf16(Bt[n][k], At[m][k], acc[ai][bj][m][n], 0, 0, 0); __builtin_amdgcn_s_setprio(0); } while (0)
#define PG8_WAIT_V(n) asm volatile("s_waitcnt vmcnt(" #n ")" ::: "memory")
#define PG8_WAIT_L(n) asm volatile("s_waitcnt lgkmcnt(" #n ")" ::: "memory")
#define PG8_BAR __builtin_amdgcn_s_barrier()
#define PG8_SCHED __builtin_amdgcn_sched_barrier(0)
    Unit cur, nxt; int ui = 0;
    if (!S.next(0, cur)) return;
    f32x4 acc[2][2][4][2];
#pragma unroll
    for (int a = 0; a < 2; ++a)
#pragma unroll
        for (int b = 0; b < 2; ++b)
#pragma unroll
            for (int m = 0; m < 4; ++m)
#pragma unroll
                for (int n = 0; n < 2; ++n) acc[a][b][m][n] = (f32x4){0.f, 0.f, 0.f, 0.f};
    bf16x8 At[4][2], B0[2][2], B1[2][2];
    f32x4 tot[2][4][2];
    if constexpr (HM) {
#pragma unroll
        for (int b = 0; b < 2; ++b)
#pragma unroll
            for (int m = 0; m < 4; ++m)
#pragma unroll
                for (int n = 0; n < 2; ++n) tot[b][m][n] = (f32x4){0.f, 0.f, 0.f, 0.f}; }
    const char* cA = (const char*)g.A + (size_t)cur.pm * astep + (size_t)cur.koff * 2; const char* cB = (const char*)g.Bt + (size_t)cur.pn * tstep + (size_t)cur.koff * 2;
    PG8_STAGE(PG8_SB(0, 0), cB, voffB); PG8_STAGE(PG8_SA(0, 0), cA, voffA); PG8_STAGE(PG8_SB(0, 1), cB + hstep, voffB); PG8_STAGE(PG8_SA(0, 1), cA + h1, voffA);
    if (wr == 1) PG8_BAR;
    PG8_WAIT_V(4); PG8_BAR;
    PG8_STAGE(PG8_SB(1, 0), cB + kstep, voffB); PG8_STAGE(PG8_SA(1, 0), cA + kstep, voffA); PG8_STAGE(PG8_SB(1, 1), cB + hstep + kstep, voffB);
    PG8_WAIT_V(6); PG8_BAR;
    for (;;) {
        const bool has_next = S.next(ui + 1, nxt);
        const char* nA = has_next ? (const char*)g.A + (size_t)nxt.pm * astep + (size_t)nxt.koff * 2 : cA; const char* nB = has_next ? (const char*)g.Bt + (size_t)nxt.pn * tstep + (size_t)nxt.koff * 2 : cB;
        const int nt = cur.nt;
        for (int t = 0; t < nt; t += 2) {
            const bool last = (t == nt - 2);
            const char* a1 = cA + (size_t)(t + 1) * kstep;
            const char* a2 = last ? nA : cA + (size_t)(t + 2) * kstep; const char* b2 = last ? nB : cB + (size_t)(t + 2) * kstep;
            const char* a3 = a2 + kstep; const char* b3 = b2 + kstep;
            PG8_LDB(B0, 0, 0); PG8_SCHED; PG8_LDA(At, 0, 0); PG8_STAGE(PG8_SA(1, 1), a1 + h1, voffA);
            PG8_WAIT_L(8); PG8_BAR; PG8_WAIT_L(0); PG8_MMA(0, 0, At, B0); PG8_BAR; PG8_SCHED;
            PG8_LDB(B1, 0, 1); PG8_STAGE(PG8_SB(0, 0), b2, voffB);
            PG8_BAR; PG8_WAIT_L(0); PG8_MMA(0, 1, At, B1); PG8_BAR;
            if constexpr (!HM) PG8_LDA(At, 0, 1);
            PG8_STAGE(PG8_SA(0, 0), a2, voffA);
            PG8_BAR; PG8_WAIT_L(0); if constexpr (!HM) PG8_MMA(1, 0, At, B0); PG8_BAR; PG8_SCHED;
            PG8_STAGE(PG8_SB(0, 1), b2 + hstep, voffB);
            PG8_WAIT_V(6); PG8_BAR; if constexpr (!HM) PG8_MMA(1, 1, At, B1); PG8_BAR;
            PG8_LDB(B0, 1, 0); PG8_SCHED; PG8_LDA(At, 1, 0); PG8_STAGE(PG8_SA(0, 1), a2 + h1, voffA);
            PG8_WAIT_L(8); PG8_BAR; PG8_WAIT_L(0); PG8_MMA(0, 0, At, B0); PG8_BAR; PG8_SCHED;
            PG8_LDB(B1, 1, 1); PG8_STAGE(PG8_SB(1, 0), b3, voffB);
            PG8_BAR; PG8_WAIT_L(0); PG8_MMA(0, 1, At, B1); PG8_BAR;
            if constexpr (!HM) PG8_LDA(At, 1, 1);
            PG8_STAGE(PG8_SA(1, 0), a3, voffA);
            PG8_BAR; PG8_WAIT_L(0); if constexpr (!HM) PG8_MMA(1, 0, At, B0); PG8_BAR; PG8_SCHED;
            PG8_STAGE(PG8_SB(1, 1), b3 + hstep, voffB);
            PG8_WAIT_V(6); PG8_BAR; if constexpr (!HM) PG8_MMA(1, 1, At, B1); PG8_BAR;
        }
        if constexpr (HM) E(acc, tot, cur, wr, wc, fr, fq); else E(acc, cur, wr, wc, fr, fq);
        if (!has_next) break;
#pragma unroll
        for (int a = 0; a < 2; ++a)
#pragma unroll
            for (int b = 0; b < 2; ++b)
#pragma unroll
                for (int m = 0; m < 4; ++m)
#pragma unroll
                    for (int n = 0; n < 2; ++n) acc[a][b][m][n] = (f32x4){0.f, 0.f, 0.f, 0.f};
        cur = nxt; cA = nA; cB = nB; ++ui;
    }
    PG8_WAIT_V(0);
    if (wr == 0) PG8_BAR;
    PG8_BAR;
#undef PG8_SA
#undef PG8_SB
#undef PG8_STAGE
#undef PG8_LDA
#undef PG8_LDB
#undef PG8_MMA
#undef PG8_WAIT_V
#undef PG8_WAIT_L
#undef PG8_BAR
#undef PG8_SCHED
}

struct EpiBias {
    static constexpr bool PERM = true;
    bf16_t* O; int ldc; const float* bias;
    __device__ __forceinline__ void operator()(const f32x4 (&acc)[2][2][4][2], const Unit& u, int wr, int wc, int fr, int fq) const {
        const int row0 = u.pm * BM + wr * 64 + fr, col0 = u.pn * BM + wc * 32 + 8 * fq;
        f32x4 bv[2][2];
#pragma unroll
        for (int bj = 0; bj < 2; ++bj)
#pragma unroll
            for (int n = 0; n < 2; ++n) bv[bj][n] = *(const f32x4*)(bias + col0 + bj * HALF + 4 * n);
#pragma unroll
        for (int ai = 0; ai < 2; ++ai)
#pragma unroll
            for (int m = 0; m < 4; ++m) { bf16_t* rowp = O + (size_t)(row0 + ai * HALF + m * 16) * ldc + col0;
#pragma unroll
                for (int bj = 0; bj < 2; ++bj) { f32x4 v0 = acc[ai][bj][m][0] + bv[bj][0], v1 = acc[ai][bj][m][1] + bv[bj][1];
                    u32x4 w; w.x = cvt_pk_bf16(v0[0], v0[1]); w.y = cvt_pk_bf16(v0[2], v0[3]); w.z = cvt_pk_bf16(v1[0], v1[1]); w.w = cvt_pk_bf16(v1[2], v1[3]);
                    *(u32x4*)(rowp + bj * HALF) = w; } }
    }
};
struct EpiLora {
    static constexpr bool PERM = true;
    bf16_t* EA; const float* w0; const float* a0;
    __device__ __forceinline__ void operator()(const f32x4 (&acc)[2][2][4][2], const Unit& u, int wr, int wc, int fr, int fq) const {
        const int row0 = u.pm * BM + wr * 64 + fr, colt = u.pn * BM, seg = colt >> 10, col0 = (colt & 1023) + wc * 32 + 8 * fq;
        const float* bp = (seg < 2 ? w0 + seg * 1024 : a0 + (seg - 2) * 1024) + col0;
        const float sc = seg < 2 ? 0.60653065971f : 1.0f;
        bf16_t* base = EA + (size_t)seg * T_TOK * 1024;
        f32x4 bv[2][2];
#pragma unroll
        for (int bj = 0; bj < 2; ++bj)
#pragma unroll
            for (int n = 0; n < 2; ++n) bv[bj][n] = *(const f32x4*)(bp + bj * HALF + 4 * n);
#pragma unroll
        for (int ai = 0; ai < 2; ++ai)
#pragma unroll
            for (int m = 0; m < 4; ++m) { const int row = row0 + ai * HALF + m * 16;
#pragma unroll
                for (int bj = 0; bj < 2; ++bj) { f32x4 v0 = acc[ai][bj][m][0] + bv[bj][0], v1 = acc[ai][bj][m][1] + bv[bj][1];
#pragma unroll
                    for (int j = 0; j < 4; ++j) { v0[j] = sc * sigmoidf_(v0[j]); v1[j] = sc * sigmoidf_(v1[j]); }
                    u32x4 w; w.x = cvt_pk_bf16(v0[0], v0[1]); w.y = cvt_pk_bf16(v0[2], v0[3]); w.z = cvt_pk_bf16(v1[0], v1[1]); w.w = cvt_pk_bf16(v1[2], v1[3]);
                    const int cc = col0 + bj * HALF;
                    *(u32x4*)(base + ((size_t)((row >> 11) * 16 + (cc >> 6)) * SEQ + (row & 2047)) * 64 + (cc & 63)) = w; } }
    }
};
struct EpiPool {
    static constexpr bool PERM = true;
    bf16_t* O; const bf16_t* HE; const float* pb; const float* ps;
    __device__ __forceinline__ void operator()(const f32x4 (&acc)[2][2][4][2], const Unit& u, int wr, int wc, int fr, int fq) const {
        const int row0 = u.pm * BM + wr * 64 + fr, col0 = u.pn * BM + wc * 32 + 8 * fq;
        f32x4 bv[2][2], sv[2][2];
#pragma unroll
        for (int bj = 0; bj < 2; ++bj)
#pragma unroll
            for (int n = 0; n < 2; ++n) { bv[bj][n] = *(const f32x4*)(pb + col0 + bj * HALF + 4 * n); sv[bj][n] = *(const f32x4*)(ps + col0 + bj * HALF + 4 * n); }
#pragma unroll
        for (int ai = 0; ai < 2; ++ai) {
            u32x4 zv[4][2];
#pragma unroll
            for (int m = 0; m < 4; ++m)
#pragma unroll
                for (int bj = 0; bj < 2; ++bj) zv[m][bj] = *(const u32x4*)(O + (size_t)(row0 + ai * HALF + m * 16) * 2048 + col0 + bj * HALF);
            __builtin_amdgcn_sched_barrier(0);
#pragma unroll
            for (int m = 0; m < 4; ++m) { const size_t row = (size_t)(row0 + ai * HALF + m * 16);
#pragma unroll
                for (int bj = 0; bj < 2; ++bj) { const int c = col0 + bj * HALF;
                    float z[8]; unpack8(zv[m][bj], z);
                    f32x4 v0 = (acc[ai][bj][m][0] + bv[bj][0]) * sv[bj][0], v1 = (acc[ai][bj][m][1] + bv[bj][1]) * sv[bj][1];
#pragma unroll
                    for (int j = 0; j < 4; ++j) { v0[j] *= siluf_(z[j]); v1[j] *= siluf_(z[4 + j]); }
                    u32x4 w; w.x = cvt_pk_bf16(v0[0], v0[1]); w.y = cvt_pk_bf16(v0[2], v0[3]); w.z = cvt_pk_bf16(v1[0], v1[1]); w.w = cvt_pk_bf16(v1[2], v1[3]);
                    *(u32x4*)(O + row * 2048 + 1024 + c) = w; } }
        }
    }
};
struct EpiMerge {
    static constexpr bool PERM = true;
    bf16_t* MRGb; const bf16_t* HL;
    __device__ __forceinline__ void operator()(const f32x4 (&acc)[2][2][4][2], f32x4 (&tot)[2][4][2], const Unit& u, int wr, int wc, int fr, int fq) const {
        const int row0 = u.pm * HALF + wr * 64 + fr, col0 = u.pn * BM + wc * 32 + 8 * fq, br = u.tag;
        u32x4 gv[4][2];
#pragma unroll
        for (int m = 0; m < 4; ++m)
#pragma unroll
            for (int bj = 0; bj < 2; ++bj) gv[m][bj] = *(const u32x4*)(HL + (size_t)(row0 + m * 16) * NL + L_GA + br * 1024 + col0 + bj * HALF);
        __builtin_amdgcn_sched_barrier(0);
#pragma unroll
        for (int m = 0; m < 4; ++m) { const size_t row = (size_t)(row0 + m * 16);
#pragma unroll
            for (int bj = 0; bj < 2; ++bj) { const int c = col0 + bj * HALF;
                float gt[8]; unpack8(gv[m][bj], gt);
                f32x4 v0 = acc[0][bj][m][0], v1 = acc[0][bj][m][1];
#pragma unroll
                for (int j = 0; j < 4; ++j) { v0[j] *= sigmoidf_(gt[j]); v1[j] *= sigmoidf_(gt[4 + j]); }
                if (br > 0) { v0 += tot[bj][m][0]; v1 += tot[bj][m][1]; }
                tot[bj][m][0] = v0; tot[bj][m][1] = v1;
                if (br == 2) { u32x4 w; w.x = cvt_pk_bf16(v0[0], v0[1]); w.y = cvt_pk_bf16(v0[2], v0[3]); w.z = cvt_pk_bf16(v1[0], v1[1]); w.w = cvt_pk_bf16(v1[2], v1[3]);
                    *(u32x4*)(MRGb + row * 1024 + c) = w; } } }
    }
};
struct EpiOut {
    static constexpr bool PERM = false;
    float* PRE; const float* xres; float alpha;
    __device__ __forceinline__ void operator()(const f32x4 (&acc)[2][2][4][2], const Unit& u, int wr, int wc, int fr, int fq) const {
        const int row0 = u.pm * BM + wr * 64 + fr, col0 = u.pn * BM + wc * 32 + 4 * fq;
#pragma unroll
        for (int ai = 0; ai < 2; ++ai) {
            f32x4 xr[4][2][2];
#pragma unroll
            for (int m = 0; m < 4; ++m)
#pragma unroll
                for (int bj = 0; bj < 2; ++bj)
#pragma unroll
                    for (int n = 0; n < 2; ++n) xr[m][bj][n] = *(const f32x4*)(xres + (size_t)(row0 + ai * HALF + m * 16) * 1024 + col0 + bj * HALF + n * 16);
            __builtin_amdgcn_sched_barrier(0);
#pragma unroll
            for (int m = 0; m < 4; ++m) { const size_t ro = (size_t)(row0 + ai * HALF + m * 16) * 1024 + col0;
#pragma unroll
                for (int bj = 0; bj < 2; ++bj)
#pragma unroll
                    for (int n = 0; n < 2; ++n) *(f32x4*)(PRE + ro + bj * HALF + n * 16) = acc[ai][bj][m][n] + xr[m][bj][n] * alpha; }
        }
    }
};
}

__device__ __forceinline__ int early_orig(int e) { return e < 3328 ? e : (e < 4096 ? 4352 + (e - 3328) : (e < 6400 ? 5888 + (e - 4096) : 5120 + (e - 6400))); }
__device__ __forceinline__ int late_orig(int c) { return c < 1024 ? 3328 + c : (c < 1280 ? 8192 + (c - 1024) : 8448 + (c - 1280)); }
__device__ __forceinline__ int my_orig(int n) { return n < NE ? early_orig(n) : late_orig(n - NE); }

__device__ __forceinline__ void convert_tile(const int t, const float* src, int src_ld, bf16_t* dst, int dst_ld, float* lds) {
    const int c = t & 63, r0 = t >> 6;
#pragma unroll
    for (int i = 0; i < 8; ++i) { const int k = r0 + 8 * i; lds[k * 65 + c] = src ? src[(size_t)k * src_ld + c] : 0.f; }
    __syncthreads();
#pragma unroll
    for (int i = 0; i < 8; ++i) { const int n = r0 + 8 * i; dst[(size_t)n * dst_ld + c] = f2bf(lds[c * 65 + n]); }
    __syncthreads();
}

struct CvtTile { const float* src; bf16_t* dst; int src_ld, dst_ld; };
__device__ __forceinline__ CvtTile cvt_decode(const Params& P, unsigned char* ws, int l, int t) {
    bf16_t* WIN = (bf16_t*)(ws + OFF_WIN); bf16_t* LORA = (bf16_t*)(ws + OFF_LORA); bf16_t* POOLW = (bf16_t*)(ws + OFF_POOLW);
    bf16_t* PROJ = (bf16_t*)(ws + OFF_PROJ); bf16_t* WOUT = (bf16_t*)(ws + OFF_WOUT);
    constexpr int N_WIN = 180 * 16, N_LORA = 64 * 4, N_POOL = 12 * 12, N_PROJ = 16 * 32;
    CvtTile d;
    if (t < N_WIN) { const int nt = t >> 4, kt = t & 15; const int n0 = nt * 64, k0 = kt * 64;
        d.src = P.w_in + (size_t)l * 1024 * NIN + (size_t)k0 * NIN + my_orig(n0); d.src_ld = NIN; d.dst = WIN + (size_t)n0 * 1024 + k0; d.dst_ld = 1024; return d; }
    t -= N_WIN;
    if (t < N_LORA) { const int nt = t >> 2, kt = t & 3; const int n0 = nt * 64, seg = n0 >> 10, ch = n0 & 1023;
        d.src = nullptr;
        if (kt == seg) d.src = (seg < 2 ? P.w_up + ((size_t)(l * 2 + seg) * 64) * 1024 : P.a_up + ((size_t)(l * 2 + seg - 2) * 64) * 1024) + ch;
        d.src_ld = 1024; d.dst = LORA + (size_t)n0 * 256 + kt * 64; d.dst_ld = 256; return d; }
    t -= N_LORA;
    if (t < N_POOL) { const int nt = t / 12, kt = t % 12; const int n0 = nt * 64, k0 = kt * 64, gn = n0 / 192, gk = k0 / 192;
        d.src = nullptr;
        if (gn == gk) d.src = P.pool_w + ((size_t)(l * 4 + gn) * 192 + (k0 - 192 * gk)) * 192 + (n0 - 192 * gn);
        d.src_ld = 192; d.dst = POOLW + (size_t)n0 * 768 + k0; d.dst_ld = 768; return d; }
    t -= N_POOL;
    if (t < N_PROJ) { const int nt = t >> 5, kt = t & 31; const int n0 = nt * 64, k0 = kt * 64;
        d.src = k0 < 1024 ? P.proj_a + ((size_t)l * 1024 + k0) * 1024 + n0
                          : (k0 < 1792 ? P.proj_b + ((size_t)l * 768 + (k0 - 1024)) * 1024 + n0 : P.proj_c + ((size_t)l * 256 + (k0 - 1792)) * 1024 + n0);
        d.src_ld = 1024; d.dst = PROJ + (size_t)n0 * 2048 + k0; d.dst_ld = 2048; return d; }
    t -= N_PROJ;
    { const int nt = t >> 4, kt = t & 15; const int n0 = nt * 64, k0 = kt * 64;
        d.src = P.w_out + ((size_t)l * 1024 + k0) * 1024 + n0; d.src_ld = 1024; d.dst = WOUT + (size_t)n0 * 1024 + k0; d.dst_ld = 1024; return d; }
}
__device__ __forceinline__ void convert_weights(const int tid, const int bid, const Params& P, unsigned char* ws, int l, float* lds) {
    float* BIASP = (float*)(ws + OFF_BIASP);
    constexpr int NTILES = 180 * 16 + 64 * 4 + 12 * 12 + 16 * 32 + 16 * 16;
    constexpr int CB = 4;
    const int c = tid & 63, r0 = tid >> 6;
    for (int tile0 = bid; tile0 < NTILES; tile0 += CB * gridDim.x) {
        CvtTile d[CB]; float v[CB][8];
#pragma unroll
        for (int q = 0; q < CB; ++q) { const int t = tile0 + q * gridDim.x; d[q] = cvt_decode(P, ws, l, t < NTILES ? t : tile0); if (t >= NTILES) d[q].dst = nullptr; }
#pragma unroll
        for (int q = 0; q < CB; ++q)
#pragma unroll
            for (int i = 0; i < 8; ++i) { const int k = r0 + 8 * i; v[q][i] = d[q].src ? d[q].src[(size_t)k * d[q].src_ld + c] : 0.f; }
#pragma unroll
        for (int q = 0; q < CB; ++q)
#pragma unroll
            for (int i = 0; i < 8; ++i) { const int k = r0 + 8 * i; lds[q * 4160 + k * 65 + c] = v[q][i]; }
        __syncthreads();
#pragma unroll
        for (int q = 0; q < CB; ++q) if (d[q].dst) {
#pragma unroll
            for (int i = 0; i < 8; ++i) { const int n = r0 + 8 * i; d[q].dst[(size_t)n * d[q].dst_ld + c] = f2bf(lds[q * 4160 + c * 65 + n]); } }
        __syncthreads();
    }
    for (int i = bid * 512 + tid; i < NIN; i += gridDim.x * 512) BIASP[i] = P.b_in[(size_t)l * NIN + my_orig(i)];
}

__device__ __forceinline__ void phase_prepass(const int tid, const int bid, const Params& P, unsigned char* ws, float* lds) {
    bf16_t* XB = (bf16_t*)(ws + OFF_XB); float* ROPE = (float*)(ws + OFF_ROPE);
    const size_t gtid = (size_t)bid * 512 + tid, gsz = (size_t)gridDim.x * 512;
    for (size_t i0 = gtid; i0 < (size_t)T_TOK * 1024 / 4; i0 += 8 * gsz) {
        f32x4 v[8];
#pragma unroll
        for (int k = 0; k < 8; ++k) { const size_t i = i0 + k * gsz; v[k] = *(const f32x4*)(P.x + (i < (size_t)T_TOK * 1024 / 4 ? i : i0) * 4); }
#pragma unroll
        for (int k = 0; k < 8; ++k) { const size_t i = i0 + k * gsz; if (i < (size_t)T_TOK * 1024 / 4) {
            u32x2 w; w.x = cvt_pk_bf16(v[k][0], v[k][1]); w.y = cvt_pk_bf16(v[k][2], v[k][3]); *(u32x2*)(XB + i * 4) = w; } } }
    for (size_t i = gtid; i < (size_t)SEQ * 32; i += gsz) { const int pos = (int)(i >> 5), fi = (int)(i & 31);
        double inv = 1.0; for (int j = 0; j < fi; ++j) inv *= 0.7498942093324559;
        const double ang = (double)pos * inv; const double n = rint(ang * 0.15915494309189535); const double r = ang - n * 6.283185307179586476925287;
        const double r2 = r * r; double sn = 1.0, cs = 1.0;
        for (int kk = 25; kk >= 3; kk -= 2) sn = 1.0 - sn * r2 / (double)(kk * (kk - 1));
        sn *= r;
        for (int kk = 24; kk >= 2; kk -= 2) cs = 1.0 - cs * r2 / (double)(kk * (kk - 1));
        ROPE[i * 2] = (float)cs; ROPE[i * 2 + 1] = (float)sn; }
    convert_weights(tid, bid, P, ws, 0, lds);
}

template <int H> __device__ __forceinline__ void pool_quad(const bf16_t* hp  , bf16_t* mp  , int pos0) {
    u32x4 rw[4 + 2 * H];
#pragma unroll
    for (int j = 0; j < 4 + 2 * H; ++j) { const int p = pos0 - H + j; rw[j] = (p >= 0 && p < SEQ) ? *(const u32x4*)(hp + (size_t)p * NE) : (u32x4){0u, 0u, 0u, 0u}; }
#pragma unroll
    for (int i = 0; i < 4; ++i) {
        float acc[8], t8[8], me[8];
#pragma unroll
        for (int j = 0; j < 8; ++j) acc[j] = 0.f;
#pragma unroll
        for (int j = i; j <= i + 2 * H; ++j) { unpack8(rw[j], t8);
#pragma unroll
            for (int q = 0; q < 8; ++q) acc[q] += t8[q]; }
        unpack8(rw[i + H], me);
        const int pos = pos0 + i, lo = max(pos - H, 0), hi = min(pos + H, SEQ - 1); const float ic = 1.0f / (float)(hi - lo + 1);
#pragma unroll
        for (int q = 0; q < 8; ++q) acc[q] = acc[q] * ic - me[q];
        *(u32x4*)(mp + (size_t)pos * 768) = pack8(acc);
    }
}
__device__ __forceinline__ void phase_prep(const int tid, const int bid, const Params& P, unsigned char* ws, int l, float* ldsf, const bool do_rope) {
    const bf16_t* HE = (const bf16_t*)(ws + OFF_A); bf16_t* RKV = (bf16_t*)(ws + OFF_B); float* RN = (float*)(ws + OFF_RN);
    bf16_t* LIN = (bf16_t*)(ws + OFF_LIN); bf16_t* MIX = (bf16_t*)(ws + OFF_MIX); bf16_t* VT = (bf16_t*)(ws + OFF_VT); const float* ROPE = (const float*)(ws + OFF_ROPE);
    bf16_t* QKH = (bf16_t*)(ws + OFF_QKH);
    const float* mu0 = P.mu + (size_t)l * 2 * 3328; const float* mu1 = mu0 + 3328; const float* kk_w = P.k_k + (size_t)l * 1024;
    const int gtid = bid * 512 + tid;
    if (gtid < 416 * 256) {
        const int cg8 = gtid % 416, tg = gtid / 416, c = cg8 * 8;
        float m0[8], m1[8], kw[8];
        { const f32x4 a = *(const f32x4*)(mu0 + c), b = *(const f32x4*)(mu0 + c + 4), d = *(const f32x4*)(mu1 + c), e = *(const f32x4*)(mu1 + c + 4);
#pragma unroll
          for (int j = 0; j < 4; ++j) { m0[j] = a[j]; m0[4 + j] = b[j]; m1[j] = d[j]; m1[4 + j] = e[j]; } }
        const bool is_k = (c >= 1024 && c < 2048);
        if (is_k) { const f32x4 a = *(const f32x4*)(kk_w + c - 1024), b = *(const f32x4*)(kk_w + c - 1024 + 4);
#pragma unroll
            for (int j = 0; j < 4; ++j) { kw[j] = a[j]; kw[4 + j] = b[j]; } }
        else {
#pragma unroll
            for (int j = 0; j < 8; ++j) kw[j] = 0.f; }
        for (int it0 = 0; it0 < 16; it0 += 2) {
            u32x4 rwb[2][6];
#pragma unroll
            for (int h = 0; h < 2; ++h) { const int tq = tg + 256 * (it0 + h), tok0 = tq * 4, pos0 = tok0 & (SEQ - 1); const bf16_t* hp = HE + (size_t)tok0 * NE + c;
#pragma unroll
                for (int j = 0; j < 6; ++j) { const int p = pos0 - 1 + j; rwb[h][j] = (p >= 0 && p < SEQ) ? *(const u32x4*)(hp + (long)(j - 1) * NE) : (u32x4){0u, 0u, 0u, 0u}; } }
            __builtin_amdgcn_sched_barrier(0);
#pragma unroll
            for (int h = 0; h < 2; ++h) {
            const int tq = tg + 256 * (it0 + h), tok0 = tq * 4, pos0 = tok0 & (SEQ - 1);
            float pv[8], cu[8], nx[8];
            unpack8(rwb[h][0], pv); unpack8(rwb[h][1], cu);
#pragma unroll
            for (int i = 0; i < 4; ++i) {
                unpack8(rwb[h][i + 2], nx);
                float o[8];
#pragma unroll
                for (int j = 0; j < 8; ++j) o[j] = cu[j] + m0[j] * (pv[j] - cu[j]) + m1[j] * (nx[j] - cu[j]);
                const int tok = tok0 + i, pos = pos0 + i;
                if (c < 3072) {
                    const int arr = c >> 10, chn = c & 1023;
                    *(u32x4*)(RKV + (size_t)arr * T_TOK * 1024 + ((size_t)((tok >> 11) * 16 + (chn >> 6)) * SEQ + pos) * 64 + (chn & 63)) = pack8(o);
                    if (is_k) { float ss = 0.f;
#pragma unroll
                        for (int j = 0; j < 8; ++j) { const float t = o[j] * kw[j]; ss += t * t; }
                        ss += dppf<DPP_QP1>(ss); ss += dppf<DPP_QP2>(ss); ss += dppf<0x141>(ss);
                        if ((cg8 & 7) == 0) RN[(size_t)((tok >> 11) * 16 + ((c - 1024) >> 6)) * SEQ + pos] = rsqrtf(ss + 1e-12f); }
                } else {
                    if (c < 3200) {
#pragma unroll
                        for (int j = 0; j < 8; ++j) { const float ax = fabsf(o[j]); const float e = __expf(-2.f * ax); const float th = (1.f - e) / (1.f + e); o[j] = o[j] < 0.f ? -th : th; } }
                    *(u32x4*)(LIN + (size_t)tok * 256 + (c - 3072)) = pack8(o);
                }
#pragma unroll
                for (int j = 0; j < 8; ++j) { pv[j] = cu[j]; cu[j] = nx[j]; }
            }
            }
        }
    }
    if (gtid < 96 * 1024) {
        const int cg8 = gtid % 96, tg = gtid / 96, c = cg8 * 8, g = c / 192;
        for (int it = 0; it < 4; ++it) {
            const int tq = tg + 1024 * it, tok0 = tq * 4, pos0 = tok0 & (SEQ - 1); const size_t tb = (size_t)(tok0 - pos0);
            const bf16_t* hp = HE + tb * NE + E_PB + c; bf16_t* mp = MIX + tb * 768 + c;
            if (g == 0) pool_quad<1>(hp, mp, pos0); else if (g == 1) pool_quad<2>(hp, mp, pos0); else if (g == 2) pool_quad<4>(hp, mp, pos0); else pool_quad<8>(hp, mp, pos0);
        }
    }
    if (do_rope && gtid < 96 * 1024) {
        const int r = gtid % 96, tg = gtid / 96, hd24 = r >> 2, jq = r & 3, dsh = 2 * ((hd24 % 12) >> 2);
        for (int it0 = 0; it0 < 16; it0 += 4) {
            u32x4 xa[4], xb[4]; f32x4 csb[4][4];
#pragma unroll
            for (int h = 0; h < 4; ++h) { const int tok = tg + 1024 * (it0 + h), pos = tok & (SEQ - 1);
                const bf16_t* p1 = HE + (size_t)tok * NE + E_Q + hd24 * 64 + jq * 8;
                xa[h] = *(const u32x4*)p1; xb[h] = *(const u32x4*)(p1 + 32);
                const float* rp = ROPE + ((size_t)pos * 32 + jq * 8) * 2;
#pragma unroll
                for (int j = 0; j < 4; ++j) csb[h][j] = *(const f32x4*)(rp + j * 4); }
            __builtin_amdgcn_sched_barrier(0);
#pragma unroll
            for (int h = 0; h < 4; ++h) { const int tok = tg + 1024 * (it0 + h), pos = tok & (SEQ - 1), b = tok >> 11;
                float x1[8], x2[8], o1[8], o2[8];
                unpack8(xa[h], x1); unpack8(xb[h], x2);
#pragma unroll
                for (int j = 0; j < 8; j += 2) { const f32x4 cs = csb[h][j >> 1];
                    o1[j] = x1[j] * cs[0] - x2[j] * cs[1]; o2[j] = x2[j] * cs[0] + x1[j] * cs[1];
                    o1[j + 1] = x1[j + 1] * cs[2] - x2[j + 1] * cs[3]; o2[j + 1] = x2[j + 1] * cs[2] + x1[j + 1] * cs[3]; }
                const int pp = ((pos & ((1 << dsh) - 1)) << (11 - dsh)) + (pos >> dsh);
                bf16_t* q1 = QKH + ((size_t)(b * 24 + hd24) * SEQ + pp) * 64 + jq * 8;
                *(u32x4*)q1 = pack8(o1); *(u32x4*)(q1 + 32) = pack8(o2); }
        }
    }
    if (gtid < 96 * 1024) {
        bf16_t* Op = (bf16_t*)(ws + OFF_O); const int r = gtid % 96, tg = gtid / 96, cz = r * 8;
        for (int it0 = 0; it0 < 16; it0 += 4) { u32x4 zz[4];
#pragma unroll
            for (int h = 0; h < 4; ++h) zz[h] = *(const u32x4*)(HE + (size_t)(tg + 1024 * (it0 + h)) * NE + E_ZB + cz);
#pragma unroll
            for (int h = 0; h < 4; ++h) *(u32x4*)(Op + (size_t)(tg + 1024 * (it0 + h)) * 2048 + cz) = zz[h]; }
    }
    {
        const int lane = tid & 63, wid = tid >> 6;
        bf16_t* lt = (bf16_t*)ldsf + wid * (64 * 72);
        for (int tile = bid * 8 + wid; tile < NB * 12 * 32; tile += gridDim.x * 8) {
            const int pt = tile & 31, bh = tile >> 5, hd = bh % 12, b = bh / 12, dsh = 2 * (hd >> 2), p0 = pt * 64;
            u32x4 w[8];
#pragma unroll
            for (int i = 0; i < 8; ++i) { const int e = lane + 64 * i, tk = e >> 3, c8 = (e & 7) * 8;
                w[i] = *(const u32x4*)(HE + ((size_t)b * SEQ + p0 + tk) * NE + E_V + hd * 64 + c8); }
#pragma unroll
            for (int i = 0; i < 8; ++i) { const int e = lane + 64 * i, tk = e >> 3, c8 = (e & 7) * 8; *(u32x4*)(lt + tk * 72 + c8) = w[i]; }
            asm volatile("s_waitcnt lgkmcnt(0)" ::: "memory");
            bf16_t* vrow = VT + ((size_t)(b * 12 + hd) * 64 + lane) * SEQ;
            const int d = 1 << dsh, run = 64 >> dsh;
#pragma unroll 1
            for (int res = 0; res < d; ++res) {
                const int ppb = (res << (11 - dsh)) + (p0 >> dsh);
#pragma unroll 1
                for (int m = 0; m < run; m += 4) {
                    const unsigned a0 = lt[(res + ((m + 0) << dsh)) * 72 + lane], a1 = lt[(res + ((m + 1) << dsh)) * 72 + lane],
                                   a2 = lt[(res + ((m + 2) << dsh)) * 72 + lane], a3 = lt[(res + ((m + 3) << dsh)) * 72 + lane];
                    u32x2 o; o.x = a0 | (a1 << 16); o.y = a2 | (a3 << 16);
                    *(u32x2*)(vrow + ppb + m) = o; }
            }
            asm volatile("s_waitcnt lgkmcnt(0)" ::: "memory");
        }
    }
}

__device__ __forceinline__ void attn_item(const bf16_t* QKH, const bf16_t* VT, bf16_t* AO, float* LSE, int item, int lane) {
    const int ti = item & 127, bh = item >> 7, hd = bh % 12, b = bh / 12;
    const int dsh = 2 * (hd >> 2), L = SEQ >> dsh, tpr = L >> 4;
    const int res = ti / tpr, m0 = (ti % tpr) << 4;
    const int fr = lane & 15, fq = lane >> 4;
    const size_t tokb = (size_t)b * SEQ + res;
    const bf16_t* qbase = QKH + ((size_t)(b * 24 + hd) * SEQ + (size_t)res * L) * 64 + fq * 8;
    const bf16_t* kbase = qbase + (size_t)12 * SEQ * 64;
    const bf16_t* qp = qbase + (size_t)(m0 + fr) * 64;
    const bf16x8 qf0 = *(const bf16x8*)qp, qf1 = *(const bf16x8*)(qp + 32);
    float sv[10][4];
    float mx = -1e30f;
    bf16x8 kf[10][2];
#pragma unroll
    for (int kt = 0; kt < 10; ++kt) {
        const int kb = m0 - 64 + 32 * (kt >> 1) + 4 * (kt & 1);
        const int mk = kb + 8 * (fr >> 2) + (fr & 3); const int mkc = min(max(mk, 0), L - 1);
        const bf16_t* kp = kbase + (size_t)mkc * 64;
        kf[kt][0] = *(const bf16x8*)kp; kf[kt][1] = *(const bf16x8*)(kp + 32);
    }
    __builtin_amdgcn_sched_barrier(0);
#pragma unroll
    for (int kt = 0; kt < 10; ++kt) {
        const int kb = m0 - 64 + 32 * (kt >> 1) + 4 * (kt & 1);
        f32x4 acc = {0.f, 0.f, 0.f, 0.f};
        acc = __builtin_amdgcn_mfma_f32_16x16x32_bf16(kf[kt][0], qf0, acc, 0, 0, 0);
        acc = __builtin_amdgcn_mfma_f32_16x16x32_bf16(kf[kt][1], qf1, acc, 0, 0, 0);
#pragma unroll
        for (int r = 0; r < 4; ++r) { const int mkk = kb + 8 * fq + r; const int dd = mkk - (m0 + fr);
            const bool valid = (mkk >= 0) && (mkk < L) && (dd <= 64) && (dd >= -64);
            const float s = valid ? acc[r] * 0.125f : -1e30f; sv[kt][r] = s; mx = fmaxf(mx, s); }
    }
    const bf16_t* vbase = VT + ((size_t)(b * 12 + hd) * 64 + fr) * SEQ + (size_t)res * L;
    bf16x8 vf[5][4];
#pragma unroll
    for (int pr = 0; pr < 5; ++pr) {
        const int mkb = m0 - 64 + 32 * pr + 8 * fq; const int k0 = (mkb >= 0 && mkb + 7 < L) ? mkb : 0;
#pragma unroll
        for (int nb = 0; nb < 4; ++nb) vf[pr][nb] = *(const bf16x8*)(vbase + (size_t)nb * 16 * SEQ + k0);
    }
    __builtin_amdgcn_sched_barrier(0);
    mx = fmaxf(mx, bperm(mx, lane ^ 16)); mx = fmaxf(mx, bperm(mx, lane ^ 32));
    float den = 0.f;
#pragma unroll
    for (int kt = 0; kt < 10; ++kt)
#pragma unroll
        for (int r = 0; r < 4; ++r) { const float p = __expf(sv[kt][r] - mx); sv[kt][r] = p; den += p; }
    den += bperm(den, lane ^ 16); den += bperm(den, lane ^ 32);
    f32x4 o[4];
#pragma unroll
    for (int nb = 0; nb < 4; ++nb) o[nb] = (f32x4){0.f, 0.f, 0.f, 0.f};
#pragma unroll
    for (int pr = 0; pr < 5; ++pr) {
        union { bf16x8 v; unsigned u[4]; } af;
        af.u[0] = cvt_pk_bf16(sv[2 * pr][0], sv[2 * pr][1]); af.u[1] = cvt_pk_bf16(sv[2 * pr][2], sv[2 * pr][3]);
        af.u[2] = cvt_pk_bf16(sv[2 * pr + 1][0], sv[2 * pr + 1][1]); af.u[3] = cvt_pk_bf16(sv[2 * pr + 1][2], sv[2 * pr + 1][3]);
#pragma unroll
        for (int nb = 0; nb < 4; ++nb) o[nb] = __builtin_amdgcn_mfma_f32_16x16x32_bf16(af.v, vf[pr][nb], o[nb], 0, 0, 0);
    }
#pragma unroll
    for (int r = 0; r < 4; ++r) { const float dq = bperm(den, 4 * fq + r); const float inv = 1.0f / dq;
        bf16_t* op = AO + (tokb + ((size_t)(m0 + 4 * fq + r) << dsh)) * 768 + hd * 64 + fr;
#pragma unroll
        for (int nb = 0; nb < 4; ++nb) op[nb * 16] = f2bf(o[nb][r] * inv); }
    if (fq == 0) LSE[(tokb + ((size_t)(m0 + fr) << dsh)) * 12 + hd] = mx + __logf(den);
}

#define DPPR8 " row_ror:8 row_mask:0xf bank_mask:0xf\n"
#define DPPQ1 " quad_perm:[1,0,3,2] row_mask:0xf bank_mask:0xf\n"
#define DPPQ2 " quad_perm:[2,3,0,1] row_mask:0xf bank_mask:0xf\n"
#define DPPHM " row_half_mirror row_mask:0xf bank_mask:0xf\n"
#define SCAN_STEP(y, N, W, Kd, Bv, R, vv, s) do { float _sa, _t, _y2; asm volatile( \
    "v_mul_f32 %0, %12, %4\n" "v_mul_f32 %1, %13, %5\n" "v_fmac_f32 %0, %14, %6\n" "v_fmac_f32 %1, %15, %7\n" \
    "v_fmac_f32_dpp %0, %12, %8" DPPR8 "v_fmac_f32_dpp %1, %13, %9" DPPR8 "v_fmac_f32_dpp %0, %14, %10" DPPR8 "v_fmac_f32_dpp %1, %15, %11" DPPR8 \
    "v_add_f32 %0, %0, %1\n" \
    "v_mul_f32 %4, %16, %4\n" "v_mul_f32 %5, %17, %5\n" \
    "v_add_f32_dpp %0, %0, %0" DPPQ1 \
    "v_mul_f32 %6, %18, %6\n" "v_mul_f32 %7, %19, %7\n" \
    "v_add_f32_dpp %0, %0, %0" DPPQ2 \
    "v_mul_f32_dpp %8, %16, %8" DPPR8 "v_mul_f32_dpp %9, %17, %9" DPPR8 \
    "v_add_f32_dpp %0, %0, %0" DPPHM \
    "v_mul_f32_dpp %10, %18, %10" DPPR8 "v_mul_f32_dpp %11, %19, %11" DPPR8 \
    "v_fmac_f32 %4, %20, %32\n" "v_fmac_f32 %5, %21, %32\n" "v_fmac_f32 %6, %22, %32\n" "v_fmac_f32 %7, %23, %32\n" \
    "v_fmac_f32_dpp %8, %20, %32" DPPR8 "v_fmac_f32_dpp %9, %21, %32" DPPR8 "v_fmac_f32_dpp %10, %22, %32" DPPR8 "v_fmac_f32_dpp %11, %23, %32" DPPR8 \
    "v_fmac_f32 %4, %24, %0\n" "v_fmac_f32 %5, %25, %0\n" "v_fmac_f32 %6, %26, %0\n" "v_fmac_f32 %7, %27, %0\n" \
    "v_fmac_f32_dpp %8, %24, %0" DPPR8 "v_fmac_f32_dpp %9, %25, %0" DPPR8 "v_fmac_f32_dpp %10, %26, %0" DPPR8 "v_fmac_f32_dpp %11, %27, %0" DPPR8 \
    "v_mul_f32 %2, %28, %4\n" "v_mul_f32 %3, %29, %5\n" "v_fmac_f32 %2, %30, %6\n" "v_fmac_f32 %3, %31, %7\n" \
    "v_fmac_f32_dpp %2, %28, %8" DPPR8 "v_fmac_f32_dpp %3, %29, %9" DPPR8 "v_fmac_f32_dpp %2, %30, %10" DPPR8 "v_fmac_f32_dpp %3, %31, %11" DPPR8 \
    "v_add_f32 %2, %2, %3\n" "s_nop 1\n" \
    "v_add_f32_dpp %2, %2, %2" DPPQ1 "s_nop 1\n" \
    "v_add_f32_dpp %2, %2, %2" DPPQ2 "s_nop 1\n" \
    "v_add_f32_dpp %2, %2, %2" DPPHM \
    : "=&v"(_sa), "=&v"(_t), "=&v"(y), "=&v"(_y2), "+v"(s[0]), "+v"(s[1]), "+v"(s[2]), "+v"(s[3]), "+v"(s[4]), "+v"(s[5]), "+v"(s[6]), "+v"(s[7]) \
    : "v"(N[0]), "v"(N[1]), "v"(N[2]), "v"(N[3]), "v"(W[0]), "v"(W[1]), "v"(W[2]), "v"(W[3]), "v"(Kd[0]), "v"(Kd[1]), "v"(Kd[2]), "v"(Kd[3]), \
      "v"(Bv[0]), "v"(Bv[1]), "v"(Bv[2]), "v"(Bv[3]), "v"(R[0]), "v"(R[1]), "v"(R[2]), "v"(R[3]), "v"(vv)); } while (0)

__device__ __forceinline__ float row16_sum2(float a, float b, bool odd) {
    float x = odd ? b : a; const float g = odd ? a : b;
    x += dppf<DPP_QP1>(g); x += dppf<DPP_QP2>(x); x += dppf<DPP_ROR4>(x); x += dppf<DPP_ROR8>(x);
    return x;
}
constexpr int SC_CH = 32;
constexpr int SC_STEP_F = 6 * 64;
constexpr int SC_BUF_F = SC_CH * SC_STEP_F;
constexpr int SC_YOFF_F = 2 * SC_BUF_F;
__device__ __forceinline__ void phase_scan_seq(const int tid, const int bid, const Params& P, unsigned char* ws, int l, float* ldsf) {
    const bf16_t* RKV = (const bf16_t*)(ws + OFF_B); const float* RN = (const float*)(ws + OFF_RN); const bf16_t* EA = (const bf16_t*)(ws + OFF_C);
    float* Y = (float*)(ws + OFF_A);
    const int lane = tid & 63, wid = tid >> 6;
    for (int st = bid; st < 256; st += gridDim.x) {
        const int dir = st >> 7, bt = (st >> 4) & 7, hh = st & 15;
        const size_t sbase = (size_t)(bt * 16 + hh) * SEQ;
        const int lp = tid >> 4, c4 = (tid & 15) * 4;
        const int lts = dir ? (SC_CH - 1 - lp) : lp;
        const bf16_t* pr = RKV + (sbase + lp) * 64 + c4; const bf16_t* pk = pr + (size_t)T_TOK * 1024; const bf16_t* pv = pk + (size_t)T_TOK * 1024;
        const bf16_t* pe = EA + (size_t)dir * T_TOK * 1024 + (sbase + lp) * 64 + c4; const bf16_t* pa = pe + (size_t)2 * T_TOK * 1024;
        const float* pn = RN + sbase + lp;
        float* py = Y + (size_t)dir * T_TOK * 1024 + (sbase + lp) * 64 + c4;
        const f32x4 kkc = *(const f32x4*)(P.k_k + (size_t)l * 1024 + hh * 64 + c4), kac = *(const f32x4*)(P.k_a + (size_t)l * 1024 + hh * 64 + c4);
        f32x2 sA[2], sB[2];
        sA[0] = sA[1] = sB[0] = sB[1] = (f32x2){0.f, 0.f};
        const int voff = 4 * (lane & 15);
        const int vrow = 8 * wid + 2 * (lane >> 4);
        const bool odd = (lane & 1) != 0;
        const int yoff = ((lane & 14) == 0) ? (vrow + (lane & 1)) : (2 * SC_CH * 64 + lane);
        u32x2 q_r, q_k, q_v, q_e, q_a; float q_n;
#define SC_P0(cc) (dir ? (SEQ - SC_CH * ((cc) + 1)) : SC_CH * (cc))
#define SC_ISSUE(cc) do { const size_t o_ = (size_t)SC_P0(cc) * 64; q_r = *(const u32x2*)(pr + o_); q_k = *(const u32x2*)(pk + o_); q_v = *(const u32x2*)(pv + o_); \
        q_e = *(const u32x2*)(pe + o_); q_a = *(const u32x2*)(pa + o_); q_n = pn[SC_P0(cc)]; } while (0)
#define SC_COMMIT(cc) do { float* bp_ = ldsf + ((cc) & 1) * SC_BUF_F + lts * SC_STEP_F + c4; \
        const f32x4 k_ = {bflo(q_k.x), bfhi(q_k.x), bflo(q_k.y), bfhi(q_k.y)}, a_ = {bflo(q_a.x), bfhi(q_a.x), bflo(q_a.y), bfhi(q_a.y)}; \
        const f32x4 e_ = {bflo(q_e.x), bfhi(q_e.x), bflo(q_e.y), bfhi(q_e.y)}; \
        const f32x4 kk_ = k_ * kkc * q_n; f32x4 w_; w_[0] = __expf(-e_[0]); w_[1] = __expf(-e_[1]); w_[2] = __expf(-e_[2]); w_[3] = __expf(-e_[3]); \
        *(f32x4*)(bp_) = kk_; *(f32x4*)(bp_ + 64) = w_; *(f32x4*)(bp_ + 128) = k_ * ((a_ - 1.f) * kac + 1.f); *(f32x4*)(bp_ + 192) = -kk_ * a_; \
        *(f32x4*)(bp_ + 256) = (f32x4){bflo(q_r.x), bfhi(q_r.x), bflo(q_r.y), bfhi(q_r.y)}; *(f32x4*)(bp_ + 320) = (f32x4){bflo(q_v.x), bfhi(q_v.x), bflo(q_v.y), bfhi(q_v.y)}; } while (0)
#define SC_FLUSH(cc) do { *(f32x4*)(py + (size_t)SC_P0(cc) * 64) = *(const f32x4*)(ldsf + SC_YOFF_F + ((cc) & 1) * (SC_CH * 64) + lts * 64 + c4); } while (0)
#define SC_BARRIER() do { asm volatile("s_waitcnt lgkmcnt(0)" ::: "memory"); __builtin_amdgcn_s_barrier(); asm volatile("" ::: "memory"); } while (0)
        __syncthreads();
        SC_ISSUE(0); SC_COMMIT(0);
        SC_BARRIER();
        for (int c = 0; c < SEQ / SC_CH; ++c) {
            if (c > 0) SC_FLUSH(c - 1);
            if (c + 1 < SEQ / SC_CH) SC_ISSUE(c + 1);
            const float* buf = ldsf + (c & 1) * SC_BUF_F;
            float* ybuf = ldsf + SC_YOFF_F + (c & 1) * (SC_CH * 64) + yoff;
            f32x4 cN = *(const f32x4*)(buf + voff), cW = *(const f32x4*)(buf + 64 + voff), cK = *(const f32x4*)(buf + 128 + voff), cB = *(const f32x4*)(buf + 192 + voff), cR = *(const f32x4*)(buf + 256 + voff);
            f32x2 cv = *(const f32x2*)(buf + 320 + vrow);
#pragma unroll
            for (int ts = 0; ts < SC_CH; ++ts) {
                f32x4 nN, nW, nK, nB, nR; f32x2 nv;
                if (ts + 1 < SC_CH) { const float* bp = buf + (ts + 1) * SC_STEP_F;
                    nN = *(const f32x4*)(bp + voff); nW = *(const f32x4*)(bp + 64 + voff); nK = *(const f32x4*)(bp + 128 + voff); nB = *(const f32x4*)(bp + 192 + voff); nR = *(const f32x4*)(bp + 256 + voff); nv = *(const f32x2*)(bp + 320 + vrow); }
                const f32x2 N0 = {cN[0], cN[1]}, N1 = {cN[2], cN[3]}, W0 = {cW[0], cW[1]}, W1 = {cW[2], cW[3]}, K0 = {cK[0], cK[1]}, K1 = {cK[2], cK[3]},
                            B0 = {cB[0], cB[1]}, B1 = {cB[2], cB[3]}, R0 = {cR[0], cR[1]}, R1 = {cR[2], cR[3]};
                const f32x2 pa = N0 * sA[0] + N1 * sA[1], pb = N0 * sB[0] + N1 * sB[1];
                const float x = row16_sum2(pa[0] + pa[1], pb[0] + pb[1], odd);
                const float o = dppf<DPP_QP1>(x);
                const float saA = odd ? o : x, saB = odd ? x : o;
                const f32x2 vA = {cv[0], cv[0]}, vB = {cv[1], cv[1]}, aA = {saA, saA}, aB = {saB, saB};
                sA[0] = W0 * sA[0] + K0 * vA + B0 * aA; sA[1] = W1 * sA[1] + K1 * vA + B1 * aA;
                sB[0] = W0 * sB[0] + K0 * vB + B0 * aB; sB[1] = W1 * sB[1] + K1 * vB + B1 * aB;
                const f32x2 qa = R0 * sA[0] + R1 * sA[1], qb = R0 * sB[0] + R1 * sB[1];
                ybuf[ts * 64] = row16_sum2(qa[0] + qa[1], qb[0] + qb[1], odd);
                if (ts + 1 < SC_CH) { cN = nN; cW = nW; cK = nK; cB = nB; cR = nR; cv = nv; }
            }
            if (c + 1 < SEQ / SC_CH) SC_COMMIT(c + 1);
            SC_BARRIER();
        }
        SC_FLUSH(SEQ / SC_CH - 1);
#undef SC_ISSUE
#undef SC_COMMIT
#undef SC_FLUSH
#undef SC_P0
    }
    __syncthreads();
}

namespace sc2 {
constexpr int C = 16;
constexpr int RAW_F = C * 6 * 64;
constexpr int O_RAW = 0;
constexpr int O_NT = 2 * RAW_F * 4;
constexpr int O_BT = O_NT + 2 * 2304, O_KT = O_BT + 2304, O_RT = O_KT + 2304;
constexpr int O_BK = O_RT + 2 * 2304;
constexpr int O_UV = O_BK + 2 * 5120;
constexpr int O_BRKR = O_UV + 2 * 5120;
constexpr int O_ZKN = O_BRKR + 2 * 1280;
constexpr int O_SB = O_ZKN + 1280;
constexpr int O_MB = O_SB + 9216;
constexpr int O_GL = O_MB + 1024;
constexpr int O_PC = O_GL + 4096;
constexpr int O_Y = O_PC + 512;
constexpr int O_END = O_Y + 8192;
}
__device__ __forceinline__ void phase_scan(const int tid, const int bid, const Params& P, unsigned char* ws, int l, float* ldsf) {
    using namespace sc2;
    const bf16_t* RKV = (const bf16_t*)(ws + OFF_B); const float* RN = (const float*)(ws + OFF_RN); const bf16_t* EA = (const bf16_t*)(ws + OFF_C);
    bf16_t* Y = (bf16_t*)(ws + OFF_Y);
    unsigned char* lb = (unsigned char*)ldsf;
    const int lane = tid & 63, wid = tid >> 6, fr = lane & 15, fq = lane >> 4;
    for (int st = bid; st < 256; st += gridDim.x) {
        const int dir = st >> 7, bt = (st >> 4) & 7, hh = st & 15;
        const size_t sbase = (size_t)(bt * 16 + hh) * SEQ;
        const int lp = tid >> 5, c2 = (tid & 31) * 2, lts = dir ? (C - 1 - lp) : lp;
        const unsigned eo = (unsigned)((sbase + lp) * 64 + c2);
        const bf16_t* RKk = RKV + (size_t)T_TOK * 1024; const bf16_t* RKv = RKV + (size_t)2 * T_TOK * 1024;
        const bf16_t* EAe = EA + (size_t)dir * T_TOK * 1024; const bf16_t* EAa = EA + (size_t)(2 + dir) * T_TOK * 1024;
        bf16_t* Yd = Y + (size_t)dir * T_TOK * 1024;
        const float kkc0 = P.k_k[(size_t)l * 1024 + hh * 64 + c2], kkc1 = P.k_k[(size_t)l * 1024 + hh * 64 + c2 + 1];
        const float kac0 = P.k_a[(size_t)l * 1024 + hh * 64 + c2], kac1 = P.k_a[(size_t)l * 1024 + hh * 64 + c2 + 1];
        unsigned qv[2][5]; float qn[2];
#define SC_P0(cc) (dir ? (SEQ - C * ((cc) + 1)) : C * (cc))
#define SC_ISSUE(cc, S) do { const unsigned o_ = eo + (unsigned)(SC_P0(cc) * 64); qv[S][0] = *(const unsigned*)(RKV + o_); qv[S][1] = *(const unsigned*)(RKk + o_); qv[S][2] = *(const unsigned*)(RKv + o_); \
        qv[S][3] = *(const unsigned*)(EAe + o_); qv[S][4] = *(const unsigned*)(EAa + o_); qn[S] = RN[(unsigned)(sbase + lp) + (unsigned)SC_P0(cc)]; } while (0)
#define SC_COMMIT(cc, S) do { float* bp_ = (float*)(lb + O_RAW) + ((cc) & 1) * RAW_F + lts * (6 * 64) + c2; \
        const float k0_ = bflo(qv[S][1]), k1_ = bfhi(qv[S][1]), a0_ = bflo(qv[S][4]), a1_ = bfhi(qv[S][4]); const float kk0_ = k0_ * kkc0 * qn[S], kk1_ = k1_ * kkc1 * qn[S]; \
        *(f32x2*)(bp_) = (f32x2){kk0_, kk1_}; *(f32x2*)(bp_ + 64) = (f32x2){bflo(qv[S][3]), bfhi(qv[S][3])}; \
        *(f32x2*)(bp_ + 128) = (f32x2){k0_ * (1.f + (a0_ - 1.f) * kac0), k1_ * (1.f + (a1_ - 1.f) * kac1)}; *(f32x2*)(bp_ + 192) = (f32x2){-kk0_ * a0_, -kk1_ * a1_}; \
        *(f32x2*)(bp_ + 256) = (f32x2){bflo(qv[S][0]), bfhi(qv[S][0])}; *(f32x2*)(bp_ + 320) = (f32x2){bflo(qv[S][2]), bfhi(qv[S][2])}; } while (0)
#define SC_FLUSH(cc) do { const f32x2 yv_ = *(const f32x2*)((const float*)(lb + O_Y) + ((cc) & 1) * (C * 64) + lts * 64 + c2); *(unsigned*)(Yd + (eo + (unsigned)(SC_P0(cc) * 64))) = cvt_pk_bf16(yv_[0], yv_[1]); } while (0)
#define SC_BARRIER() do { asm volatile("s_waitcnt lgkmcnt(0)" ::: "memory"); __builtin_amdgcn_s_barrier(); asm volatile("" ::: "memory"); } while (0)
#define SC_PREPG(cc, WLO, WHI, TLO, NK) do { if (wid >= (WLO) && wid < (WHI)) { const float* raw_ = (const float*)(lb + O_RAW) + ((cc) & 1) * RAW_F; const int j_ = lane; \
        unsigned char* bk_ = lb + O_BK + ((cc) & 1) * 5120 + j_ * 80; unsigned char* uv_ = lb + O_UV + ((cc) & 1) * 5120 + j_ * 80; \
        unsigned char* nt_b = lb + O_NT + ((cc) & 1) * 2304 + j_ * 2; unsigned char* rt_b = lb + O_RT + ((cc) & 1) * 2304 + j_ * 2; \
        float ev_[15]; _Pragma("unroll") for (int tau_ = 0; tau_ < 15; ++tau_) ev_[tau_] = raw_[tau_ * 384 + 64 + j_]; \
        _Pragma("unroll") for (int k_ = 0; k_ < (NK); ++k_) { const int t_ = (TLO) + (wid - (WLO)) + ((WHI) - (WLO)) * k_; if (t_ < C) { \
            const float* rp_ = raw_ + t_ * 384 + j_; const float i0_ = rp_[0], i1_ = rp_[64], i2_ = rp_[128], i3_ = rp_[192], i4_ = rp_[256], i5_ = rp_[320]; \
            float E_ = 0.f; _Pragma("unroll") for (int tau_ = 0; tau_ < 15; ++tau_) E_ += (tau_ < t_) ? ev_[tau_] : 0.f; \
            const float pprev_ = __expf(-E_); E_ += i1_; const float pc_ = __expf(-E_), ipc_ = __expf(E_); \
            const bf16_t nt_ = f2bf(pprev_ * i0_), bt_ = f2bf(ipc_ * i3_), kt_ = f2bf(ipc_ * i2_), rt_ = f2bf(pc_ * i4_), vv_ = f2bf(i5_); \
            *(bf16_t*)(nt_b + t_ * 144) = nt_; *(bf16_t*)(lb + O_BT + t_ * 144 + j_ * 2) = bt_; *(bf16_t*)(lb + O_KT + t_ * 144 + j_ * 2) = kt_; *(bf16_t*)(rt_b + t_ * 144) = rt_; \
            *(bf16_t*)(bk_ + t_ * 2) = bt_; *(bf16_t*)(bk_ + (16 + t_) * 2) = kt_; *(bf16_t*)(uv_ + (16 + t_) * 2) = vv_; \
            if (t_ == C - 1) *(float*)(lb + O_PC + ((cc) & 1) * 256 + j_ * 4) = pc_; } } } } while (0)
#define SC_PREP(cc) SC_PREPG(cc, 0, 8, 0, 2)
#define SC_PREP_A(cc) SC_PREPG(cc, 0, 4, 0, 1)
#define SC_PREP_B(cc) SC_PREPG(cc, 1, 8, 4, 2)
#define SC_P1(cc) do { if (wid < 4) { \
        const unsigned char* xa_ = lb + ((wid & 1) ? O_KT : O_BT) + fr * 144 + fq * 16; const unsigned char* yb_ = lb + ((wid >> 1) ? O_RT : O_NT) + ((cc) & 1) * 2304 + fr * 144 + fq * 16; \
        f32x4 acc_ = {0.f, 0.f, 0.f, 0.f}; \
        acc_ = __builtin_amdgcn_mfma_f32_16x16x32_bf16(*(const bf16x8*)xa_, *(const bf16x8*)yb_, acc_, 0, 0, 0); \
        acc_ = __builtin_amdgcn_mfma_f32_16x16x32_bf16(*(const bf16x8*)(xa_ + 64), *(const bf16x8*)(yb_ + 64), acc_, 0, 0, 0); \
        _Pragma("unroll") for (int r_ = 0; r_ < 4; ++r_) { const int tau_ = 4 * fq + r_; const bool keep_ = (wid < 2) ? (tau_ < fr) : (tau_ <= fr); acc_[r_] = keep_ ? acc_[r_] : 0.f; } \
        if (wid == 0) *(f32x4*)(lb + O_MB + fr * 64 + fq * 16) = acc_; \
        else { u32x2 w_; w_.x = cvt_pk_bf16(acc_[0], acc_[1]); w_.y = cvt_pk_bf16(acc_[2], acc_[3]); \
            if (wid == 1) { *(u32x2*)(lb + O_ZKN + fr * 80 + (16 + 4 * fq) * 2) = w_; *(u32x2*)(lb + O_ZKN + fr * 80 + (4 * fq) * 2) = (u32x2){0u, 0u}; } \
            else *(u32x2*)(lb + O_BRKR + ((cc) & 1) * 1280 + fr * 80 + ((wid - 2) * 16 + 4 * fq) * 2) = w_; } } } while (0)
        f32x4 sacc[2]; sacc[0] = sacc[1] = (f32x4){0.f, 0.f, 0.f, 0.f};
        const int ib = wid >> 1, jb0 = 2 * (wid & 1);
        __syncthreads();
        for (int i = tid; i < 576; i += 512) *(u32x4*)(lb + O_SB + i * 16) = (u32x4){0u, 0u, 0u, 0u};
        for (int i = tid; i < 640; i += 512) *(u32x4*)(lb + O_UV + i * 16) = (u32x4){0u, 0u, 0u, 0u};
        SC_ISSUE(0, 0); SC_COMMIT(0, 0);
        SC_ISSUE(1, 1); SC_COMMIT(1, 1);
        SC_ISSUE(2, 0); SC_ISSUE(3, 1);
        SC_BARRIER();
        SC_PREP(0);
        SC_BARRIER();
        SC_P1(0);
        SC_BARRIER();
        for (int ch = 0; ch < SEQ / C / 2; ++ch) {
#pragma unroll
        for (int cc = 0; cc < 2; ++cc) {
            const int c = 2 * ch + cc;
            if (c > 0) SC_FLUSH(c - 1);
            if (c + 1 < SEQ / C) SC_PREP_A(c + 1);
            f32x4 hacc = {0.f, 0.f, 0.f, 0.f};
            if (wid >= 4) {
                const int ibb = wid - 4;
                const unsigned char* sa_ = lb + O_SB + (16 * ibb + fr) * 144 + fq * 16;
                const bf16x8 a0 = *(const bf16x8*)sa_, a1 = *(const bf16x8*)(sa_ + 64);
                const bf16x8 av = *(const bf16x8*)(lb + O_UV + (c & 1) * 5120 + (16 * ibb + fr) * 80 + fq * 16);
                const unsigned char* nb_ = lb + O_NT + (c & 1) * 2304 + fr * 144 + fq * 16; const unsigned char* rb_ = lb + O_RT + (c & 1) * 2304 + fr * 144 + fq * 16;
                f32x4 g = {0.f, 0.f, 0.f, 0.f};
                g = __builtin_amdgcn_mfma_f32_16x16x32_bf16(a0, *(const bf16x8*)nb_, g, 0, 0, 0);
                g = __builtin_amdgcn_mfma_f32_16x16x32_bf16(a1, *(const bf16x8*)(nb_ + 64), g, 0, 0, 0);
                g = __builtin_amdgcn_mfma_f32_16x16x32_bf16(av, *(const bf16x8*)(lb + O_ZKN + fr * 80 + fq * 16), g, 0, 0, 0);
                hacc = __builtin_amdgcn_mfma_f32_16x16x32_bf16(a0, *(const bf16x8*)rb_, hacc, 0, 0, 0);
                hacc = __builtin_amdgcn_mfma_f32_16x16x32_bf16(a1, *(const bf16x8*)(rb_ + 64), hacc, 0, 0, 0);
                *(f32x4*)(lb + O_GL + fr * 256 + (16 * ibb + 4 * fq) * 4) = g;
            }
            SC_BARRIER();
            if (wid == 0) {
                const int i = lane; float u[C];
#pragma unroll
                for (int t = 0; t < C; ++t) {
                    float a0 = *(const float*)(lb + O_GL + t * 256 + i * 4), a1 = 0.f;
                    f32x4 m[4];
#pragma unroll
                    for (int q = 0; q < 4; ++q) if (4 * q < t) m[q] = *(const f32x4*)(lb + O_MB + t * 64 + q * 16);
#pragma unroll
                    for (int tau = 0; tau < t; ++tau) { if (tau & 1) a1 += u[tau] * m[tau >> 2][tau & 3]; else a0 += u[tau] * m[tau >> 2][tau & 3]; }
                    u[t] = a0 + a1;
                }
                u32x4 w0, w1;
                w0.x = cvt_pk_bf16(u[0], u[1]); w0.y = cvt_pk_bf16(u[2], u[3]); w0.z = cvt_pk_bf16(u[4], u[5]); w0.w = cvt_pk_bf16(u[6], u[7]);
                w1.x = cvt_pk_bf16(u[8], u[9]); w1.y = cvt_pk_bf16(u[10], u[11]); w1.z = cvt_pk_bf16(u[12], u[13]); w1.w = cvt_pk_bf16(u[14], u[15]);
                *(u32x4*)(lb + O_UV + (c & 1) * 5120 + i * 80) = w0; *(u32x4*)(lb + O_UV + (c & 1) * 5120 + i * 80 + 16) = w1;
            }
            if (c + 1 < SEQ / C) SC_PREP_B(c + 1);
            SC_BARRIER();
            if (wid >= 4) {
                const int ibb = wid - 4;
                const bf16x8 af = *(const bf16x8*)(lb + O_UV + (c & 1) * 5120 + (16 * ibb + fr) * 80 + fq * 16), bf_ = *(const bf16x8*)(lb + O_BRKR + (c & 1) * 1280 + fr * 80 + fq * 16);
                hacc = __builtin_amdgcn_mfma_f32_16x16x32_bf16(af, bf_, hacc, 0, 0, 0);
                *(f32x4*)(lb + O_Y + (c & 1) * (C * 64 * 4) + fr * 256 + (16 * ibb + 4 * fq) * 4) = hacc;
            }
            {
                const bf16x8 af = *(const bf16x8*)(lb + O_UV + (c & 1) * 5120 + (16 * ib + fr) * 80 + fq * 16);
#pragma unroll
                for (int q = 0; q < 2; ++q) {
                    const int j = 16 * (jb0 + q) + fr;
                    const bf16x8 bf_ = *(const bf16x8*)(lb + O_BK + (c & 1) * 5120 + j * 80 + fq * 16);
                    sacc[q] = __builtin_amdgcn_mfma_f32_16x16x32_bf16(af, bf_, sacc[q], 0, 0, 0);
                    const float pc = *(const float*)(lb + O_PC + (c & 1) * 256 + j * 4);
                    sacc[q] *= pc;
#pragma unroll
                    for (int r = 0; r < 4; ++r) *(bf16_t*)(lb + O_SB + (16 * ib + 4 * fq + r) * 144 + j * 2) = f2bf(sacc[q][r]);
                }
            }
            if (c + 1 < SEQ / C) SC_P1(c + 1);
            if (c + 2 < SEQ / C) SC_COMMIT(c + 2, cc);
            if (c + 4 < SEQ / C) SC_ISSUE(c + 4, cc);
            SC_BARRIER();
        }
        }
        SC_FLUSH(SEQ / C - 1);
#undef SC_ISSUE
#undef SC_COMMIT
#undef SC_FLUSH
#undef SC_P0
#undef SC_BARRIER
#undef SC_PREP
#undef SC_P1
    }
    __syncthreads();
}

__device__ __forceinline__ void phase_post(const int tid, const int bid, const Params& P, unsigned char* ws, int l) {
    const bf16_t* Y = (const bf16_t*)(ws + OFF_Y); const bf16_t* RKV = (const bf16_t*)(ws + OFF_B); const bf16_t* HL = (const bf16_t*)(ws + OFF_HL);
    const bf16_t* AO = (const bf16_t*)(ws + OFF_AO); const float* LSE = (const float*)(ws + OFF_LSE); bf16_t* O = (bf16_t*)(ws + OFF_O);
    const float* gg = P.gn_g + (size_t)l * 1024; const float* gb = P.gn_b + (size_t)l * 1024; const float* rk = P.r_k + (size_t)l * 1024;
    const size_t gtid = (size_t)bid * 512 + tid, gsz = (size_t)gridDim.x * 512;
    constexpr int PB = 8;
    for (size_t u0 = gtid; u0 < (size_t)T_TOK * 256; u0 += PB * gsz) {
        u32x2 ya[PB], yb[PB]; u32x2 rw[PB], kw[PB], vw[PB], zw[PB];
#pragma unroll
        for (int k = 0; k < PB; ++k) { size_t u = u0 + k * gsz; if (u >= (size_t)T_TOK * 256) u = u0;
            const size_t tok = u >> 8; const int c = (int)(u & 255) * 4;
            const size_t hm = ((size_t)((tok >> 11) * 16 + (c >> 6)) * SEQ + (tok & 2047)) * 64 + (c & 63);
            ya[k] = *(const u32x2*)(Y + hm); yb[k] = *(const u32x2*)(Y + (size_t)T_TOK * 1024 + hm);
            rw[k] = *(const u32x2*)(RKV + hm); kw[k] = *(const u32x2*)(RKV + (size_t)T_TOK * 1024 + hm); vw[k] = *(const u32x2*)(RKV + (size_t)2 * T_TOK * 1024 + hm);
            zw[k] = *(const u32x2*)(HL + tok * NL + L_ZA + c); }
        __builtin_amdgcn_sched_barrier(0);
#pragma unroll
        for (int k = 0; k < PB; ++k) { const size_t u = u0 + k * gsz; if (u < (size_t)T_TOK * 256) {
            const size_t tok = u >> 8; const int c = (int)(u & 255) * 4;
            const f32x4 y = {bflo(ya[k].x) + bflo(yb[k].x), bfhi(ya[k].x) + bfhi(yb[k].x), bflo(ya[k].y) + bflo(yb[k].y), bfhi(ya[k].y) + bfhi(yb[k].y)};
            const f32x4 rkv = *(const f32x4*)(rk + c);
            const float r4[4] = {bflo(rw[k].x), bfhi(rw[k].x), bflo(rw[k].y), bfhi(rw[k].y)}, k4[4] = {bflo(kw[k].x), bfhi(kw[k].x), bflo(kw[k].y), bfhi(kw[k].y)}, v4[4] = {bflo(vw[k].x), bfhi(vw[k].x), bflo(vw[k].y), bfhi(vw[k].y)};
            float s1 = y[0] + y[1] + y[2] + y[3], bd = r4[0] * k4[0] * rkv[0] + r4[1] * k4[1] * rkv[1] + r4[2] * k4[2] * rkv[2] + r4[3] * k4[3] * rkv[3];
            s1 += dppf<DPP_QP1>(s1); bd += dppf<DPP_QP1>(bd); s1 += dppf<DPP_QP2>(s1); bd += dppf<DPP_QP2>(bd);
            s1 += dppf<DPP_ROR4>(s1); bd += dppf<DPP_ROR4>(bd); s1 += dppf<DPP_ROR8>(s1); bd += dppf<DPP_ROR8>(bd);
            const float mean = s1 * (1.f / 64.f);
            float s2 = 0.f;
#pragma unroll
            for (int j = 0; j < 4; ++j) { const float d = y[j] - mean; s2 += d * d; }
            s2 += dppf<DPP_QP1>(s2); s2 += dppf<DPP_QP2>(s2); s2 += dppf<DPP_ROR4>(s2); s2 += dppf<DPP_ROR8>(s2);
            const float rstd = rsqrtf(s2 * (1.f / 64.f) + 64e-5f);
            const f32x4 g4 = *(const f32x4*)(gg + c), b4 = *(const f32x4*)(gb + c);
            const float z4[4] = {bflo(zw[k].x), bfhi(zw[k].x), bflo(zw[k].y), bfhi(zw[k].y)};
            float o[4];
#pragma unroll
            for (int j = 0; j < 4; ++j) o[j] = ((y[j] - mean) * rstd * g4[j] + b4[j] + bd * v4[j]) * siluf_(z4[j]);
            u32x2 w; w.x = cvt_pk_bf16(o[0], o[1]); w.y = cvt_pk_bf16(o[2], o[3]);
            *(u32x2*)(O + tok * 2048 + c) = w; } }
    }
    for (size_t u0 = gtid; u0 < (size_t)T_TOK * 64; u0 += PB * gsz) {
        float l0[PB], l1[PB], l2[PB]; u32x2 a0[PB], a1[PB], a2[PB], zc[PB];
#pragma unroll
        for (int k = 0; k < PB; ++k) { size_t u = u0 + k * gsz; if (u >= (size_t)T_TOK * 64) u = u0;
            const size_t tok = u >> 6; const int r = (int)(u & 63), hs = r >> 4, d4 = (r & 15) * 4;
            l0[k] = LSE[tok * 12 + hs]; l1[k] = LSE[tok * 12 + 4 + hs]; l2[k] = LSE[tok * 12 + 8 + hs];
            a0[k] = *(const u32x2*)(AO + tok * 768 + hs * 64 + d4); a1[k] = *(const u32x2*)(AO + tok * 768 + (4 + hs) * 64 + d4); a2[k] = *(const u32x2*)(AO + tok * 768 + (8 + hs) * 64 + d4);
            zc[k] = *(const u32x2*)(HL + tok * NL + L_ZC + hs * 64 + d4); }
        __builtin_amdgcn_sched_barrier(0);
#pragma unroll
        for (int k = 0; k < PB; ++k) { const size_t u = u0 + k * gsz; if (u < (size_t)T_TOK * 64) {
            const size_t tok = u >> 6; const int r = (int)(u & 63), hs = r >> 4, d4 = (r & 15) * 4;
            const float lm = fmaxf(l0[k], fmaxf(l1[k], l2[k])); const float e0 = __expf(l0[k] - lm), e1 = __expf(l1[k] - lm), e2 = __expf(l2[k] - lm); const float inv = __builtin_amdgcn_rcpf(e0 + e1 + e2);
            float o[4];
            o[0] = (e0 * bflo(a0[k].x) + e1 * bflo(a1[k].x) + e2 * bflo(a2[k].x)) * inv * siluf_(bflo(zc[k].x));
            o[1] = (e0 * bfhi(a0[k].x) + e1 * bfhi(a1[k].x) + e2 * bfhi(a2[k].x)) * inv * siluf_(bfhi(zc[k].x));
            o[2] = (e0 * bflo(a0[k].y) + e1 * bflo(a1[k].y) + e2 * bflo(a2[k].y)) * inv * siluf_(bflo(zc[k].y));
            o[3] = (e0 * bfhi(a0[k].y) + e1 * bfhi(a1[k].y) + e2 * bfhi(a2[k].y)) * inv * siluf_(bfhi(zc[k].y));
            u32x2 w; w.x = cvt_pk_bf16(o[0], o[1]); w.y = cvt_pk_bf16(o[2], o[3]);
            *(u32x2*)(O + tok * 2048 + 1792 + hs * 64 + d4) = w; } }
    }
}

__device__ __forceinline__ void phase_ln(const int tid, const int bid, const Params& P, unsigned char* ws, int l) {
    const float* PRE = (const float*)(ws + OFF_A); bf16_t* XB = (bf16_t*)(ws + OFF_XB);
    const float* g = P.ln_g + (size_t)l * 1024; const float* bb = P.ln_b + (size_t)l * 1024;
    const int lane = tid & 63, wid = tid >> 6;
    constexpr int LR = 8;
    for (int row0 = (bid * 8 + wid) * LR; row0 < T_TOK; row0 += gridDim.x * 8 * LR) {
        f32x4 v[LR][4]; float s[LR], s2[LR], mean[LR], rstd[LR];
#pragma unroll
        for (int q = 0; q < LR; ++q) { const float* pr = PRE + (size_t)(row0 + q) * 1024;
#pragma unroll
            for (int i = 0; i < 4; ++i) v[q][i] = *(const f32x4*)(pr + i * 256 + lane * 4); }
        __builtin_amdgcn_sched_barrier(0);
#pragma unroll
        for (int q = 0; q < LR; ++q) { s[q] = 0.f;
#pragma unroll
            for (int i = 0; i < 4; ++i) s[q] += v[q][i][0] + v[q][i][1] + v[q][i][2] + v[q][i][3]; }
#pragma unroll
        for (int q = 0; q < LR; ++q) { float t = s[q]; t += dppf<DPP_QP1>(t); t += dppf<DPP_QP2>(t); t += dppf<DPP_ROR4>(t); t += dppf<DPP_ROR8>(t); t += bperm(t, lane ^ 16); t += bperm(t, lane ^ 32); mean[q] = t * (1.f / 1024.f); }
#pragma unroll
        for (int q = 0; q < LR; ++q) { float t = 0.f;
#pragma unroll
            for (int i = 0; i < 4; ++i)
#pragma unroll
                for (int j = 0; j < 4; ++j) { const float d = v[q][i][j] - mean[q]; t += d * d; }
            s2[q] = t; }
#pragma unroll
        for (int q = 0; q < LR; ++q) { float t = s2[q]; t += dppf<DPP_QP1>(t); t += dppf<DPP_QP2>(t); t += dppf<DPP_ROR4>(t); t += dppf<DPP_ROR8>(t); t += bperm(t, lane ^ 16); t += bperm(t, lane ^ 32); rstd[q] = rsqrtf(t * (1.f / 1024.f) + 1e-5f); }
#pragma unroll
        for (int q = 0; q < LR; ++q)
#pragma unroll
            for (int i = 0; i < 4; ++i) { const int c = i * 256 + lane * 4; const f32x4 g4 = *(const f32x4*)(g + c), b4 = *(const f32x4*)(bb + c);
                f32x4 o; for (int j = 0; j < 4; ++j) o[j] = (v[q][i][j] - mean[q]) * rstd[q] * g4[j] + b4[j];
                *(f32x4*)(P.out + (size_t)(row0 + q) * 1024 + c) = o;
                u32x2 w; w.x = cvt_pk_bf16(o[0], o[1]); w.y = cvt_pk_bf16(o[2], o[3]); *(u32x2*)(XB + (size_t)(row0 + q) * 1024 + c) = w; }
    }
}

#define XB_TMO      128
#define XB_XCNT(j)  (256  + 64 * (j))
#define XB_XSUB(j)  (1280 + 64 * (j))
#define XB_XGEN(j)  (2304 + 64 * (j))
#define XB_TOP      3328
#define XB_TOPGEN   3392
#define XCD_BAR_WORDS 3456
#define XB_SPIN_CAP (1u << 20)
__device__ __forceinline__ unsigned xb_ld(unsigned* p)              { return __hip_atomic_load(p, __ATOMIC_RELAXED, __HIP_MEMORY_SCOPE_AGENT); }
__device__ __forceinline__ unsigned xb_add(unsigned* p, unsigned v) { return __hip_atomic_fetch_add(p, v, __ATOMIC_RELAXED, __HIP_MEMORY_SCOPE_AGENT); }
__device__ __forceinline__ unsigned xb_xcc_id() { return (unsigned)__builtin_amdgcn_s_getreg((3 << 11) | 20) & 0xFu; }
#define XB_SPIN(cond, bar) do { unsigned _sp = 0; while (cond) { __builtin_amdgcn_s_sleep(1); \
    if ((++_sp & 255u) == 0u) { if (xb_ld(&(bar)[XB_TMO])) break; if (_sp > XB_SPIN_CAP) { atomicAdd(&(bar)[XB_TMO], 1u); break; } } } } while (0)
struct XcdBarrier { unsigned* bar; unsigned x; volatile LAS unsigned* st; };
__device__ __forceinline__ XcdBarrier xcd_barrier_post(unsigned* bar, volatile LAS unsigned* st) {
    XcdBarrier b; b.bar = bar; b.x = xb_xcc_id(); b.st = st;
    if (threadIdx.x == 0) (void)xb_add(&bar[XB_XCNT(b.x)], 1u);
    return b;
}
__device__ __forceinline__ void xcd_barrier_complete(unsigned* bar, unsigned x, unsigned& nloc, unsigned& nx) {
    const unsigned G = gridDim.x * gridDim.y * gridDim.z;
    unsigned sum, cnt, mine, sp = 0u;
    for (;;) {
        sum = 0u; cnt = 0u; mine = 0u;
#pragma unroll
        for (unsigned j = 0; j < 16; ++j) { const unsigned c = xb_ld(&bar[XB_XCNT(j)]); sum += c; cnt += (c > 0u) ? 1u : 0u; mine = (j == x) ? c : mine; }
        if (sum == G) break;
        __builtin_amdgcn_s_sleep(1);
        if ((++sp & 255u) == 0u) { if (xb_ld(&bar[XB_TMO])) break; if (sp > XB_SPIN_CAP) { atomicAdd(&bar[XB_TMO], 1u); break; } }
    }
    nloc = mine > 0u ? mine : 1u; nx = cnt > 0u ? cnt : 1u;
}
__device__ __forceinline__ void xcd_barrier(const XcdBarrier& b) {
    asm volatile("s_waitcnt vmcnt(0)" ::: "memory");
    __syncthreads();
    if (threadIdx.x == 0) {
        unsigned* bar = b.bar;
        __builtin_amdgcn_s_waitcnt(0);
        unsigned nloc = b.st[0], nx = b.st[1];
        if (nloc == 0u) { xcd_barrier_complete(bar, b.x, nloc, nx); b.st[0] = nloc; b.st[1] = nx; }
        const unsigned old = xb_add(&bar[XB_XSUB(b.x)], 1u);
        const unsigned gen = old / nloc;
        if (old + 1u == (gen + 1u) * nloc) {
            __builtin_amdgcn_fence(__ATOMIC_RELEASE, "agent");
            asm volatile("s_waitcnt vmcnt(0)" ::: "memory");
            const unsigned og = xb_add(&bar[XB_TOP], 1u);
            const unsigned tg = og / nx;
            if (og + 1u == (tg + 1u) * nx) xb_add(&bar[XB_TOPGEN], 1u);
            else XB_SPIN(xb_ld(&bar[XB_TOPGEN]) == tg, bar);
            __builtin_amdgcn_fence(__ATOMIC_ACQUIRE, "agent");
            xb_add(&bar[XB_XGEN(b.x)], 1u);
            asm volatile("s_waitcnt vmcnt(0)" ::: "memory");
        } else {
            XB_SPIN(xb_ld(&bar[XB_XGEN(b.x)]) == gen, bar);
            __builtin_amdgcn_fence(__ATOMIC_ACQUIRE, "agent");
            asm volatile("s_waitcnt vmcnt(0)" ::: "memory");
        }
    }
    __syncthreads();
}

constexpr int PER = 8;
constexpr int N_PH = 1 + PER * DEPTH;
__global__ void __launch_bounds__(512, 2) fwd_kernel(Params P) {
    extern __shared__ __attribute__((aligned(16))) unsigned char shm[];
    LAS unsigned char* lds = (LAS unsigned char*)shm; float* ldsf = (float*)shm;
    const int G = (int)gridDim.x;
#if !MK_MULTI
    volatile LAS unsigned* xst = (volatile LAS unsigned*)(lds + 131072);
    if (threadIdx.x == 0) { xst[0] = 0u; xst[1] = 0u; }
    __syncthreads();
    const XcdBarrier xb = xcd_barrier_post((unsigned*)(P.ws + OFF_BAR), xst);
#endif
    for (int ph = P.ph_lo; ph < P.ph_hi; ++ph) {
        int tid = threadIdx.x; asm volatile("" : "+v"(tid));
        int c = blockIdx.x; asm volatile("" : "+s"(c));
        size_t wz = 0; asm volatile("" : "+s"(wz)); const Params& PP = *(const Params*)((const char*)&P + wz); unsigned char* ws = PP.ws;
        if (ph == 0) { phase_prepass(tid, c, PP, ws, ldsf); }
        else {
            const int l = (ph - 1) / PER, slot = (ph - 1) % PER, k = slot < 4 ? slot : slot + 1;
            const int rep = 0;
            switch (k) {
            case 0: {
                pg8::Gemm g{(const bf16_t*)(ws + OFF_XB), (const bf16_t*)(ws + OFF_WIN), T_TOK, NE, 1024};
                pg8::StaticOrder S; S.init(T_TOK, NE, 1024, G, c);
                pg8::EpiBias E{(bf16_t*)(ws + OFF_A), NE, (const float*)(ws + OFF_BIASP)};
                pg8::gemm_phase(tid, lds, g, S, E); } break;
            case 1: phase_prep(tid, c, PP, ws, l, ldsf, rep == 0); break;
            case 2: {
                if (!rep || MK_SUB < 0 || MK_SUB == 0) { pg8::Gemm g{(const bf16_t*)(ws + OFF_LIN), (const bf16_t*)(ws + OFF_LORA), T_TOK, 4096, 256};
                  pg8::StaticOrder S; S.init(T_TOK, 4096, 256, G, c);
                  pg8::EpiLora E{(bf16_t*)(ws + OFF_C), PP.w0 + (size_t)l * 2048, PP.a0 + (size_t)l * 2048};
                  pg8::gemm_phase(tid, lds, g, S, E); }
                {
                  pg8::Gemm g{(const bf16_t*)(ws + OFF_XB), (const bf16_t*)(ws + OFF_WIN) + (size_t)NE * 1024, T_TOK, NL, 1024};
                  pg8::StaticOrder S; S.init(T_TOK, NL, 1024, G, c);
                  pg8::EpiBias E{(bf16_t*)(ws + OFF_HL), NL, (const float*)(ws + OFF_BIASP) + NE};
                  pg8::gemm_phase(tid, lds, g, S, E); }
                if (!rep || MK_SUB < 0 || MK_SUB == 1) { pg8::Gemm g{(const bf16_t*)(ws + OFF_MIX), (const bf16_t*)(ws + OFF_POOLW), T_TOK, 768, 768};
                  pg8::StaticOrder S; S.init(T_TOK, 768, 768, G, G - 1 - c);
                  pg8::EpiPool E{(bf16_t*)(ws + OFF_O), (const bf16_t*)(ws + OFF_A), PP.pool_b + (size_t)l * 768, PP.pool_scale + (size_t)l * 768};
                  pg8::gemm_phase(tid, lds, g, S, E); }
                if (!rep || MK_SUB < 0 || MK_SUB == 2) { const int lane = tid & 63, wid = tid >> 6;
                  for (int item = c * 8 + wid; item < NB * 12 * 128; item += G * 8)
                      attn_item((const bf16_t*)(ws + OFF_QKH), (const bf16_t*)(ws + OFF_VT), (bf16_t*)(ws + OFF_AO), (float*)(ws + OFF_LSE), item, lane); }
                } break;
            case 3: phase_scan(tid, c, PP, ws, l, ldsf); break;
            case 5: phase_post(tid, c, PP, ws, l); break;
            case 6: {
                pg8::Gemm g{(const bf16_t*)(ws + OFF_O), (const bf16_t*)(ws + OFF_PROJ), T_TOK, 1024, 2048};
                pg8::MergeOrder S; S.init(G, c);
                pg8::EpiMerge E{(bf16_t*)(ws + OFF_D), (const bf16_t*)(ws + OFF_HL)};
                pg8::gemm_phase<pg8::EpiMerge, pg8::MergeOrder, true>(tid, lds, g, S, E); } break;
            case 7: {
                pg8::Gemm g{(const bf16_t*)(ws + OFF_D), (const bf16_t*)(ws + OFF_WOUT), T_TOK, 1024, 1024};
                pg8::StaticOrder S; S.init(T_TOK, 1024, 1024, G, c);
                pg8::EpiOut E{(float*)(ws + OFF_A), l == 0 ? PP.x : (const float*)PP.out, 1.681792830507429f};
                pg8::gemm_phase(tid, lds, g, S, E); } break;
            case 8: phase_ln(tid, c, PP, ws, l); if (l + 1 < DEPTH) convert_weights(tid, c, PP, ws, l + 1, ldsf); break;
            }
        }
#if !MK_MULTI
        if (ph + 1 < P.ph_hi) { if (ph == 0) cg::this_grid().sync(); else xcd_barrier(xb); }
#endif
    }
}

extern "C" void kernel_launch(void* const* d_in, const int* in_sizes, int n_in, void* d_out, int out_size, void* d_ws, size_t ws_size, hipStream_t stream) {
    constexpr size_t kDynLds = 131072 + 64;
    static int grid_blocks = 0;
    if (!grid_blocks) {
        hipFuncSetAttribute((const void*)fwd_kernel, hipFuncAttributeMaxDynamicSharedMemorySize, (int)kDynLds);
        int dev = 0, cus = 0, per_cu = 0;
        hipGetDevice(&dev);
        hipDeviceGetAttribute(&cus, hipDeviceAttributeMultiprocessorCount, dev);
        hipOccupancyMaxActiveBlocksPerMultiprocessor(&per_cu, fwd_kernel, 512, kDynLds);
        if (per_cu < 1) per_cu = 1;
        grid_blocks = cus * per_cu;
        if (grid_blocks > 256) grid_blocks = 256;
        if (ws_size < WS_TOTAL) fprintf(stderr, "workspace too small: %zu < %zu\n", ws_size, (size_t)WS_TOTAL);
    }
    Params p{};
    p.x = (const float*)d_in[0]; p.w_in = (const float*)d_in[1]; p.b_in = (const float*)d_in[2]; p.mu = (const float*)d_in[3]; p.w0 = (const float*)d_in[4];
    p.w_up = (const float*)d_in[5]; p.a0 = (const float*)d_in[6]; p.a_up = (const float*)d_in[7]; p.k_k = (const float*)d_in[8]; p.k_a = (const float*)d_in[9];
    p.r_k = (const float*)d_in[10]; p.gn_g = (const float*)d_in[11]; p.gn_b = (const float*)d_in[12]; p.pool_w = (const float*)d_in[13]; p.pool_b = (const float*)d_in[14];
    p.pool_scale = (const float*)d_in[15]; p.proj_a = (const float*)d_in[16]; p.proj_b = (const float*)d_in[17]; p.proj_c = (const float*)d_in[18]; p.w_out = (const float*)d_in[19];
    p.ln_g = (const float*)d_in[20]; p.ln_b = (const float*)d_in[21];
    p.out = (float*)d_out; p.ws = (unsigned char*)d_ws;
#if MK_MULTI
    for (int ph = 0; ph < N_PH; ++ph) { p.ph_lo = ph; p.ph_hi = ph + 1;
        hipLaunchKernelGGL(fwd_kernel, dim3(grid_blocks), dim3(512), kDynLds, stream, p); }
#else
    p.ph_lo = 0; p.ph_hi = N_PH;
    hipMemsetAsync((unsigned char*)d_ws + OFF_BAR, 0, 16384, stream);
    void* args[] = {&p};
    hipError_t e = hipLaunchCooperativeKernel((void*)fwd_kernel, dim3(grid_blocks), dim3(512), args, kDynLds, stream);
    if (e != hipSuccess) fprintf(stderr, "cooperative launch failed: %s (grid %d)\n", hipGetErrorString(e), grid_blocks);
#endif
}
```

```cpp
#include <hip/hip_runtime.h>
#include <hip/hip_cooperative_groups.h>
#include <cstdio>
namespace cg = cooperative_groups;

#ifndef MK_REP
#define MK_REP -1
#endif
#ifndef MK_SUB
#define MK_SUB -1
#endif
#ifndef MK_MULTI
#define MK_MULTI 0
#endif

typedef unsigned short bf16_t;
typedef short bf16x8 __attribute__((ext_vector_type(8)));
typedef short bf16x4 __attribute__((ext_vector_type(4)));
typedef float f32x4 __attribute__((ext_vector_type(4)));
typedef unsigned u32x4 __attribute__((ext_vector_type(4)));
typedef unsigned u32x2 __attribute__((ext_vector_type(2)));
typedef float f32x2 __attribute__((ext_vector_type(2)));
#define LAS __attribute__((address_space(3)))

constexpr int T_TOK = 16384, SEQ = 2048, NB = 8, DM = 1024, DEPTH = 4;
constexpr int NE = 7168, NL = 4352, NIN = 11520;
constexpr int E_PB = 3328, E_Q = 4096, E_K = 4864, E_V = 5632, E_ZB = 6400;
constexpr int L_ZA = 0, L_ZC = 1024, L_GA = 1280;

constexpr size_t OFF_WIN = 0;
constexpr size_t OFF_LORA = OFF_WIN + (size_t)NIN * 1024 * 2;
constexpr size_t OFF_POOLW = OFF_LORA + (size_t)4096 * 256 * 2;
constexpr size_t OFF_PROJ = OFF_POOLW + (size_t)768 * 768 * 2;
constexpr size_t OFF_WOUT = OFF_PROJ + (size_t)1024 * 2048 * 2;
constexpr size_t OFF_BIASP = OFF_WOUT + (size_t)1024 * 1024 * 2;
constexpr size_t OFF_ROPE = OFF_BIASP + (size_t)NIN * 4;
constexpr size_t OFF_XB = OFF_ROPE + (size_t)SEQ * 64 * 4;
constexpr size_t OFF_A = OFF_XB + (size_t)T_TOK * 1024 * 2;
constexpr size_t OFF_HL = OFF_A;
constexpr size_t OFF_Y = OFF_A + (size_t)T_TOK * NL * 2;
constexpr size_t OFF_B = OFF_A + (size_t)T_TOK * NE * 2;
constexpr size_t OFF_RN = OFF_B + (size_t)T_TOK * 3072 * 2;
constexpr size_t OFF_C = OFF_RN + (size_t)T_TOK * 16 * 4;
constexpr size_t OFF_D = OFF_C + (size_t)T_TOK * NL * 2;
constexpr size_t OFF_LIN = OFF_D;
constexpr size_t OFF_MIX = OFF_LIN + (size_t)T_TOK * 256 * 2;
constexpr size_t OFF_VT = OFF_MIX + (size_t)T_TOK * 768 * 2;
constexpr size_t OFF_AO = OFF_VT + (size_t)T_TOK * 768 * 2;
constexpr size_t OFF_LSE = OFF_AO + (size_t)T_TOK * 768 * 2;
constexpr size_t OFF_O = OFF_LSE + (size_t)T_TOK * 12 * 4;
constexpr size_t OFF_QKH = OFF_O + (size_t)T_TOK * 2048 * 2;
constexpr size_t OFF_BAR = OFF_QKH + (size_t)T_TOK * 1536 * 2;
constexpr size_t WS_TOTAL = OFF_BAR + 16384;

struct Params {
    const float* x; const float* w_in; const float* b_in; const float* mu; const float* w0; const float* w_up; const float* a0; const float* a_up;
    const float* k_k; const float* k_a; const float* r_k; const float* gn_g; const float* gn_b; const float* pool_w; const float* pool_b; const float* pool_scale;
    const float* proj_a; const float* proj_b; const float* proj_c; const float* w_out; const float* ln_g; const float* ln_b;
    float* out; unsigned char* ws; int ph_lo, ph_hi;
};

__device__ __forceinline__ float bf2f(bf16_t v) { return __uint_as_float(((unsigned)v) << 16); }
__device__ __forceinline__ float bflo(unsigned w) { return __uint_as_float(w << 16); }
__device__ __forceinline__ float bfhi(unsigned w) { return __uint_as_float(w & 0xffff0000u); }
__device__ __forceinline__ unsigned cvt_pk_bf16(float lo, float hi) { unsigned r; asm volatile("v_cvt_pk_bf16_f32 %0, %1, %2" : "=v"(r) : "v"(lo), "v"(hi)); return r; }
__device__ __forceinline__ bf16_t f2bf(float f) { return (bf16_t)(cvt_pk_bf16(f, 0.f) & 0xffffu); }
__device__ __forceinline__ float sigmoidf_(float v) { return __builtin_amdgcn_rcpf(1.0f + __expf(-v)); }
__device__ __forceinline__ float siluf_(float v) { return v * __builtin_amdgcn_rcpf(1.0f + __expf(-v)); }
__device__ __forceinline__ float bperm(float v, int srclane) { return __builtin_bit_cast(float, __builtin_amdgcn_ds_bpermute(srclane << 2, __builtin_bit_cast(int, v))); }
constexpr int DPP_QP1 = 0xB1, DPP_QP2 = 0x4E, DPP_ROR4 = 0x124, DPP_ROR8 = 0x128;
template <int CTRL> __device__ __forceinline__ float dppf(float v) {
    return __builtin_bit_cast(float, __builtin_amdgcn_update_dpp(0, __builtin_bit_cast(int, v), CTRL, 0xf, 0xf, true));
}
__device__ __forceinline__ void unpack8(u32x4 w, float* f) {
    f[0] = bflo(w.x); f[1] = bfhi(w.x); f[2] = bflo(w.y); f[3] = bfhi(w.y); f[4] = bflo(w.z); f[5] = bfhi(w.z); f[6] = bflo(w.w); f[7] = bfhi(w.w);
}
__device__ __forceinline__ u32x4 pack8(const float* f) {
    u32x4 w; w.x = cvt_pk_bf16(f[0], f[1]); w.y = cvt_pk_bf16(f[2], f[3]); w.z = cvt_pk_bf16(f[4], f[5]); w.w = cvt_pk_bf16(f[6], f[7]); return w;
}

namespace pg8 {
constexpr int BM = 256, BK = 64, HALF = 128, HTB = HALF * BK * 2, STAGE_BYTES = 8 * HTB, NXCD = 8, WGM = 8;
__device__ __forceinline__ int lds_byte(int r, int c) { const int st = (r >> 4) * 2 + (c >> 5), rr = r & 15, cc = c & 31, ob = rr * 64 + cc * 2; return st * 1024 + (ob ^ (((ob >> 9) & 1) << 5)); }
__device__ __forceinline__ void stage_rc(int b, int& R, int& C) { const int st = b / 1024, sb = b % 1024, swz = sb ^ (((sb >> 9) & 1) << 5); R = (st >> 1) * 16 + swz / 64; C = (st & 1) * 32 + (swz % 64) / 2; }
__device__ __forceinline__ int perm32(int rho) { const int n = rho >> 4, i = rho & 15; return 8 * (i >> 2) + 4 * n + (i & 3); }

struct Unit { int pm, pn, koff, nt, tag; };
struct Gemm { const bf16_t* A; const bf16_t* Bt; int M, N, ld; };

struct StaticOrder {
    int nM, nN, nwg, G, c, nt;
    __device__ void init(int M, int N, int K, int G_, int c_) { nM = M / BM; nN = N / BM; nwg = nM * nN; G = G_; c = c_; nt = K / BK; }
    __device__ bool next(int i, Unit& u) const {
        const long L = (long)i * G + c; if (L >= nwg) return false;
        int wgid = (int)L; { const int q = nwg / NXCD, r = nwg % NXCD, xcd = wgid % NXCD, off = wgid / NXCD; wgid = (xcd < r ? xcd * (q + 1) : r * (q + 1) + (xcd - r) * q) + off; }
        const int nig = WGM * nN, gid = wgid / nig, fm = gid * WGM, gsz = (nM - fm) < WGM ? (nM - fm) : WGM;
        u.pm = fm + ((wgid % nig) % gsz); u.pn = (wgid % nig) / gsz; u.koff = 0; u.nt = nt; u.tag = 0; return true;
    }
};
struct MergeOrder {
    int G, c;
    __device__ void init(int G_, int c_) { G = G_; c = c_; }
    __device__ bool next(int i, Unit& u) const {
        const int ti = i / 3, br = i - ti * 3; const int cx = (G == 256) ? ((c & 7) * 32 + (c >> 3)) : c;
        const long L = (long)ti * G + cx; if (L >= 512) return false;
        u.pm = (int)(L >> 2); u.pn = (int)(L & 3); u.tag = br;
        u.koff = br == 0 ? 0 : (br == 1 ? 1024 : 1792); u.nt = br == 0 ? 16 : (br == 1 ? 12 : 4); return true;
    }
};

template <class Epi, class Sched, bool HM = false>
__device__ __forceinline__ void gemm_phase(const int tid, LAS unsigned char* lds, const Gemm g, const Sched& S, const Epi& E) {
    const int wid = __builtin_amdgcn_readfirstlane(tid >> 6), lane = tid & 63, wr = wid >> 2, wc = wid & 3, fr = lane & 15, fq = lane >> 4;
    const int K = g.ld;
    unsigned voffA[2], voffB[2];
#pragma unroll
    for (int i = 0; i < 2; ++i) { int R, C; stage_rc(tid * 16 + i * 8192, R, C); const int Rb = Epi::PERM ? ((R & ~31) + perm32(R & 31)) : R;
        voffA[i] = (unsigned)(R * K + C) * 2u; voffB[i] = (unsigned)(Rb * K + C) * 2u; }
    const size_t kstep = (size_t)(BK * 2);
    const size_t hstep = (size_t)HALF * K * 2;
    const size_t tstep = 2 * hstep;
    const size_t astep = HM ? hstep : tstep;
    const size_t h1 = HM ? 0 : hstep;
    const unsigned ldsw = (unsigned)wid * 1024u;
    const int aoff = lds_byte(wr * 64 + fr, fq * 8), boff = lds_byte(wc * 32 + fr, fq * 8);
#define PG8_SA(b, h) (((b) * 2 + (h)) * HTB)
#define PG8_SB(b, h) ((4 + (b) * 2 + (h)) * HTB)
#define PG8_STAGE(bufoff, gbase, voff) do { _Pragma("unroll") for (int _i = 0; _i < 2; ++_i) \
        __builtin_amdgcn_global_load_lds((const unsigned*)((const char*)(gbase) + (voff)[_i]), (LAS unsigned*)(lds + (bufoff) + ldsw + _i * 8192), 16, 0, 0); } while (0)
#define PG8_LDA(dst, b, h) do { _Pragma("unroll") for (int m = 0; m < 4; ++m) _Pragma("unroll") for (int k = 0; k < 2; ++k) dst[m][k] = *(const LAS bf16x8*)(lds + PG8_SA(b, h) + aoff + m * 2048 + k * 1024); } while (0)
#define PG8_LDB(dst, b, h) do { _Pragma("unroll") for (int n = 0; n < 2; ++n) _Pragma("unroll") for (int k = 0; k < 2; ++k) dst[n][k] = *(const LAS bf16x8*)(lds + PG8_SB(b, h) + boff + n * 2048 + k * 1024); } while (0)
#define PG8_MMA(ai, bj, At, Bt) do { __builtin_amdgcn_s_setprio(1); _Pragma("unroll") for (int m = 0; m < 4; ++m) _Pragma("unroll") for (int n = 0; n < 2; ++n) _Pragma("unroll") for (int k = 0; k < 2; ++k) \
        acc[ai][bj][m][n] = __builtin_amdgcn_mfma_f32_16x16x32_bf16(Bt[n][k], At[m][k], acc[ai][bj][m][n], 0, 0, 0); __builtin_amdgcn_s_setprio(0); } while (0)
#define PG8_WAIT_V(n) asm volatile("s_waitcnt vmcnt(" #n ")" ::: "memory")
#define PG8_WAIT_L(n) asm volatile("s_waitcnt lgkmcnt(" #n ")" ::: "memory")
#define PG8_BAR __builtin_amdgcn_s_barrier()
#define PG8_SCHED __builtin_amdgcn_sched_barrier(0)
    Unit cur, nxt; int ui = 0;
    if (!S.next(0, cur)) return;
    f32x4 acc[2][2][4][2];
#pragma unroll
    for (int a = 0; a < 2; ++a)
#pragma unroll
        for (int b = 0; b < 2; ++b)
#pragma unroll
            for (int m = 0; m < 4; ++m)
#pragma unroll
                for (int n = 0; n < 2; ++n) acc[a][b][m][n] = (f32x4){0.f, 0.f, 0.f, 0.f};
    bf16x8 At[4][2], B0[2][2], B1[2][2];
    f32x4 tot[2][4][2];
    if constexpr (HM) {
#pragma unroll
        for (int b = 0; b < 2; ++b)
#pragma unroll
            for (int m = 0; m < 4; ++m)
#pragma unroll
                for (int n = 0; n < 2; ++n) tot[b][m][n] = (f32x4){0.f, 0.f, 0.f, 0.f}; }
    const char* cA = (const char*)g.A + (size_t)cur.pm * astep + (size_t)cur.koff * 2; const char* cB = (const char*)g.Bt + (size_t)cur.pn * tstep + (size_t)cur.koff * 2;
    PG8_STAGE(PG8_SB(0, 0), cB, voffB); PG8_STAGE(PG8_SA(0, 0), cA, voffA); PG8_STAGE(PG8_SB(0, 1), cB + hstep, voffB); PG8_STAGE(PG8_SA(0, 1), cA + h1, voffA);
    if (wr == 1) PG8_BAR;
    PG8_WAIT_V(4); PG8_BAR;
    PG8_STAGE(PG8_SB(1, 0), cB + kstep, voffB); PG8_STAGE(PG8_SA(1, 0), cA + kstep, voffA); PG8_STAGE(PG8_SB(1, 1), cB + hstep + kstep, voffB);
    PG8_WAIT_V(6); PG8_BAR;
    for (;;) {
        const bool has_next = S.next(ui + 1, nxt);
        const char* nA = has_next ? (const char*)g.A + (size_t)nxt.pm * astep + (size_t)nxt.koff * 2 : cA; const char* nB = has_next ? (const char*)g.Bt + (size_t)nxt.pn * tstep + (size_t)nxt.koff * 2 : cB;
        const int nt = cur.nt;
        for (int t = 0; t < nt; t += 2) {
            const bool last = (t == nt - 2);
            const char* a1 = cA + (size_t)(t + 1) * kstep;
            const char* a2 = last ? nA : cA + (size_t)(t + 2) * kstep; const char* b2 = last ? nB : cB + (size_t)(t + 2) * kstep;
            const char* a3 = a2 + kstep; const char* b3 = b2 + kstep;
            PG8_LDB(B0, 0, 0); PG8_SCHED; PG8_LDA(At, 0, 0); PG8_STAGE(PG8_SA(1, 1), a1 + h1, voffA);
            PG8_WAIT_L(8); PG8_BAR; PG8_WAIT_L(0); PG8_MMA(0, 0, At, B0); PG8_BAR; PG8_SCHED;
            PG8_LDB(B1, 0, 1); PG8_STAGE(PG8_SB(0, 0), b2, voffB);
            PG8_BAR; PG8_WAIT_L(0); PG8_MMA(0, 1, At, B1); PG8_BAR;
            if constexpr (!HM) PG8_LDA(At, 0, 1);
            PG8_STAGE(PG8_SA(0, 0), a2, voffA);
            PG8_BAR; PG8_WAIT_L(0); if constexpr (!HM) PG8_MMA(1, 0, At, B0); PG8_BAR; PG8_SCHED;
            PG8_STAGE(PG8_SB(0, 1), b2 + hstep, voffB);
            PG8_WAIT_V(6); PG8_BAR; if constexpr (!HM) PG8_MMA(1, 1, At, B1); PG8_BAR;
            PG8_LDB(B0, 1, 0); PG8_SCHED; PG8_LDA(At, 1, 0); PG8_STAGE(PG8_SA(0, 1), a2 + h1, voffA);
            PG8_WAIT_L(8); PG8_BAR; PG8_WAIT_L(0); PG8_MMA(0, 0, At, B0); PG8_BAR; PG8_SCHED;
            PG8_LDB(B1, 1, 1); PG8_STAGE(PG8_SB(1, 0), b3, voffB);
            PG8_BAR; PG8_WAIT_L(0); PG8_MMA(0, 1, At, B1); PG8_BAR;
            if constexpr (!HM) PG8_LDA(At, 1, 1);
            PG8_STAGE(PG8_SA(1, 0), a3, voffA);
            PG8_BAR; PG8_WAIT_L(0); if constexpr (!HM) PG8_MMA(1, 0, At, B0); PG8_BAR; PG8_SCHED;
            PG8_STAGE(PG8_SB(1, 1), b3 + hstep, voffB);
            PG8_WAIT_V(6); PG8_BAR; if constexpr (!HM) PG8_MMA(1, 1, At, B1); PG8_BAR;
        }
        if constexpr (HM) E(acc, tot, cur, wr, wc, fr, fq); else E(acc, cur, wr, wc, fr, fq);
        if (!has_next) break;
#pragma unroll
        for (int a = 0; a < 2; ++a)
#pragma unroll
            for (int b = 0; b < 2; ++b)
#pragma unroll
                for (int m = 0; m < 4; ++m)
#pragma unroll
                    for (int n = 0; n < 2; ++n) acc[a][b][m][n] = (f32x4){0.f, 0.f, 0.f, 0.f};
        cur = nxt; cA = nA; cB = nB; ++ui;
    }
    PG8_WAIT_V(0);
    if (wr == 0) PG8_BAR;
    PG8_BAR;
#undef PG8_SA
#undef PG8_SB
#undef PG8_STAGE
#undef PG8_LDA
#undef PG8_LDB
#undef PG8_MMA
#undef PG8_WAIT_V
#undef PG8_WAIT_L
#undef PG8_BAR
#undef PG8_SCHED
}

struct EpiBias {
    static constexpr bool PERM = true;
    bf16_t* O; int ldc; const float* bias;
    __device__ __forceinline__ void operator()(const f32x4 (&acc)[2][2][4][2], const Unit& u, int wr, int wc, int fr, int fq) const {
        const int row0 = u.pm * BM + wr * 64 + fr, col0 = u.pn * BM + wc * 32 + 8 * fq;
        f32x4 bv[2][2];
#pragma unroll
        for (int bj = 0; bj < 2; ++bj)
#pragma unroll
            for (int n = 0; n < 2; ++n) bv[bj][n] = *(const f32x4*)(bias + col0 + bj * HALF + 4 * n);
#pragma unroll
        for (int ai = 0; ai < 2; ++ai)
#pragma unroll
            for (int m = 0; m < 4; ++m) { bf16_t* rowp = O + (size_t)(row0 + ai * HALF + m * 16) * ldc + col0;
#pragma unroll
                for (int bj = 0; bj < 2; ++bj) { f32x4 v0 = acc[ai][bj][m][0] + bv[bj][0], v1 = acc[ai][bj][m][1] + bv[bj][1];
                    u32x4 w; w.x = cvt_pk_bf16(v0[0], v0[1]); w.y = cvt_pk_bf16(v0[2], v0[3]); w.z = cvt_pk_bf16(v1[0], v1[1]); w.w = cvt_pk_bf16(v1[2], v1[3]);
                    *(u32x4*)(rowp + bj * HALF) = w; } }
    }
};
struct EpiLora {
    static constexpr bool PERM = true;
    bf16_t* EA; const float* w0; const float* a0;
    __device__ __forceinline__ void operator()(const f32x4 (&acc)[2][2][4][2], const Unit& u, int wr, int wc, int fr, int fq) const {
        const int row0 = u.pm * BM + wr * 64 + fr, colt = u.pn * BM, seg = colt >> 10, col0 = (colt & 1023) + wc * 32 + 8 * fq;
        const float* bp = (seg < 2 ? w0 + seg * 1024 : a0 + (seg - 2) * 1024) + col0;
        const float sc = seg < 2 ? 0.60653065971f : 1.0f;
        bf16_t* base = EA + (size_t)seg * T_TOK * 1024;
        f32x4 bv[2][2];
#pragma unroll
        for (int bj = 0; bj < 2; ++bj)
#pragma unroll
            for (int n = 0; n < 2; ++n) bv[bj][n] = *(const f32x4*)(bp + bj * HALF + 4 * n);
#pragma unroll
        for (int ai = 0; ai < 2; ++ai)
#pragma unroll
            for (int m = 0; m < 4; ++m) { const int row = row0 + ai * HALF + m * 16;
#pragma unroll
                for (int bj = 0; bj < 2; ++bj) { f32x4 v0 = acc[ai][bj][m][0] + bv[bj][0], v1 = acc[ai][bj][m][1] + bv[bj][1];
#pragma unroll
                    for (int j = 0; j < 4; ++j) { v0[j] = sc * sigmoidf_(v0[j]); v1[j] = sc * sigmoidf_(v1[j]); }
                    u32x4 w; w.x = cvt_pk_bf16(v0[0], v0[1]); w.y = cvt_pk_bf16(v0[2], v0[3]); w.z = cvt_pk_bf16(v1[0], v1[1]); w.w = cvt_pk_bf16(v1[2], v1[3]);
                    const int cc = col0 + bj * HALF;
                    *(u32x4*)(base + ((size_t)((row >> 11) * 16 + (cc >> 6)) * SEQ + (row & 2047)) * 64 + (cc & 63)) = w; } }
    }
};
struct EpiPool {
    static constexpr bool PERM = true;
    bf16_t* O; const bf16_t* HE; const float* pb; const float* ps;
    __device__ __forceinline__ void operator()(const f32x4 (&acc)[2][2][4][2], const Unit& u, int wr, int wc, int fr, int fq) const {
        const int row0 = u.pm * BM + wr * 64 + fr, col0 = u.pn * BM + wc * 32 + 8 * fq;
        f32x4 bv[2][2], sv[2][2];
#pragma unroll
        for (int bj = 0; bj < 2; ++bj)
#pragma unroll
            for (int n = 0; n < 2; ++n) { bv[bj][n] = *(const f32x4*)(pb + col0 + bj * HALF + 4 * n); sv[bj][n] = *(const f32x4*)(ps + col0 + bj * HALF + 4 * n); }
#pragma unroll
        for (int ai = 0; ai < 2; ++ai) {
            u32x4 zv[4][2];
#pragma unroll
            for (int m = 0; m < 4; ++m)
#pragma unroll
                for (int bj = 0; bj < 2; ++bj) zv[m][bj] = *(const u32x4*)(O + (size_t)(row0 + ai * HALF + m * 16) * 2048 + col0 + bj * HALF);
            __builtin_amdgcn_sched_barrier(0);
#pragma unroll
            for (int m = 0; m < 4; ++m) { const size_t row = (size_t)(row0 + ai * HALF + m * 16);
#pragma unroll
                for (int bj = 0; bj < 2; ++bj) { const int c = col0 + bj * HALF;
                    float z[8]; unpack8(zv[m][bj], z);
                    f32x4 v0 = (acc[ai][bj][m][0] + bv[bj][0]) * sv[bj][0], v1 = (acc[ai][bj][m][1] + bv[bj][1]) * sv[bj][1];
#pragma unroll
                    for (int j = 0; j < 4; ++j) { v0[j] *= siluf_(z[j]); v1[j] *= siluf_(z[4 + j]); }
                    u32x4 w; w.x = cvt_pk_bf16(v0[0], v0[1]); w.y = cvt_pk_bf16(v0[2], v0[3]); w.z = cvt_pk_bf16(v1[0], v1[1]); w.w = cvt_pk_bf16(v1[2], v1[3]);
                    *(u32x4*)(O + row * 2048 + 1024 + c) = w; } }
        }
    }
};
struct EpiMerge {
    static constexpr bool PERM = true;
    bf16_t* MRGb; const bf16_t* HL;
    __device__ __forceinline__ void operator()(const f32x4 (&acc)[2][2][4][2], f32x4 (&tot)[2][4][2], const Unit& u, int wr, int wc, int fr, int fq) const {
        const int row0 = u.pm * HALF + wr * 64 + fr, col0 = u.pn * BM + wc * 32 + 8 * fq, br = u.tag;
        u32x4 gv[4][2];
#pragma unroll
        for (int m = 0; m < 4; ++m)
#pragma unroll
            for (int bj = 0; bj < 2; ++bj) gv[m][bj] = *(const u32x4*)(HL + (size_t)(row0 + m * 16) * NL + L_GA + br * 1024 + col0 + bj * HALF);
        __builtin_amdgcn_sched_barrier(0);
#pragma unroll
        for (int m = 0; m < 4; ++m) { const size_t row = (size_t)(row0 + m * 16);
#pragma unroll
            for (int bj = 0; bj < 2; ++bj) { const int c = col0 + bj * HALF;
                float gt[8]; unpack8(gv[m][bj], gt);
                f32x4 v0 = acc[0][bj][m][0], v1 = acc[0][bj][m][1];
#pragma unroll
                for (int j = 0; j < 4; ++j) { v0[j] *= sigmoidf_(gt[j]); v1[j] *= sigmoidf_(gt[4 + j]); }
                if (br > 0) { v0 += tot[bj][m][0]; v1 += tot[bj][m][1]; }
                tot[bj][m][0] = v0; tot[bj][m][1] = v1;
                if (br == 2) { u32x4 w; w.x = cvt_pk_bf16(v0[0], v0[1]); w.y = cvt_pk_bf16(v0[2], v0[3]); w.z = cvt_pk_bf16(v1[0], v1[1]); w.w = cvt_pk_bf16(v1[2], v1[3]);
                    *(u32x4*)(MRGb + row * 1024 + c) = w; } } }
    }
};
struct EpiOut {
    static constexpr bool PERM = false;
    float* PRE; const float* xres; float alpha;
    __device__ __forceinline__ void operator()(const f32x4 (&acc)[2][2][4][2], const Unit& u, int wr, int wc, int fr, int fq) const {
        const int row0 = u.pm * BM + wr * 64 + fr, col0 = u.pn * BM + wc * 32 + 4 * fq;
#pragma unroll
        for (int ai = 0; ai < 2; ++ai) {
            f32x4 xr[4][2][2];
#pragma unroll
            for (int m = 0; m < 4; ++m)
#pragma unroll
                for (int bj = 0; bj < 2; ++bj)
#pragma unroll
                    for (int n = 0; n < 2; ++n) xr[m][bj][n] = *(const f32x4*)(xres + (size_t)(row0 + ai * HALF + m * 16) * 1024 + col0 + bj * HALF + n * 16);
            __builtin_amdgcn_sched_barrier(0);
#pragma unroll
            for (int m = 0; m < 4; ++m) { const size_t ro = (size_t)(row0 + ai * HALF + m * 16) * 1024 + col0;
#pragma unroll
                for (int bj = 0; bj < 2; ++bj)
#pragma unroll
                    for (int n = 0; n < 2; ++n) *(f32x4*)(PRE + ro + bj * HALF + n * 16) = acc[ai][bj][m][n] + xr[m][bj][n] * alpha; }
        }
    }
};
}

__device__ __forceinline__ int early_orig(int e) { return e < 3328 ? e : (e < 4096 ? 4352 + (e - 3328) : (e < 6400 ? 5888 + (e - 4096) : 5120 + (e - 6400))); }
__device__ __forceinline__ int late_orig(int c) { return c < 1024 ? 3328 + c : (c < 1280 ? 8192 + (c - 1024) : 8448 + (c - 1280)); }
__device__ __forceinline__ int my_orig(int n) { return n < NE ? early_orig(n) : late_orig(n - NE); }

__device__ __forceinline__ void convert_tile(const int t, const float* src, int src_ld, bf16_t* dst, int dst_ld, float* lds) {
    const int c = t & 63, r0 = t >> 6;
#pragma unroll
    for (int i = 0; i < 8; ++i) { const int k = r0 + 8 * i; lds[k * 65 + c] = src ? src[(size_t)k * src_ld + c] : 0.f; }
    __syncthreads();
#pragma unroll
    for (int i = 0; i < 8; ++i) { const int n = r0 + 8 * i; dst[(size_t)n * dst_ld + c] = f2bf(lds[c * 65 + n]); }
    __syncthreads();
}

struct CvtTile { const float* src; bf16_t* dst; int src_ld, dst_ld; };
__device__ __forceinline__ CvtTile cvt_decode(const Params& P, unsigned char* ws, int l, int t) {
    bf16_t* WIN = (bf16_t*)(ws + OFF_WIN); bf16_t* LORA = (bf16_t*)(ws + OFF_LORA); bf16_t* POOLW = (bf16_t*)(ws + OFF_POOLW);
    bf16_t* PROJ = (bf16_t*)(ws + OFF_PROJ); bf16_t* WOUT = (bf16_t*)(ws + OFF_WOUT);
    constexpr int N_WIN = 180 * 16, N_LORA = 64 * 4, N_POOL = 12 * 12, N_PROJ = 16 * 32;
    CvtTile d;
    if (t < N_WIN) { const int nt = t >> 4, kt = t & 15; const int n0 = nt * 64, k0 = kt * 64;
        d.src = P.w_in + (size_t)l * 1024 * NIN + (size_t)k0 * NIN + my_orig(n0); d.src_ld = NIN; d.dst = WIN + (size_t)n0 * 1024 + k0; d.dst_ld = 1024; return d; }
    t -= N_WIN;
    if (t < N_LORA) { const int nt = t >> 2, kt = t & 3; const int n0 = nt * 64, seg = n0 >> 10, ch = n0 & 1023;
        d.src = nullptr;
        if (kt == seg) d.src = (seg < 2 ? P.w_up + ((size_t)(l * 2 + seg) * 64) * 1024 : P.a_up + ((size_t)(l * 2 + seg - 2) * 64) * 1024) + ch;
        d.src_ld = 1024; d.dst = LORA + (size_t)n0 * 256 + kt * 64; d.dst_ld = 256; return d; }
    t -= N_LORA;
    if (t < N_POOL) { const int nt = t / 12, kt = t % 12; const int n0 = nt * 64, k0 = kt * 64, gn = n0 / 192, gk = k0 / 192;
        d.src = nullptr;
        if (gn == gk) d.src = P.pool_w + ((size_t)(l * 4 + gn) * 192 + (k0 - 192 * gk)) * 192 + (n0 - 192 * gn);
        d.src_ld = 192; d.dst = POOLW + (size_t)n0 * 768 + k0; d.dst_ld = 768; return d; }
    t -= N_POOL;
    if (t < N_PROJ) { const int nt = t >> 5, kt = t & 31; const int n0 = nt * 64, k0 = kt * 64;
        d.src = k0 < 1024 ? P.proj_a + ((size_t)l * 1024 + k0) * 1024 + n0
                          : (k0 < 1792 ? P.proj_b + ((size_t)l * 768 + (k0 - 1024)) * 1024 + n0 : P.proj_c + ((size_t)l * 256 + (k0 - 1792)) * 1024 + n0);
        d.src_ld = 1024; d.dst = PROJ + (size_t)n0 * 2048 + k0; d.dst_ld = 2048; return d; }
    t -= N_PROJ;
    { const int nt = t >> 4, kt = t & 15; const int n0 = nt * 64, k0 = kt * 64;
        d.src = P.w_out + ((size_t)l * 1024 + k0) * 1024 + n0; d.src_ld = 1024; d.dst = WOUT + (size_t)n0 * 1024 + k0; d.dst_ld = 1024; return d; }
}
__device__ __forceinline__ void convert_weights(const int tid, const int bid, const Params& P, unsigned char* ws, int l, float* lds) {
    float* BIASP = (float*)(ws + OFF_BIASP);
    constexpr int NTILES = 180 * 16 + 64 * 4 + 12 * 12 + 16 * 32 + 16 * 16;
    constexpr int CB = 4;
    const int c = tid & 63, r0 = tid >> 6;
    for (int tile0 = bid; tile0 < NTILES; tile0 += CB * gridDim.x) {
        CvtTile d[CB]; float v[CB][8];
#pragma unroll
        for (int q = 0; q < CB; ++q) { const int t = tile0 + q * gridDim.x; d[q] = cvt_decode(P, ws, l, t < NTILES ? t : tile0); if (t >= NTILES) d[q].dst = nullptr; }
#pragma unroll
        for (int q = 0; q < CB; ++q)
#pragma unroll
            for (int i = 0; i < 8; ++i) { const int k = r0 + 8 * i; v[q][i] = d[q].src ? d[q].src[(size_t)k * d[q].src_ld + c] : 0.f; }
#pragma unroll
        for (int q = 0; q < CB; ++q)
#pragma unroll
            for (int i = 0; i < 8; ++i) { const int k = r0 + 8 * i; lds[q * 4160 + k * 65 + c] = v[q][i]; }
        __syncthreads();
#pragma unroll
        for (int q = 0; q < CB; ++q) if (d[q].dst) {
#pragma unroll
            for (int i = 0; i < 8; ++i) { const int n = r0 + 8 * i; d[q].dst[(size_t)n * d[q].dst_ld + c] = f2bf(lds[q * 4160 + c * 65 + n]); } }
        __syncthreads();
    }
    for (int i = bid * 512 + tid; i < NIN; i += gridDim.x * 512) BIASP[i] = P.b_in[(size_t)l * NIN + my_orig(i)];
}

__device__ __forceinline__ void phase_prepass(const int tid, const int bid, const Params& P, unsigned char* ws, float* lds) {
    bf16_t* XB = (bf16_t*)(ws + OFF_XB); float* ROPE = (float*)(ws + OFF_ROPE);
    const size_t gtid = (size_t)bid * 512 + tid, gsz = (size_t)gridDim.x * 512;
    for (size_t i = gtid; i < (size_t)T_TOK * 1024 / 4; i += gsz) { const f32x4 v = *(const f32x4*)(P.x + i * 4);
        u32x2 w; w.x = cvt_pk_bf16(v[0], v[1]); w.y = cvt_pk_bf16(v[2], v[3]); *(u32x2*)(XB + i * 4) = w; }
    for (size_t i = gtid; i < (size_t)SEQ * 32; i += gsz) { const int pos = (int)(i >> 5), fi = (int)(i & 31);
        double inv = 1.0; for (int j = 0; j < fi; ++j) inv *= 0.7498942093324559;
        const double ang = (double)pos * inv; const double n = rint(ang * 0.15915494309189535); const double r = ang - n * 6.283185307179586476925287;
        const double r2 = r * r; double sn = 1.0, cs = 1.0;
        for (int kk = 25; kk >= 3; kk -= 2) sn = 1.0 - sn * r2 / (double)(kk * (kk - 1));
        sn *= r;
        for (int kk = 24; kk >= 2; kk -= 2) cs = 1.0 - cs * r2 / (double)(kk * (kk - 1));
        ROPE[i * 2] = (float)cs; ROPE[i * 2 + 1] = (float)sn; }
    convert_weights(tid, bid, P, ws, 0, lds);
}

template <int H> __device__ __forceinline__ void pool_quad(const bf16_t* hp  , bf16_t* mp  , int pos0) {
    u32x4 rw[4 + 2 * H];
#pragma unroll
    for (int j = 0; j < 4 + 2 * H; ++j) { const int p = pos0 - H + j; rw[j] = (p >= 0 && p < SEQ) ? *(const u32x4*)(hp + (size_t)p * NE) : (u32x4){0u, 0u, 0u, 0u}; }
#pragma unroll
    for (int i = 0; i < 4; ++i) {
        float acc[8], t8[8], me[8];
#pragma unroll
        for (int j = 0; j < 8; ++j) acc[j] = 0.f;
#pragma unroll
        for (int j = i; j <= i + 2 * H; ++j) { unpack8(rw[j], t8);
#pragma unroll
            for (int q = 0; q < 8; ++q) acc[q] += t8[q]; }
        unpack8(rw[i + H], me);
        const int pos = pos0 + i, lo = max(pos - H, 0), hi = min(pos + H, SEQ - 1); const float ic = 1.0f / (float)(hi - lo + 1);
#pragma unroll
        for (int q = 0; q < 8; ++q) acc[q] = acc[q] * ic - me[q];
        *(u32x4*)(mp + (size_t)pos * 768) = pack8(acc);
    }
}
__device__ __forceinline__ void phase_prep(const int tid, const int bid, const Params& P, unsigned char* ws, int l, float* ldsf, const bool do_rope) {
    const bf16_t* HE = (const bf16_t*)(ws + OFF_A); bf16_t* RKV = (bf16_t*)(ws + OFF_B); float* RN = (float*)(ws + OFF_RN);
    bf16_t* LIN = (bf16_t*)(ws + OFF_LIN); bf16_t* MIX = (bf16_t*)(ws + OFF_MIX); bf16_t* VT = (bf16_t*)(ws + OFF_VT); const float* ROPE = (const float*)(ws + OFF_ROPE);
    bf16_t* QKH = (bf16_t*)(ws + OFF_QKH);
    const float* mu0 = P.mu + (size_t)l * 2 * 3328; const float* mu1 = mu0 + 3328; const float* kk_w = P.k_k + (size_t)l * 1024;
    const int gtid = bid * 512 + tid;
    if (gtid < 416 * 256) {
        const int cg8 = gtid % 416, tg = gtid / 416, c = cg8 * 8;
        float m0[8], m1[8], kw[8];
        { const f32x4 a = *(const f32x4*)(mu0 + c), b = *(const f32x4*)(mu0 + c + 4), d = *(const f32x4*)(mu1 + c), e = *(const f32x4*)(mu1 + c + 4);
#pragma unroll
          for (int j = 0; j < 4; ++j) { m0[j] = a[j]; m0[4 + j] = b[j]; m1[j] = d[j]; m1[4 + j] = e[j]; } }
        const bool is_k = (c >= 1024 && c < 2048);
        if (is_k) { const f32x4 a = *(const f32x4*)(kk_w + c - 1024), b = *(const f32x4*)(kk_w + c - 1024 + 4);
#pragma unroll
            for (int j = 0; j < 4; ++j) { kw[j] = a[j]; kw[4 + j] = b[j]; } }
        else {
#pragma unroll
            for (int j = 0; j < 8; ++j) kw[j] = 0.f; }
        for (int it0 = 0; it0 < 16; it0 += 4) {
            u32x4 rwb[4][6];
#pragma unroll
            for (int h = 0; h < 4; ++h) { const int tq = tg + 256 * (it0 + h), tok0 = tq * 4, pos0 = tok0 & (SEQ - 1); const bf16_t* hp = HE + (size_t)tok0 * NE + c;
#pragma unroll
                for (int j = 0; j < 6; ++j) { const int p = pos0 - 1 + j; rwb[h][j] = (p >= 0 && p < SEQ) ? *(const u32x4*)(hp + (long)(j - 1) * NE) : (u32x4){0u, 0u, 0u, 0u}; } }
            __builtin_amdgcn_sched_barrier(0);
#pragma unroll
            for (int h = 0; h < 4; ++h) {
            const int tq = tg + 256 * (it0 + h), tok0 = tq * 4, pos0 = tok0 & (SEQ - 1);
            float pv[8], cu[8], nx[8];
            unpack8(rwb[h][0], pv); unpack8(rwb[h][1], cu);
#pragma unroll
            for (int i = 0; i < 4; ++i) {
                unpack8(rwb[h][i + 2], nx);
                float o[8];
#pragma unroll
                for (int j = 0; j < 8; ++j) o[j] = cu[j] + m0[j] * (pv[j] - cu[j]) + m1[j] * (nx[j] - cu[j]);
                const int tok = tok0 + i, pos = pos0 + i;
                if (c < 3072) {
                    const int arr = c >> 10, chn = c & 1023;
                    *(u32x4*)(RKV + (size_t)arr * T_TOK * 1024 + ((size_t)((tok >> 11) * 16 + (chn >> 6)) * SEQ + pos) * 64 + (chn & 63)) = pack8(o);
                    if (is_k) { float ss = 0.f;
#pragma unroll
                        for (int j = 0; j < 8; ++j) { const float t = o[j] * kw[j]; ss += t * t; }
                        ss += dppf<DPP_QP1>(ss); ss += dppf<DPP_QP2>(ss); ss += dppf<0x141>(ss);
                        if ((cg8 & 7) == 0) RN[(size_t)((tok >> 11) * 16 + ((c - 1024) >> 6)) * SEQ + pos] = rsqrtf(ss + 1e-12f); }
                } else {
                    if (c < 3200) {
#pragma unroll
                        for (int j = 0; j < 8; ++j) { const float ax = fabsf(o[j]); const float e = __expf(-2.f * ax); const float th = (1.f - e) / (1.f + e); o[j] = o[j] < 0.f ? -th : th; } }
                    *(u32x4*)(LIN + (size_t)tok * 256 + (c - 3072)) = pack8(o);
                }
#pragma unroll
                for (int j = 0; j < 8; ++j) { pv[j] = cu[j]; cu[j] = nx[j]; }
            }
            }
        }
    }
    if (gtid < 96 * 1024) {
        const int cg8 = gtid % 96, tg = gtid / 96, c = cg8 * 8, g = c / 192;
        for (int it = 0; it < 4; ++it) {
            const int tq = tg + 1024 * it, tok0 = tq * 4, pos0 = tok0 & (SEQ - 1); const size_t tb = (size_t)(tok0 - pos0);
            const bf16_t* hp = HE + tb * NE + E_PB + c; bf16_t* mp = MIX + tb * 768 + c;
            if (g == 0) pool_quad<1>(hp, mp, pos0); else if (g == 1) pool_quad<2>(hp, mp, pos0); else if (g == 2) pool_quad<4>(hp, mp, pos0); else pool_quad<8>(hp, mp, pos0);
        }
    }
    if (do_rope && gtid < 96 * 1024) {
        const int r = gtid % 96, tg = gtid / 96, hd24 = r >> 2, jq = r & 3, dsh = 2 * ((hd24 % 12) >> 2);
        for (int it0 = 0; it0 < 16; it0 += 4) {
            u32x4 xa[4], xb[4]; f32x4 csb[4][4];
#pragma unroll
            for (int h = 0; h < 4; ++h) { const int tok = tg + 1024 * (it0 + h), pos = tok & (SEQ - 1);
                const bf16_t* p1 = HE + (size_t)tok * NE + E_Q + hd24 * 64 + jq * 8;
                xa[h] = *(const u32x4*)p1; xb[h] = *(const u32x4*)(p1 + 32);
                const float* rp = ROPE + ((size_t)pos * 32 + jq * 8) * 2;
#pragma unroll
                for (int j = 0; j < 4; ++j) csb[h][j] = *(const f32x4*)(rp + j * 4); }
            __builtin_amdgcn_sched_barrier(0);
#pragma unroll
            for (int h = 0; h < 4; ++h) { const int tok = tg + 1024 * (it0 + h), pos = tok & (SEQ - 1), b = tok >> 11;
                float x1[8], x2[8], o1[8], o2[8];
                unpack8(xa[h], x1); unpack8(xb[h], x2);
#pragma unroll
                for (int j = 0; j < 8; j += 2) { const f32x4 cs = csb[h][j >> 1];
                    o1[j] = x1[j] * cs[0] - x2[j] * cs[1]; o2[j] = x2[j] * cs[0] + x1[j] * cs[1];
                    o1[j + 1] = x1[j + 1] * cs[2] - x2[j + 1] * cs[3]; o2[j + 1] = x2[j + 1] * cs[2] + x1[j + 1] * cs[3]; }
                const int pp = ((pos & ((1 << dsh) - 1)) << (11 - dsh)) + (pos >> dsh);
                bf16_t* q1 = QKH + ((size_t)(b * 24 + hd24) * SEQ + pp) * 64 + jq * 8;
                *(u32x4*)q1 = pack8(o1); *(u32x4*)(q1 + 32) = pack8(o2); }
        }
    }
    if (gtid < 96 * 1024) {
        bf16_t* Op = (bf16_t*)(ws + OFF_O); const int r = gtid % 96, tg = gtid / 96, cz = r * 8;
        for (int it0 = 0; it0 < 16; it0 += 8) { u32x4 zz[8];
#pragma unroll
            for (int h = 0; h < 8; ++h) zz[h] = *(const u32x4*)(HE + (size_t)(tg + 1024 * (it0 + h)) * NE + E_ZB + cz);
#pragma unroll
            for (int h = 0; h < 8; ++h) *(u32x4*)(Op + (size_t)(tg + 1024 * (it0 + h)) * 2048 + cz) = zz[h]; }
    }
    {
        const int lane = tid & 63, wid = tid >> 6;
        bf16_t* lt = (bf16_t*)ldsf + wid * (64 * 72);
        for (int tile = bid * 8 + wid; tile < NB * 12 * 32; tile += gridDim.x * 8) {
            const int pt = tile & 31, bh = tile >> 5, hd = bh % 12, b = bh / 12, dsh = 2 * (hd >> 2), p0 = pt * 64;
            u32x4 w[8];
#pragma unroll
            for (int i = 0; i < 8; ++i) { const int e = lane + 64 * i, tk = e >> 3, c8 = (e & 7) * 8;
                w[i] = *(const u32x4*)(HE + ((size_t)b * SEQ + p0 + tk) * NE + E_V + hd * 64 + c8); }
#pragma unroll
            for (int i = 0; i < 8; ++i) { const int e = lane + 64 * i, tk = e >> 3, c8 = (e & 7) * 8; *(u32x4*)(lt + tk * 72 + c8) = w[i]; }
            asm volatile("s_waitcnt lgkmcnt(0)" ::: "memory");
            bf16_t* vrow = VT + ((size_t)(b * 12 + hd) * 64 + lane) * SEQ;
            const int d = 1 << dsh, run = 64 >> dsh;
#pragma unroll 1
            for (int res = 0; res < d; ++res) {
                const int ppb = (res << (11 - dsh)) + (p0 >> dsh);
#pragma unroll 1
                for (int m = 0; m < run; m += 4) {
                    const unsigned a0 = lt[(res + ((m + 0) << dsh)) * 72 + lane], a1 = lt[(res + ((m + 1) << dsh)) * 72 + lane],
                                   a2 = lt[(res + ((m + 2) << dsh)) * 72 + lane], a3 = lt[(res + ((m + 3) << dsh)) * 72 + lane];
                    u32x2 o; o.x = a0 | (a1 << 16); o.y = a2 | (a3 << 16);
                    *(u32x2*)(vrow + ppb + m) = o; }
            }
            asm volatile("s_waitcnt lgkmcnt(0)" ::: "memory");
        }
    }
}

__device__ __forceinline__ void attn_item(const bf16_t* QKH, const bf16_t* VT, bf16_t* AO, float* LSE, int item, int lane) {
    const int ti = item & 127, bh = item >> 7, hd = bh % 12, b = bh / 12;
    const int dsh = 2 * (hd >> 2), L = SEQ >> dsh, tpr = L >> 4;
    const int res = ti / tpr, m0 = (ti % tpr) << 4;
    const int fr = lane & 15, fq = lane >> 4;
    const size_t tokb = (size_t)b * SEQ + res;
    const bf16_t* qbase = QKH + ((size_t)(b * 24 + hd) * SEQ + (size_t)res * L) * 64 + fq * 8;
    const bf16_t* kbase = qbase + (size_t)12 * SEQ * 64;
    const bf16_t* qp = qbase + (size_t)(m0 + fr) * 64;
    const bf16x8 qf0 = *(const bf16x8*)qp, qf1 = *(const bf16x8*)(qp + 32);
    float sv[10][4];
    float mx = -1e30f;
    bf16x8 kf[10][2];
#pragma unroll
    for (int kt = 0; kt < 10; ++kt) {
        const int kb = m0 - 64 + 32 * (kt >> 1) + 4 * (kt & 1);
        const int mk = kb + 8 * (fr >> 2) + (fr & 3); const int mkc = min(max(mk, 0), L - 1);
        const bf16_t* kp = kbase + (size_t)mkc * 64;
        kf[kt][0] = *(const bf16x8*)kp; kf[kt][1] = *(const bf16x8*)(kp + 32);
    }
    __builtin_amdgcn_sched_barrier(0);
#pragma unroll
    for (int kt = 0; kt < 10; ++kt) {
        const int kb = m0 - 64 + 32 * (kt >> 1) + 4 * (kt & 1);
        f32x4 acc = {0.f, 0.f, 0.f, 0.f};
        acc = __builtin_amdgcn_mfma_f32_16x16x32_bf16(kf[kt][0], qf0, acc, 0, 0, 0);
        acc = __builtin_amdgcn_mfma_f32_16x16x32_bf16(kf[kt][1], qf1, acc, 0, 0, 0);
#pragma unroll
        for (int r = 0; r < 4; ++r) { const int mkk = kb + 8 * fq + r; const int dd = mkk - (m0 + fr);
            const bool valid = (mkk >= 0) && (mkk < L) && (dd <= 64) && (dd >= -64);
            const float s = valid ? acc[r] * 0.125f : -1e30f; sv[kt][r] = s; mx = fmaxf(mx, s); }
    }
    const bf16_t* vbase = VT + ((size_t)(b * 12 + hd) * 64 + fr) * SEQ + (size_t)res * L;
    bf16x8 vf[5][4];
#pragma unroll
    for (int pr = 0; pr < 5; ++pr) {
        const int mkb = m0 - 64 + 32 * pr + 8 * fq; const int k0 = (mkb >= 0 && mkb + 7 < L) ? mkb : 0;
#pragma unroll
        for (int nb = 0; nb < 4; ++nb) vf[pr][nb] = *(const bf16x8*)(vbase + (size_t)nb * 16 * SEQ + k0);
    }
    __builtin_amdgcn_sched_barrier(0);
    mx = fmaxf(mx, bperm(mx, lane ^ 16)); mx = fmaxf(mx, bperm(mx, lane ^ 32));
    float den = 0.f;
#pragma unroll
    for (int kt = 0; kt < 10; ++kt)
#pragma unroll
        for (int r = 0; r < 4; ++r) { const float p = __expf(sv[kt][r] - mx); sv[kt][r] = p; den += p; }
    den += bperm(den, lane ^ 16); den += bperm(den, lane ^ 32);
    f32x4 o[4];
#pragma unroll
    for (int nb = 0; nb < 4; ++nb) o[nb] = (f32x4){0.f, 0.f, 0.f, 0.f};
#pragma unroll
    for (int pr = 0; pr < 5; ++pr) {
        union { bf16x8 v; unsigned u[4]; } af;
        af.u[0] = cvt_pk_bf16(sv[2 * pr][0], sv[2 * pr][1]); af.u[1] = cvt_pk_bf16(sv[2 * pr][2], sv[2 * pr][3]);
        af.u[2] = cvt_pk_bf16(sv[2 * pr + 1][0], sv[2 * pr + 1][1]); af.u[3] = cvt_pk_bf16(sv[2 * pr + 1][2], sv[2 * pr + 1][3]);
#pragma unroll
        for (int nb = 0; nb < 4; ++nb) o[nb] = __builtin_amdgcn_mfma_f32_16x16x32_bf16(af.v, vf[pr][nb], o[nb], 0, 0, 0);
    }
#pragma unroll
    for (int r = 0; r < 4; ++r) { const float dq = bperm(den, 4 * fq + r); const float inv = 1.0f / dq;
        bf16_t* op = AO + (tokb + ((size_t)(m0 + 4 * fq + r) << dsh)) * 768 + hd * 64 + fr;
#pragma unroll
        for (int nb = 0; nb < 4; ++nb) op[nb * 16] = f2bf(o[nb][r] * inv); }
    if (fq == 0) LSE[(tokb + ((size_t)(m0 + fr) << dsh)) * 12 + hd] = mx + __logf(den);
}

#define DPPR8 " row_ror:8 row_mask:0xf bank_mask:0xf\n"
#define DPPQ1 " quad_perm:[1,0,3,2] row_mask:0xf bank_mask:0xf\n"
#define DPPQ2 " quad_perm:[2,3,0,1] row_mask:0xf bank_mask:0xf\n"
#define DPPHM " row_half_mirror row_mask:0xf bank_mask:0xf\n"
#define SCAN_STEP(y, N, W, Kd, Bv, R, vv, s) do { float _sa, _t, _y2; asm volatile( \
    "v_mul_f32 %0, %12, %4\n" "v_mul_f32 %1, %13, %5\n" "v_fmac_f32 %0, %14, %6\n" "v_fmac_f32 %1, %15, %7\n" \
    "v_fmac_f32_dpp %0, %12, %8" DPPR8 "v_fmac_f32_dpp %1, %13, %9" DPPR8 "v_fmac_f32_dpp %0, %14, %10" DPPR8 "v_fmac_f32_dpp %1, %15, %11" DPPR8 \
    "v_add_f32 %0, %0, %1\n" \
    "v_mul_f32 %4, %16, %4\n" "v_mul_f32 %5, %17, %5\n" \
    "v_add_f32_dpp %0, %0, %0" DPPQ1 \
    "v_mul_f32 %6, %18, %6\n" "v_mul_f32 %7, %19, %7\n" \
    "v_add_f32_dpp %0, %0, %0" DPPQ2 \
    "v_mul_f32_dpp %8, %16, %8" DPPR8 "v_mul_f32_dpp %9, %17, %9" DPPR8 \
    "v_add_f32_dpp %0, %0, %0" DPPHM \
    "v_mul_f32_dpp %10, %18, %10" DPPR8 "v_mul_f32_dpp %11, %19, %11" DPPR8 \
    "v_fmac_f32 %4, %20, %32\n" "v_fmac_f32 %5, %21, %32\n" "v_fmac_f32 %6, %22, %32\n" "v_fmac_f32 %7, %23, %32\n" \
    "v_fmac_f32_dpp %8, %20, %32" DPPR8 "v_fmac_f32_dpp %9, %21, %32" DPPR8 "v_fmac_f32_dpp %10, %22, %32" DPPR8 "v_fmac_f32_dpp %11, %23, %32" DPPR8 \
    "v_fmac_f32 %4, %24, %0\n" "v_fmac_f32 %5, %25, %0\n" "v_fmac_f32 %6, %26, %0\n" "v_fmac_f32 %7, %27, %0\n" \
    "v_fmac_f32_dpp %8, %24, %0" DPPR8 "v_fmac_f32_dpp %9, %25, %0" DPPR8 "v_fmac_f32_dpp %10, %26, %0" DPPR8 "v_fmac_f32_dpp %11, %27, %0" DPPR8 \
    "v_mul_f32 %2, %28, %4\n" "v_mul_f32 %3, %29, %5\n" "v_fmac_f32 %2, %30, %6\n" "v_fmac_f32 %3, %31, %7\n" \
    "v_fmac_f32_dpp %2, %28, %8" DPPR8 "v_fmac_f32_dpp %3, %29, %9" DPPR8 "v_fmac_f32_dpp %2, %30, %10" DPPR8 "v_fmac_f32_dpp %3, %31, %11" DPPR8 \
    "v_add_f32 %2, %2, %3\n" "s_nop 1\n" \
    "v_add_f32_dpp %2, %2, %2" DPPQ1 "s_nop 1\n" \
    "v_add_f32_dpp %2, %2, %2" DPPQ2 "s_nop 1\n" \
    "v_add_f32_dpp %2, %2, %2" DPPHM \
    : "=&v"(_sa), "=&v"(_t), "=&v"(y), "=&v"(_y2), "+v"(s[0]), "+v"(s[1]), "+v"(s[2]), "+v"(s[3]), "+v"(s[4]), "+v"(s[5]), "+v"(s[6]), "+v"(s[7]) \
    : "v"(N[0]), "v"(N[1]), "v"(N[2]), "v"(N[3]), "v"(W[0]), "v"(W[1]), "v"(W[2]), "v"(W[3]), "v"(Kd[0]), "v"(Kd[1]), "v"(Kd[2]), "v"(Kd[3]), \
      "v"(Bv[0]), "v"(Bv[1]), "v"(Bv[2]), "v"(Bv[3]), "v"(R[0]), "v"(R[1]), "v"(R[2]), "v"(R[3]), "v"(vv)); } while (0)

__device__ __forceinline__ float row16_sum2(float a, float b, bool odd) {
    float x = odd ? b : a; const float g = odd ? a : b;
    x += dppf<DPP_QP1>(g); x += dppf<DPP_QP2>(x); x += dppf<DPP_ROR4>(x); x += dppf<DPP_ROR8>(x);
    return x;
}
constexpr int SC_CH = 32;
constexpr int SC_STEP_F = 6 * 64;
constexpr int SC_BUF_F = SC_CH * SC_STEP_F;
constexpr int SC_YOFF_F = 2 * SC_BUF_F;
__device__ __forceinline__ void phase_scan_seq(const int tid, const int bid, const Params& P, unsigned char* ws, int l, float* ldsf) {
    const bf16_t* RKV = (const bf16_t*)(ws + OFF_B); const float* RN = (const float*)(ws + OFF_RN); const bf16_t* EA = (const bf16_t*)(ws + OFF_C);
    float* Y = (float*)(ws + OFF_A);
    const int lane = tid & 63, wid = tid >> 6;
    for (int st = bid; st < 256; st += gridDim.x) {
        const int dir = st >> 7, bt = (st >> 4) & 7, hh = st & 15;
        const size_t sbase = (size_t)(bt * 16 + hh) * SEQ;
        const int lp = tid >> 4, c4 = (tid & 15) * 4;
        const int lts = dir ? (SC_CH - 1 - lp) : lp;
        const bf16_t* pr = RKV + (sbase + lp) * 64 + c4; const bf16_t* pk = pr + (size_t)T_TOK * 1024; const bf16_t* pv = pk + (size_t)T_TOK * 1024;
        const bf16_t* pe = EA + (size_t)dir * T_TOK * 1024 + (sbase + lp) * 64 + c4; const bf16_t* pa = pe + (size_t)2 * T_TOK * 1024;
        const float* pn = RN + sbase + lp;
        float* py = Y + (size_t)dir * T_TOK * 1024 + (sbase + lp) * 64 + c4;
        const f32x4 kkc = *(const f32x4*)(P.k_k + (size_t)l * 1024 + hh * 64 + c4), kac = *(const f32x4*)(P.k_a + (size_t)l * 1024 + hh * 64 + c4);
        f32x2 sA[2], sB[2];
        sA[0] = sA[1] = sB[0] = sB[1] = (f32x2){0.f, 0.f};
        const int voff = 4 * (lane & 15);
        const int vrow = 8 * wid + 2 * (lane >> 4);
        const bool odd = (lane & 1) != 0;
        const int yoff = ((lane & 14) == 0) ? (vrow + (lane & 1)) : (2 * SC_CH * 64 + lane);
        u32x2 q_r, q_k, q_v, q_e, q_a; float q_n;
#define SC_P0(cc) (dir ? (SEQ - SC_CH * ((cc) + 1)) : SC_CH * (cc))
#define SC_ISSUE(cc) do { const size_t o_ = (size_t)SC_P0(cc) * 64; q_r = *(const u32x2*)(pr + o_); q_k = *(const u32x2*)(pk + o_); q_v = *(const u32x2*)(pv + o_); \
        q_e = *(const u32x2*)(pe + o_); q_a = *(const u32x2*)(pa + o_); q_n = pn[SC_P0(cc)]; } while (0)
#define SC_COMMIT(cc) do { float* bp_ = ldsf + ((cc) & 1) * SC_BUF_F + lts * SC_STEP_F + c4; \
        const f32x4 k_ = {bflo(q_k.x), bfhi(q_k.x), bflo(q_k.y), bfhi(q_k.y)}, a_ = {bflo(q_a.x), bfhi(q_a.x), bflo(q_a.y), bfhi(q_a.y)}; \
        const f32x4 e_ = {bflo(q_e.x), bfhi(q_e.x), bflo(q_e.y), bfhi(q_e.y)}; \
        const f32x4 kk_ = k_ * kkc * q_n; f32x4 w_; w_[0] = __expf(-e_[0]); w_[1] = __expf(-e_[1]); w_[2] = __expf(-e_[2]); w_[3] = __expf(-e_[3]); \
        *(f32x4*)(bp_) = kk_; *(f32x4*)(bp_ + 64) = w_; *(f32x4*)(bp_ + 128) = k_ * ((a_ - 1.f) * kac + 1.f); *(f32x4*)(bp_ + 192) = -kk_ * a_; \
        *(f32x4*)(bp_ + 256) = (f32x4){bflo(q_r.x), bfhi(q_r.x), bflo(q_r.y), bfhi(q_r.y)}; *(f32x4*)(bp_ + 320) = (f32x4){bflo(q_v.x), bfhi(q_v.x), bflo(q_v.y), bfhi(q_v.y)}; } while (0)
#define SC_FLUSH(cc) do { *(f32x4*)(py + (size_t)SC_P0(cc) * 64) = *(const f32x4*)(ldsf + SC_YOFF_F + ((cc) & 1) * (SC_CH * 64) + lts * 64 + c4); } while (0)
#define SC_BARRIER() do { asm volatile("s_waitcnt lgkmcnt(0)" ::: "memory"); __builtin_amdgcn_s_barrier(); asm volatile("" ::: "memory"); } while (0)
        __syncthreads();
        SC_ISSUE(0); SC_COMMIT(0);
        SC_BARRIER();
        for (int c = 0; c < SEQ / SC_CH; ++c) {
            if (c > 0) SC_FLUSH(c - 1);
            if (c + 1 < SEQ / SC_CH) SC_ISSUE(c + 1);
            const float* buf = ldsf + (c & 1) * SC_BUF_F;
            float* ybuf = ldsf + SC_YOFF_F + (c & 1) * (SC_CH * 64) + yoff;
            f32x4 cN = *(const f32x4*)(buf + voff), cW = *(const f32x4*)(buf + 64 + voff), cK = *(const f32x4*)(buf + 128 + voff), cB = *(const f32x4*)(buf + 192 + voff), cR = *(const f32x4*)(buf + 256 + voff);
            f32x2 cv = *(const f32x2*)(buf + 320 + vrow);
#pragma unroll
            for (int ts = 0; ts < SC_CH; ++ts) {
                f32x4 nN, nW, nK, nB, nR; f32x2 nv;
                if (ts + 1 < SC_CH) { const float* bp = buf + (ts + 1) * SC_STEP_F;
                    nN = *(const f32x4*)(bp + voff); nW = *(const f32x4*)(bp + 64 + voff); nK = *(const f32x4*)(bp + 128 + voff); nB = *(const f32x4*)(bp + 192 + voff); nR = *(const f32x4*)(bp + 256 + voff); nv = *(const f32x2*)(bp + 320 + vrow); }
                const f32x2 N0 = {cN[0], cN[1]}, N1 = {cN[2], cN[3]}, W0 = {cW[0], cW[1]}, W1 = {cW[2], cW[3]}, K0 = {cK[0], cK[1]}, K1 = {cK[2], cK[3]},
                            B0 = {cB[0], cB[1]}, B1 = {cB[2], cB[3]}, R0 = {cR[0], cR[1]}, R1 = {cR[2], cR[3]};
                const f32x2 pa = N0 * sA[0] + N1 * sA[1], pb = N0 * sB[0] + N1 * sB[1];
                const float x = row16_sum2(pa[0] + pa[1], pb[0] + pb[1], odd);
                const float o = dppf<DPP_QP1>(x);
                const float saA = odd ? o : x, saB = odd ? x : o;
                const f32x2 vA = {cv[0], cv[0]}, vB = {cv[1], cv[1]}, aA = {saA, saA}, aB = {saB, saB};
                sA[0] = W0 * sA[0] + K0 * vA + B0 * aA; sA[1] = W1 * sA[1] + K1 * vA + B1 * aA;
                sB[0] = W0 * sB[0] + K0 * vB + B0 * aB; sB[1] = W1 * sB[1] + K1 * vB + B1 * aB;
                const f32x2 qa = R0 * sA[0] + R1 * sA[1], qb = R0 * sB[0] + R1 * sB[1];
                ybuf[ts * 64] = row16_sum2(qa[0] + qa[1], qb[0] + qb[1], odd);
                if (ts + 1 < SC_CH) { cN = nN; cW = nW; cK = nK; cB = nB; cR = nR; cv = nv; }
            }
            if (c + 1 < SEQ / SC_CH) SC_COMMIT(c + 1);
            SC_BARRIER();
        }
        SC_FLUSH(SEQ / SC_CH - 1);
#undef SC_ISSUE
#undef SC_COMMIT
#undef SC_FLUSH
#undef SC_P0
    }
    __syncthreads();
}

namespace sc2 {
constexpr int C = 16;
constexpr int RAW_F = C * 6 * 64;
constexpr int O_RAW = 0;
constexpr int O_NT = 2 * RAW_F * 4;
constexpr int O_BT = O_NT + 2 * 2304, O_KT = O_BT + 2304, O_RT = O_KT + 2304;
constexpr int O_BK = O_RT + 2 * 2304;
constexpr int O_UV = O_BK + 2 * 5120;
constexpr int O_BRKR = O_UV + 2 * 5120;
constexpr int O_ZKN = O_BRKR + 2 * 1280;
constexpr int O_SB = O_ZKN + 1280;
constexpr int O_MB = O_SB + 9216;
constexpr int O_GL = O_MB + 1024;
constexpr int O_PC = O_GL + 4096;
constexpr int O_Y = O_PC + 512;
constexpr int O_END = O_Y + 8192;
}
__device__ __forceinline__ void phase_scan(const int tid, const int bid, const Params& P, unsigned char* ws, int l, float* ldsf) {
    using namespace sc2;
    const bf16_t* RKV = (const bf16_t*)(ws + OFF_B); const float* RN = (const float*)(ws + OFF_RN); const bf16_t* EA = (const bf16_t*)(ws + OFF_C);
    bf16_t* Y = (bf16_t*)(ws + OFF_Y);
    unsigned char* lb = (unsigned char*)ldsf;
    const int lane = tid & 63, wid = tid >> 6, fr = lane & 15, fq = lane >> 4;
    for (int st = bid; st < 256; st += gridDim.x) {
        const int dir = st >> 7, bt = (st >> 4) & 7, hh = st & 15;
        const size_t sbase = (size_t)(bt * 16 + hh) * SEQ;
        const int lp = tid >> 5, c2 = (tid & 31) * 2, lts = dir ? (C - 1 - lp) : lp;
        const unsigned eo = (unsigned)((sbase + lp) * 64 + c2);
        const bf16_t* RKk = RKV + (size_t)T_TOK * 1024; const bf16_t* RKv = RKV + (size_t)2 * T_TOK * 1024;
        const bf16_t* EAe = EA + (size_t)dir * T_TOK * 1024; const bf16_t* EAa = EA + (size_t)(2 + dir) * T_TOK * 1024;
        bf16_t* Yd = Y + (size_t)dir * T_TOK * 1024;
        const float kkc0 = P.k_k[(size_t)l * 1024 + hh * 64 + c2], kkc1 = P.k_k[(size_t)l * 1024 + hh * 64 + c2 + 1];
        const float kac0 = P.k_a[(size_t)l * 1024 + hh * 64 + c2], kac1 = P.k_a[(size_t)l * 1024 + hh * 64 + c2 + 1];
        unsigned qv[2][5]; float qn[2];
#define SC_P0(cc) (dir ? (SEQ - C * ((cc) + 1)) : C * (cc))
#define SC_ISSUE(cc, S) do { const unsigned o_ = eo + (unsigned)(SC_P0(cc) * 64); qv[S][0] = *(const unsigned*)(RKV + o_); qv[S][1] = *(const unsigned*)(RKk + o_); qv[S][2] = *(const unsigned*)(RKv + o_); \
        qv[S][3] = *(const unsigned*)(EAe + o_); qv[S][4] = *(const unsigned*)(EAa + o_); qn[S] = RN[(unsigned)(sbase + lp) + (unsigned)SC_P0(cc)]; } while (0)
#define SC_COMMIT(cc, S) do { float* bp_ = (float*)(lb + O_RAW) + ((cc) & 1) * RAW_F + lts * (6 * 64) + c2; \
        const float k0_ = bflo(qv[S][1]), k1_ = bfhi(qv[S][1]), a0_ = bflo(qv[S][4]), a1_ = bfhi(qv[S][4]); const float kk0_ = k0_ * kkc0 * qn[S], kk1_ = k1_ * kkc1 * qn[S]; \
        *(f32x2*)(bp_) = (f32x2){kk0_, kk1_}; *(f32x2*)(bp_ + 64) = (f32x2){bflo(qv[S][3]), bfhi(qv[S][3])}; \
        *(f32x2*)(bp_ + 128) = (f32x2){k0_ * (1.f + (a0_ - 1.f) * kac0), k1_ * (1.f + (a1_ - 1.f) * kac1)}; *(f32x2*)(bp_ + 192) = (f32x2){-kk0_ * a0_, -kk1_ * a1_}; \
        *(f32x2*)(bp_ + 256) = (f32x2){bflo(qv[S][0]), bfhi(qv[S][0])}; *(f32x2*)(bp_ + 320) = (f32x2){bflo(qv[S][2]), bfhi(qv[S][2])}; } while (0)
#define SC_FLUSH(cc) do { const f32x2 yv_ = *(const f32x2*)((const float*)(lb + O_Y) + ((cc) & 1) * (C * 64) + lts * 64 + c2); *(unsigned*)(Yd + (eo + (unsigned)(SC_P0(cc) * 64))) = cvt_pk_bf16(yv_[0], yv_[1]); } while (0)
#define SC_BARRIER() do { asm volatile("s_waitcnt lgkmcnt(0)" ::: "memory"); __builtin_amdgcn_s_barrier(); asm volatile("" ::: "memory"); } while (0)
#define SC_PREPG(cc, WLO, WHI, TLO, NK) do { if (wid >= (WLO) && wid < (WHI)) { const float* raw_ = (const float*)(lb + O_RAW) + ((cc) & 1) * RAW_F; const int j_ = lane; \
        unsigned char* bk_ = lb + O_BK + ((cc) & 1) * 5120 + j_ * 80; unsigned char* uv_ = lb + O_UV + ((cc) & 1) * 5120 + j_ * 80; \
        unsigned char* nt_b = lb + O_NT + ((cc) & 1) * 2304 + j_ * 2; unsigned char* rt_b = lb + O_RT + ((cc) & 1) * 2304 + j_ * 2; \
        float ev_[15]; _Pragma("unroll") for (int tau_ = 0; tau_ < 15; ++tau_) ev_[tau_] = raw_[tau_ * 384 + 64 + j_]; \
        _Pragma("unroll") for (int k_ = 0; k_ < (NK); ++k_) { const int t_ = (TLO) + (wid - (WLO)) + ((WHI) - (WLO)) * k_; if (t_ < C) { \
            const float* rp_ = raw_ + t_ * 384 + j_; const float i0_ = rp_[0], i1_ = rp_[64], i2_ = rp_[128], i3_ = rp_[192], i4_ = rp_[256], i5_ = rp_[320]; \
            float E_ = 0.f; _Pragma("unroll") for (int tau_ = 0; tau_ < 15; ++tau_) E_ += (tau_ < t_) ? ev_[tau_] : 0.f; \
            const float pprev_ = __expf(-E_); E_ += i1_; const float pc_ = __expf(-E_), ipc_ = __expf(E_); \
            const bf16_t nt_ = f2bf(pprev_ * i0_), bt_ = f2bf(ipc_ * i3_), kt_ = f2bf(ipc_ * i2_), rt_ = f2bf(pc_ * i4_), vv_ = f2bf(i5_); \
            *(bf16_t*)(nt_b + t_ * 144) = nt_; *(bf16_t*)(lb + O_BT + t_ * 144 + j_ * 2) = bt_; *(bf16_t*)(lb + O_KT + t_ * 144 + j_ * 2) = kt_; *(bf16_t*)(rt_b + t_ * 144) = rt_; \
            *(bf16_t*)(bk_ + t_ * 2) = bt_; *(bf16_t*)(bk_ + (16 + t_) * 2) = kt_; *(bf16_t*)(uv_ + (16 + t_) * 2) = vv_; \
            if (t_ == C - 1) *(float*)(lb + O_PC + ((cc) & 1) * 256 + j_ * 4) = pc_; } } } } while (0)
#define SC_PREP(cc) SC_PREPG(cc, 0, 8, 0, 2)
#define SC_PREP_A(cc) SC_PREPG(cc, 0, 4, 0, 1)
#define SC_PREP_B(cc) SC_PREPG(cc, 1, 8, 4, 2)
#define SC_P1(cc) do { if (wid < 4) { \
        const unsigned char* xa_ = lb + ((wid & 1) ? O_KT : O_BT) + fr * 144 + fq * 16; const unsigned char* yb_ = lb + ((wid >> 1) ? O_RT : O_NT) + ((cc) & 1) * 2304 + fr * 144 + fq * 16; \
        f32x4 acc_ = {0.f, 0.f, 0.f, 0.f}; \
        acc_ = __builtin_amdgcn_mfma_f32_16x16x32_bf16(*(const bf16x8*)xa_, *(const bf16x8*)yb_, acc_, 0, 0, 0); \
        acc_ = __builtin_amdgcn_mfma_f32_16x16x32_bf16(*(const bf16x8*)(xa_ + 64), *(const bf16x8*)(yb_ + 64), acc_, 0, 0, 0); \
        _Pragma("unroll") for (int r_ = 0; r_ < 4; ++r_) { const int tau_ = 4 * fq + r_; const bool keep_ = (wid < 2) ? (tau_ < fr) : (tau_ <= fr); acc_[r_] = keep_ ? acc_[r_] : 0.f; } \
        if (wid == 0) *(f32x4*)(lb + O_MB + fr * 64 + fq * 16) = acc_; \
        else { u32x2 w_; w_.x = cvt_pk_bf16(acc_[0], acc_[1]); w_.y = cvt_pk_bf16(acc_[2], acc_[3]); \
            if (wid == 1) { *(u32x2*)(lb + O_ZKN + fr * 80 + (16 + 4 * fq) * 2) = w_; *(u32x2*)(lb + O_ZKN + fr * 80 + (4 * fq) * 2) = (u32x2){0u, 0u}; } \
            else *(u32x2*)(lb + O_BRKR + ((cc) & 1) * 1280 + fr * 80 + ((wid - 2) * 16 + 4 * fq) * 2) = w_; } } } while (0)
        f32x4 sacc[2]; sacc[0] = sacc[1] = (f32x4){0.f, 0.f, 0.f, 0.f};
        const int ib = wid >> 1, jb0 = 2 * (wid & 1);
        __syncthreads();
        for (int i = tid; i < 576; i += 512) *(u32x4*)(lb + O_SB + i * 16) = (u32x4){0u, 0u, 0u, 0u};
        for (int i = tid; i < 640; i += 512) *(u32x4*)(lb + O_UV + i * 16) = (u32x4){0u, 0u, 0u, 0u};
        SC_ISSUE(0, 0); SC_COMMIT(0, 0);
        SC_ISSUE(1, 1); SC_COMMIT(1, 1);
        SC_ISSUE(2, 0); SC_ISSUE(3, 1);
        SC_BARRIER();
        SC_PREP(0);
        SC_BARRIER();
        SC_P1(0);
        SC_BARRIER();
        for (int ch = 0; ch < SEQ / C / 2; ++ch) {
#pragma unroll
        for (int cc = 0; cc < 2; ++cc) {
            const int c = 2 * ch + cc;
            if (c > 0) SC_FLUSH(c - 1);
            if (c + 1 < SEQ / C) SC_PREP_A(c + 1);
            f32x4 hacc = {0.f, 0.f, 0.f, 0.f};
            if (wid >= 4) {
                const int ibb = wid - 4;
                const unsigned char* sa_ = lb + O_SB + (16 * ibb + fr) * 144 + fq * 16;
                const bf16x8 a0 = *(const bf16x8*)sa_, a1 = *(const bf16x8*)(sa_ + 64);
                const bf16x8 av = *(const bf16x8*)(lb + O_UV + (c & 1) * 5120 + (16 * ibb + fr) * 80 + fq * 16);
                const unsigned char* nb_ = lb + O_NT + (c & 1) * 2304 + fr * 144 + fq * 16; const unsigned char* rb_ = lb + O_RT + (c & 1) * 2304 + fr * 144 + fq * 16;
                f32x4 g = {0.f, 0.f, 0.f, 0.f};
                g = __builtin_amdgcn_mfma_f32_16x16x32_bf16(a0, *(const bf16x8*)nb_, g, 0, 0, 0);
                g = __builtin_amdgcn_mfma_f32_16x16x32_bf16(a1, *(const bf16x8*)(nb_ + 64), g, 0, 0, 0);
                g = __builtin_amdgcn_mfma_f32_16x16x32_bf16(av, *(const bf16x8*)(lb + O_ZKN + fr * 80 + fq * 16), g, 0, 0, 0);
                hacc = __builtin_amdgcn_mfma_f32_16x16x32_bf16(a0, *(const bf16x8*)rb_, hacc, 0, 0, 0);
                hacc = __builtin_amdgcn_mfma_f32_16x16x32_bf16(a1, *(const bf16x8*)(rb_ + 64), hacc, 0, 0, 0);
                *(f32x4*)(lb + O_GL + fr * 256 + (16 * ibb + 4 * fq) * 4) = g;
            }
            SC_BARRIER();
            if (wid == 0) {
                const int i = lane; float u[C];
#pragma unroll
                for (int t = 0; t < C; ++t) {
                    float a0 = *(const float*)(lb + O_GL + t * 256 + i * 4), a1 = 0.f;
                    f32x4 m[4];
#pragma unroll
                    for (int q = 0; q < 4; ++q) if (4 * q < t) m[q] = *(const f32x4*)(lb + O_MB + t * 64 + q * 16);
#pragma unroll
                    for (int tau = 0; tau < t; ++tau) { if (tau & 1) a1 += u[tau] * m[tau >> 2][tau & 3]; else a0 += u[tau] * m[tau >> 2][tau & 3]; }
                    u[t] = a0 + a1;
                }
                u32x4 w0, w1;
                w0.x = cvt_pk_bf16(u[0], u[1]); w0.y = cvt_pk_bf16(u[2], u[3]); w0.z = cvt_pk_bf16(u[4], u[5]); w0.w = cvt_pk_bf16(u[6], u[7]);
                w1.x = cvt_pk_bf16(u[8], u[9]); w1.y = cvt_pk_bf16(u[10], u[11]); w1.z = cvt_pk_bf16(u[12], u[13]); w1.w = cvt_pk_bf16(u[14], u[15]);
                *(u32x4*)(lb + O_UV + (c & 1) * 5120 + i * 80) = w0; *(u32x4*)(lb + O_UV + (c & 1) * 5120 + i * 80 + 16) = w1;
            }
            if (c + 1 < SEQ / C) SC_PREP_B(c + 1);
            SC_BARRIER();
            if (wid >= 4) {
                const int ibb = wid - 4;
                const bf16x8 af = *(const bf16x8*)(lb + O_UV + (c & 1) * 5120 + (16 * ibb + fr) * 80 + fq * 16), bf_ = *(const bf16x8*)(lb + O_BRKR + (c & 1) * 1280 + fr * 80 + fq * 16);
                hacc = __builtin_amdgcn_mfma_f32_16x16x32_bf16(af, bf_, hacc, 0, 0, 0);
                *(f32x4*)(lb + O_Y + (c & 1) * (C * 64 * 4) + fr * 256 + (16 * ibb + 4 * fq) * 4) = hacc;
            }
            {
                const bf16x8 af = *(const bf16x8*)(lb + O_UV + (c & 1) * 5120 + (16 * ib + fr) * 80 + fq * 16);
#pragma unroll
                for (int q = 0; q < 2; ++q) {
                    const int j = 16 * (jb0 + q) + fr;
                    const bf16x8 bf_ = *(const bf16x8*)(lb + O_BK + (c & 1) * 5120 + j * 80 + fq * 16);
                    sacc[q] = __builtin_amdgcn_mfma_f32_16x16x32_bf16(af, bf_, sacc[q], 0, 0, 0);
                    const float pc = *(const float*)(lb + O_PC + (c & 1) * 256 + j * 4);
                    sacc[q] *= pc;
#pragma unroll
                    for (int r = 0; r < 4; ++r) *(bf16_t*)(lb + O_SB + (16 * ib + 4 * fq + r) * 144 + j * 2) = f2bf(sacc[q][r]);
                }
            }
            if (c + 1 < SEQ / C) SC_P1(c + 1);
            if (c + 2 < SEQ / C) SC_COMMIT(c + 2, cc);
            if (c + 4 < SEQ / C) SC_ISSUE(c + 4, cc);
            SC_BARRIER();
        }
        }
        SC_FLUSH(SEQ / C - 1);
#undef SC_ISSUE
#undef SC_COMMIT
#undef SC_FLUSH
#undef SC_P0
#undef SC_BARRIER
#undef SC_PREP
#undef SC_P1
    }
    __syncthreads();
}

__device__ __forceinline__ void phase_post(const int tid, const int bid, const Params& P, unsigned char* ws, int l) {
    const bf16_t* Y = (const bf16_t*)(ws + OFF_Y); const bf16_t* RKV = (const bf16_t*)(ws + OFF_B); const bf16_t* HL = (const bf16_t*)(ws + OFF_HL);
    const bf16_t* AO = (const bf16_t*)(ws + OFF_AO); const float* LSE = (const float*)(ws + OFF_LSE); bf16_t* O = (bf16_t*)(ws + OFF_O);
    const float* gg = P.gn_g + (size_t)l * 1024; const float* gb = P.gn_b + (size_t)l * 1024; const float* rk = P.r_k + (size_t)l * 1024;
    const size_t gtid = (size_t)bid * 512 + tid, gsz = (size_t)gridDim.x * 512;
    constexpr int PB = 8;
    for (size_t u0 = gtid; u0 < (size_t)T_TOK * 256; u0 += PB * gsz) {
        u32x2 ya[PB], yb[PB]; u32x2 rw[PB], kw[PB], vw[PB], zw[PB];
#pragma unroll
        for (int k = 0; k < PB; ++k) { size_t u = u0 + k * gsz; if (u >= (size_t)T_TOK * 256) u = u0;
            const size_t tok = u >> 8; const int c = (int)(u & 255) * 4;
            const size_t hm = ((size_t)((tok >> 11) * 16 + (c >> 6)) * SEQ + (tok & 2047)) * 64 + (c & 63);
            ya[k] = *(const u32x2*)(Y + hm); yb[k] = *(const u32x2*)(Y + (size_t)T_TOK * 1024 + hm);
            rw[k] = *(const u32x2*)(RKV + hm); kw[k] = *(const u32x2*)(RKV + (size_t)T_TOK * 1024 + hm); vw[k] = *(const u32x2*)(RKV + (size_t)2 * T_TOK * 1024 + hm);
            zw[k] = *(const u32x2*)(HL + tok * NL + L_ZA + c); }
        __builtin_amdgcn_sched_barrier(0);
#pragma unroll
        for (int k = 0; k < PB; ++k) { const size_t u = u0 + k * gsz; if (u < (size_t)T_TOK * 256) {
            const size_t tok = u >> 8; const int c = (int)(u & 255) * 4;
            const f32x4 y = {bflo(ya[k].x) + bflo(yb[k].x), bfhi(ya[k].x) + bfhi(yb[k].x), bflo(ya[k].y) + bflo(yb[k].y), bfhi(ya[k].y) + bfhi(yb[k].y)};
            const f32x4 rkv = *(const f32x4*)(rk + c);
            const float r4[4] = {bflo(rw[k].x), bfhi(rw[k].x), bflo(rw[k].y), bfhi(rw[k].y)}, k4[4] = {bflo(kw[k].x), bfhi(kw[k].x), bflo(kw[k].y), bfhi(kw[k].y)}, v4[4] = {bflo(vw[k].x), bfhi(vw[k].x), bflo(vw[k].y), bfhi(vw[k].y)};
            float s1 = y[0] + y[1] + y[2] + y[3], bd = r4[0] * k4[0] * rkv[0] + r4[1] * k4[1] * rkv[1] + r4[2] * k4[2] * rkv[2] + r4[3] * k4[3] * rkv[3];
            s1 += dppf<DPP_QP1>(s1); bd += dppf<DPP_QP1>(bd); s1 += dppf<DPP_QP2>(s1); bd += dppf<DPP_QP2>(bd);
            s1 += dppf<DPP_ROR4>(s1); bd += dppf<DPP_ROR4>(bd); s1 += dppf<DPP_ROR8>(s1); bd += dppf<DPP_ROR8>(bd);
            const float mean = s1 * (1.f / 64.f);
            float s2 = 0.f;
#pragma unroll
            for (int j = 0; j < 4; ++j) { const float d = y[j] - mean; s2 += d * d; }
            s2 += dppf<DPP_QP1>(s2); s2 += dppf<DPP_QP2>(s2); s2 += dppf<DPP_ROR4>(s2); s2 += dppf<DPP_ROR8>(s2);
            const float rstd = rsqrtf(s2 * (1.f / 64.f) + 64e-5f);
            const f32x4 g4 = *(const f32x4*)(gg + c), b4 = *(const f32x4*)(gb + c);
            const float z4[4] = {bflo(zw[k].x), bfhi(zw[k].x), bflo(zw[k].y), bfhi(zw[k].y)};
            float o[4];
#pragma unroll
            for (int j = 0; j < 4; ++j) o[j] = ((y[j] - mean) * rstd * g4[j] + b4[j] + bd * v4[j]) * siluf_(z4[j]);
            u32x2 w; w.x = cvt_pk_bf16(o[0], o[1]); w.y = cvt_pk_bf16(o[2], o[3]);
            *(u32x2*)(O + tok * 2048 + c) = w; } }
    }
    for (size_t u0 = gtid; u0 < (size_t)T_TOK * 64; u0 += PB * gsz) {
        float l0[PB], l1[PB], l2[PB]; u32x2 a0[PB], a1[PB], a2[PB], zc[PB];
#pragma unroll
        for (int k = 0; k < PB; ++k) { size_t u = u0 + k * gsz; if (u >= (size_t)T_TOK * 64) u = u0;
            const size_t tok = u >> 6; const int r = (int)(u & 63), hs = r >> 4, d4 = (r & 15) * 4;
            l0[k] = LSE[tok * 12 + hs]; l1[k] = LSE[tok * 12 + 4 + hs]; l2[k] = LSE[tok * 12 + 8 + hs];
            a0[k] = *(const u32x2*)(AO + tok * 768 + hs * 64 + d4); a1[k] = *(const u32x2*)(AO + tok * 768 + (4 + hs) * 64 + d4); a2[k] = *(const u32x2*)(AO + tok * 768 + (8 + hs) * 64 + d4);
            zc[k] = *(const u32x2*)(HL + tok * NL + L_ZC + hs * 64 + d4); }
        __builtin_amdgcn_sched_barrier(0);
#pragma unroll
        for (int k = 0; k < PB; ++k) { const size_t u = u0 + k * gsz; if (u < (size_t)T_TOK * 64) {
            const size_t tok = u >> 6; const int r = (int)(u & 63), hs = r >> 4, d4 = (r & 15) * 4;
            const float lm = fmaxf(l0[k], fmaxf(l1[k], l2[k])); const float e0 = __expf(l0[k] - lm), e1 = __expf(l1[k] - lm), e2 = __expf(l2[k] - lm); const float inv = __builtin_amdgcn_rcpf(e0 + e1 + e2);
            float o[4];
            o[0] = (e0 * bflo(a0[k].x) + e1 * bflo(a1[k].x) + e2 * bflo(a2[k].x)) * inv * siluf_(bflo(zc[k].x));
            o[1] = (e0 * bfhi(a0[k].x) + e1 * bfhi(a1[k].x) + e2 * bfhi(a2[k].x)) * inv * siluf_(bfhi(zc[k].x));
            o[2] = (e0 * bflo(a0[k].y) + e1 * bflo(a1[k].y) + e2 * bflo(a2[k].y)) * inv * siluf_(bflo(zc[k].y));
            o[3] = (e0 * bfhi(a0[k].y) + e1 * bfhi(a1[k].y) + e2 * bfhi(a2[k].y)) * inv * siluf_(bfhi(zc[k].y));
            u32x2 w; w.x = cvt_pk_bf16(o[0], o[1]); w.y = cvt_pk_bf16(o[2], o[3]);
            *(u32x2*)(O + tok * 2048 + 1792 + hs * 64 + d4) = w; } }
    }
}

__device__ __forceinline__ void phase_ln(const int tid, const int bid, const Params& P, unsigned char* ws, int l) {
    const float* PRE = (const float*)(ws + OFF_A); bf16_t* XB = (bf16_t*)(ws + OFF_XB);
    const float* g = P.ln_g + (size_t)l * 1024; const float* bb = P.ln_b + (size_t)l * 1024;
    const int lane = tid & 63, wid = tid >> 6;
    constexpr int LR = 8;
    for (int row0 = (bid * 8 + wid) * LR; row0 < T_TOK; row0 += gridDim.x * 8 * LR) {
        f32x4 v[LR][4]; float s[LR], s2[LR], mean[LR], rstd[LR];
#pragma unroll
        for (int q = 0; q < LR; ++q) { const float* pr = PRE + (size_t)(row0 + q) * 1024;
#pragma unroll
            for (int i = 0; i < 4; ++i) v[q][i] = *(const f32x4*)(pr + i * 256 + lane * 4); }
        __builtin_amdgcn_sched_barrier(0);
#pragma unroll
        for (int q = 0; q < LR; ++q) { s[q] = 0.f;
#pragma unroll
            for (int i = 0; i < 4; ++i) s[q] += v[q][i][0] + v[q][i][1] + v[q][i][2] + v[q][i][3]; }
#pragma unroll
        for (int q = 0; q < LR; ++q) { float t = s[q]; t += dppf<DPP_QP1>(t); t += dppf<DPP_QP2>(t); t += dppf<DPP_ROR4>(t); t += dppf<DPP_ROR8>(t); t += bperm(t, lane ^ 16); t += bperm(t, lane ^ 32); mean[q] = t * (1.f / 1024.f); }
#pragma unroll
        for (int q = 0; q < LR; ++q) { float t = 0.f;
#pragma unroll
            for (int i = 0; i < 4; ++i)
#pragma unroll
                for (int j = 0; j < 4; ++j) { const float d = v[q][i][j] - mean[q]; t += d * d; }
            s2[q] = t; }
#pragma unroll
        for (int q = 0; q < LR; ++q) { float t = s2[q]; t += dppf<DPP_QP1>(t); t += dppf<DPP_QP2>(t); t += dppf<DPP_ROR4>(t); t += dppf<DPP_ROR8>(t); t += bperm(t, lane ^ 16); t += bperm(t, lane ^ 32); rstd[q] = rsqrtf(t * (1.f / 1024.f) + 1e-5f); }
#pragma unroll
        for (int q = 0; q < LR; ++q)
#pragma unroll
            for (int i = 0; i < 4; ++i) { const int c = i * 256 + lane * 4; const f32x4 g4 = *(const f32x4*)(g + c), b4 = *(const f32x4*)(bb + c);
                f32x4 o; for (int j = 0; j < 4; ++j) o[j] = (v[q][i][j] - mean[q]) * rstd[q] * g4[j] + b4[j];
                *(f32x4*)(P.out + (size_t)(row0 + q) * 1024 + c) = o;
                u32x2 w; w.x = cvt_pk_bf16(o[0], o[1]); w.y = cvt_pk_bf16(o[2], o[3]); *(u32x2*)(XB + (size_t)(row0 + q) * 1024 + c) = w; }
    }
}

#define XB_TMO      128
#define XB_XCNT(j)  (256  + 64 * (j))
#define XB_XSUB(j)  (1280 + 64 * (j))
#define XB_XGEN(j)  (2304 + 64 * (j))
#define XB_TOP      3328
#define XB_TOPGEN   3392
#define XCD_BAR_WORDS 3456
#define XB_SPIN_CAP (1u << 20)
__device__ __forceinline__ unsigned xb_ld(unsigned* p)              { return __hip_atomic_load(p, __ATOMIC_RELAXED, __HIP_MEMORY_SCOPE_AGENT); }
__device__ __forceinline__ unsigned xb_add(unsigned* p, unsigned v) { return __hip_atomic_fetch_add(p, v, __ATOMIC_RELAXED, __HIP_MEMORY_SCOPE_AGENT); }
__device__ __forceinline__ unsigned xb_xcc_id() { return (unsigned)__builtin_amdgcn_s_getreg((3 << 11) | 20) & 0xFu; }
#define XB_SPIN(cond, bar) do { unsigned _sp = 0; while (cond) { __builtin_amdgcn_s_sleep(1); \
    if ((++_sp & 255u) == 0u) { if (xb_ld(&(bar)[XB_TMO])) break; if (_sp > XB_SPIN_CAP) { atomicAdd(&(bar)[XB_TMO], 1u); break; } } } } while (0)
struct XcdBarrier { unsigned* bar; unsigned x; volatile LAS unsigned* st; };
__device__ __forceinline__ XcdBarrier xcd_barrier_post(unsigned* bar, volatile LAS unsigned* st) {
    XcdBarrier b; b.bar = bar; b.x = xb_xcc_id(); b.st = st;
    if (threadIdx.x == 0) (void)xb_add(&bar[XB_XCNT(b.x)], 1u);
    return b;
}
__device__ __forceinline__ void xcd_barrier_complete(unsigned* bar, unsigned x, unsigned& nloc, unsigned& nx) {
    const unsigned G = gridDim.x * gridDim.y * gridDim.z;
    unsigned sum, cnt, mine, sp = 0u;
    for (;;) {
        sum = 0u; cnt = 0u; mine = 0u;
#pragma unroll
        for (unsigned j = 0; j < 16; ++j) { const unsigned c = xb_ld(&bar[XB_XCNT(j)]); sum += c; cnt += (c > 0u) ? 1u : 0u; mine = (j == x) ? c : mine; }
        if (sum == G) break;
        __builtin_amdgcn_s_sleep(1);
        if ((++sp & 255u) == 0u) { if (xb_ld(&bar[XB_TMO])) break; if (sp > XB_SPIN_CAP) { atomicAdd(&bar[XB_TMO], 1u); break; } }
    }
    nloc = mine > 0u ? mine : 1u; nx = cnt > 0u ? cnt : 1u;
}
__device__ __forceinline__ void xcd_barrier(const XcdBarrier& b) {
    asm volatile("s_waitcnt vmcnt(0)" ::: "memory");
    __syncthreads();
    if (threadIdx.x == 0) {
        unsigned* bar = b.bar;
        __builtin_amdgcn_s_waitcnt(0);
        unsigned nloc = b.st[0], nx = b.st[1];
        if (nloc == 0u) { xcd_barrier_complete(bar, b.x, nloc, nx); b.st[0] = nloc; b.st[1] = nx; }
        const unsigned old = xb_add(&bar[XB_XSUB(b.x)], 1u);
        const unsigned gen = old / nloc;
        if (old + 1u == (gen + 1u) * nloc) {
            __builtin_amdgcn_fence(__ATOMIC_RELEASE, "agent");
            asm volatile("s_waitcnt vmcnt(0)" ::: "memory");
            const unsigned og = xb_add(&bar[XB_TOP], 1u);
            const unsigned tg = og / nx;
            if (og + 1u == (tg + 1u) * nx) xb_add(&bar[XB_TOPGEN], 1u);
            else XB_SPIN(xb_ld(&bar[XB_TOPGEN]) == tg, bar);
            __builtin_amdgcn_fence(__ATOMIC_ACQUIRE, "agent");
            xb_add(&bar[XB_XGEN(b.x)], 1u);
            asm volatile("s_waitcnt vmcnt(0)" ::: "memory");
        } else {
            XB_SPIN(xb_ld(&bar[XB_XGEN(b.x)]) == gen, bar);
            __builtin_amdgcn_fence(__ATOMIC_ACQUIRE, "agent");
            asm volatile("s_waitcnt vmcnt(0)" ::: "memory");
        }
    }
    __syncthreads();
}

constexpr int PER = 8;
constexpr int N_PH = 1 + PER * DEPTH;
__global__ void __launch_bounds__(512, 2) fwd_kernel(Params P) {
    extern __shared__ __attribute__((aligned(16))) unsigned char shm[];
    LAS unsigned char* lds = (LAS unsigned char*)shm; float* ldsf = (float*)shm;
    const int G = (int)gridDim.x;
#if !MK_MULTI
    volatile LAS unsigned* xst = (volatile LAS unsigned*)(lds + 131072);
    if (threadIdx.x == 0) { xst[0] = 0u; xst[1] = 0u; }
    __syncthreads();
    const XcdBarrier xb = xcd_barrier_post((unsigned*)(P.ws + OFF_BAR), xst);
#endif
    for (int ph = P.ph_lo; ph < P.ph_hi; ++ph) {
        int tid = threadIdx.x; asm volatile("" : "+v"(tid));
        int c = blockIdx.x; asm volatile("" : "+s"(c));
        size_t wz = 0; asm volatile("" : "+s"(wz)); const Params& PP = *(const Params*)((const char*)&P + wz); unsigned char* ws = PP.ws;
        if (ph == 0) { phase_prepass(tid, c, PP, ws, ldsf); }
        else {
            const int l = (ph - 1) / PER, slot = (ph - 1) % PER, k = slot < 4 ? slot : slot + 1;
            const int rep = 0;
            switch (k) {
            case 0: {
                pg8::Gemm g{(const bf16_t*)(ws + OFF_XB), (const bf16_t*)(ws + OFF_WIN), T_TOK, NE, 1024};
                pg8::StaticOrder S; S.init(T_TOK, NE, 1024, G, c);
                pg8::EpiBias E{(bf16_t*)(ws + OFF_A), NE, (const float*)(ws + OFF_BIASP)};
                pg8::gemm_phase(tid, lds, g, S, E); } break;
            case 1: phase_prep(tid, c, PP, ws, l, ldsf, rep == 0); break;
            case 2: {
                if (!rep || MK_SUB < 0 || MK_SUB == 0) { pg8::Gemm g{(const bf16_t*)(ws + OFF_LIN), (const bf16_t*)(ws + OFF_LORA), T_TOK, 4096, 256};
                  pg8::StaticOrder S; S.init(T_TOK, 4096, 256, G, c);
                  pg8::EpiLora E{(bf16_t*)(ws + OFF_C), PP.w0 + (size_t)l * 2048, PP.a0 + (size_t)l * 2048};
                  pg8::gemm_phase(tid, lds, g, S, E); }
                {
                  pg8::Gemm g{(const bf16_t*)(ws + OFF_XB), (const bf16_t*)(ws + OFF_WIN) + (size_t)NE * 1024, T_TOK, NL, 1024};
                  pg8::StaticOrder S; S.init(T_TOK, NL, 1024, G, c);
                  pg8::EpiBias E{(bf16_t*)(ws + OFF_HL), NL, (const float*)(ws + OFF_BIASP) + NE};
                  pg8::gemm_phase(tid, lds, g, S, E); }
                if (!rep || MK_SUB < 0 || MK_SUB == 1) { pg8::Gemm g{(const bf16_t*)(ws + OFF_MIX), (const bf16_t*)(ws + OFF_POOLW), T_TOK, 768, 768};
                  pg8::StaticOrder S; S.init(T_TOK, 768, 768, G, G - 1 - c);
                  pg8::EpiPool E{(bf16_t*)(ws + OFF_O), (const bf16_t*)(ws + OFF_A), PP.pool_b + (size_t)l * 768, PP.pool_scale + (size_t)l * 768};
                  pg8::gemm_phase(tid, lds, g, S, E); }
                if (!rep || MK_SUB < 0 || MK_SUB == 2) { const int lane = tid & 63, wid = tid >> 6;
                  for (int item = c * 8 + wid; item < NB * 12 * 128; item += G * 8)
                      attn_item((const bf16_t*)(ws + OFF_QKH), (const bf16_t*)(ws + OFF_VT), (bf16_t*)(ws + OFF_AO), (float*)(ws + OFF_LSE), item, lane); }
                } break;
            case 3: phase_scan(tid, c, PP, ws, l, ldsf); break;
            case 5: phase_post(tid, c, PP, ws, l); break;
            case 6: {
                pg8::Gemm g{(const bf16_t*)(ws + OFF_O), (const bf16_t*)(ws + OFF_PROJ), T_TOK, 1024, 2048};
                pg8::MergeOrder S; S.init(G, c);
                pg8::EpiMerge E{(bf16_t*)(ws + OFF_D), (const bf16_t*)(ws + OFF_HL)};
                pg8::gemm_phase<pg8::EpiMerge, pg8::MergeOrder, true>(tid, lds, g, S, E); } break;
            case 7: {
                pg8::Gemm g{(const bf16_t*)(ws + OFF_D), (const bf16_t*)(ws + OFF_WOUT), T_TOK, 1024, 1024};
                pg8::StaticOrder S; S.init(T_TOK, 1024, 1024, G, c);
                pg8::EpiOut E{(float*)(ws + OFF_A), l == 0 ? PP.x : (const float*)PP.out, 1.681792830507429f};
                pg8::gemm_phase(tid, lds, g, S, E); } break;
            case 8: phase_ln(tid, c, PP, ws, l); if (l + 1 < DEPTH) convert_weights(tid, c, PP, ws, l + 1, ldsf); break;
            }
        }
#if !MK_MULTI
        if (ph + 1 < P.ph_hi) { if (ph == 0) cg::this_grid().sync(); else xcd_barrier(xb); }
#endif
    }
}

extern "C" void kernel_launch(void* const* d_in, const int* in_sizes, int n_in, void* d_out, int out_size, void* d_ws, size_t ws_size, hipStream_t stream) {
    constexpr size_t kDynLds = 131072 + 64;
    static int grid_blocks = 0;
    if (!grid_blocks) {
        hipFuncSetAttribute((const void*)fwd_kernel, hipFuncAttributeMaxDynamicSharedMemorySize, (int)kDynLds);
        int dev = 0, cus = 0, per_cu = 0;
        hipGetDevice(&dev);
        hipDeviceGetAttribute(&cus, hipDeviceAttributeMultiprocessorCount, dev);
        hipOccupancyMaxActiveBlocksPerMultiprocessor(&per_cu, fwd_kernel, 512, kDynLds);
        if (per_cu < 1) per_cu = 1;
        grid_blocks = cus * per_cu;
        if (grid_blocks > 256) grid_blocks = 256;
        if (ws_size < WS_TOTAL) fprintf(stderr, "workspace too small: %zu < %zu\n", ws_size, (size_t)WS_TOTAL);
    }
    Params p{};
    p.x = (const float*)d_in[0]; p.w_in = (const float*)d_in[1]; p.b_in = (const float*)d_in[2]; p.mu = (const float*)d_in[3]; p.w0 = (const float*)d_in[4];
    p.w_up = (const float*)d_in[5]; p.a0 = (const float*)d_in[6]; p.a_up = (const float*)d_in[7]; p.k_k = (const float*)d_in[8]; p.k_a = (const float*)d_in[9];
    p.r_k = (const float*)d_in[10]; p.gn_g = (const float*)d_in[11]; p.gn_b = (const float*)d_in[12]; p.pool_w = (const float*)d_in[13]; p.pool_b = (const float*)d_in[14];
    p.pool_scale = (const float*)d_in[15]; p.proj_a = (const float*)d_in[16]; p.proj_b = (const float*)d_in[17]; p.proj_c = (const float*)d_in[18]; p.w_out = (const float*)d_in[19];
    p.ln_g = (const float*)d_in[20]; p.ln_b = (const float*)d_in[21];
    p.out = (float*)d_out; p.ws = (unsigned char*)d_ws;
#if MK_MULTI
    for (int ph = 0; ph < N_PH; ++ph) { p.ph_lo = ph; p.ph_hi = ph + 1;
        hipLaunchKernelGGL(fwd_kernel, dim3(grid_blocks), dim3(512), kDynLds, stream, p); }
#else
    p.ph_lo = 0; p.ph_hi = N_PH;
    hipMemsetAsync((unsigned char*)d_ws + OFF_BAR, 0, 16384, stream);
    void* args[] = {&p};
    hipError_t e = hipLaunchCooperativeKernel((void*)fwd_kernel, dim3(grid_blocks), dim3(512), args, kDynLds, stream);
    if (e != hipSuccess) fprintf(stderr, "cooperative launch failed: %s (grid %d)\n", hipGetErrorString(e), grid_blocks);
#endif
}
```

```cpp
#include <hip/hip_runtime.h>
#include <hip/hip_cooperative_groups.h>
#include <cstdio>
namespace cg = cooperative_groups;

#ifndef MK_REP
#define MK_REP -1
#endif
#ifndef MK_SUB
#define MK_SUB -1
#endif
#ifndef MK_MULTI
#define MK_MULTI 0
#endif

typedef unsigned short bf16_t;
typedef short bf16x8 __attribute__((ext_vector_type(8)));
typedef short bf16x4 __attribute__((ext_vector_type(4)));
typedef float f32x4 __attribute__((ext_vector_type(4)));
typedef unsigned u32x4 __attribute__((ext_vector_type(4)));
typedef unsigned u32x2 __attribute__((ext_vector_type(2)));
typedef float f32x2 __attribute__((ext_vector_type(2)));
#define LAS __attribute__((address_space(3)))

constexpr int T_TOK = 16384, SEQ = 2048, NB = 8, DM = 1024, DEPTH = 4;
constexpr int NE = 7168, NL = 4352, NIN = 11520;
constexpr int E_PB = 3328, E_Q = 4096, E_K = 4864, E_V = 5632, E_ZB = 6400;
constexpr int L_ZA = 0, L_ZC = 1024, L_GA = 1280;

constexpr size_t OFF_WIN = 0;
constexpr size_t OFF_LORA = OFF_WIN + (size_t)NIN * 1024 * 2;
constexpr size_t OFF_POOLW = OFF_LORA + (size_t)4096 * 256 * 2;
constexpr size_t OFF_PROJ = OFF_POOLW + (size_t)768 * 768 * 2;
constexpr size_t OFF_WOUT = OFF_PROJ + (size_t)1024 * 2048 * 2;
constexpr size_t OFF_BIASP = OFF_WOUT + (size_t)1024 * 1024 * 2;
constexpr size_t OFF_ROPE = OFF_BIASP + (size_t)NIN * 4;
constexpr size_t OFF_XB = OFF_ROPE + (size_t)SEQ * 64 * 4;
constexpr size_t OFF_A = OFF_XB + (size_t)T_TOK * 1024 * 2;
constexpr size_t OFF_HL = OFF_A;
constexpr size_t OFF_Y = OFF_A + (size_t)T_TOK * NL * 2;
constexpr size_t OFF_B = OFF_A + (size_t)T_TOK * NE * 2;
constexpr size_t OFF_RN = OFF_B + (size_t)T_TOK * 3072 * 2;
constexpr size_t OFF_C = OFF_RN + (size_t)T_TOK * 16 * 4;
constexpr size_t OFF_D = OFF_C + (size_t)T_TOK * NL * 2;
constexpr size_t OFF_LIN = OFF_D;
constexpr size_t OFF_MIX = OFF_LIN + (size_t)T_TOK * 256 * 2;
constexpr size_t OFF_VT = OFF_MIX + (size_t)T_TOK * 768 * 2;
constexpr size_t OFF_AO = OFF_VT + (size_t)T_TOK * 768 * 2;
constexpr size_t OFF_LSE = OFF_AO + (size_t)T_TOK * 768 * 2;
constexpr size_t OFF_O = OFF_LSE + (size_t)T_TOK * 12 * 4;
constexpr size_t OFF_QKH = OFF_O + (size_t)T_TOK * 2048 * 2;
constexpr size_t OFF_BAR = OFF_QKH + (size_t)T_TOK * 1536 * 2;
constexpr size_t WS_TOTAL = OFF_BAR + 16384;

struct Params {
    const float* x; const float* w_in; const float* b_in; const float* mu; const float* w0; const float* w_up; const float* a0; const float* a_up;
    const float* k_k; const float* k_a; const float* r_k; const float* gn_g; const float* gn_b; const float* pool_w; const float* pool_b; const float* pool_scale;
    const float* proj_a; const float* proj_b; const float* proj_c; const float* w_out; const float* ln_g; const float* ln_b;
    float* out; unsigned char* ws; int ph_lo, ph_hi;
};

__device__ __forceinline__ float bf2f(bf16_t v) { return __uint_as_float(((unsigned)v) << 16); }
__device__ __forceinline__ float bflo(unsigned w) { return __uint_as_float(w << 16); }
__device__ __forceinline__ float bfhi(unsigned w) { return __uint_as_float(w & 0xffff0000u); }
__device__ __forceinline__ unsigned cvt_pk_bf16(float lo, float hi) { unsigned r; asm volatile("v_cvt_pk_bf16_f32 %0, %1, %2" : "=v"(r) : "v"(lo), "v"(hi)); return r; }
__device__ __forceinline__ bf16_t f2bf(float f) { return (bf16_t)(cvt_pk_bf16(f, 0.f) & 0xffffu); }
__device__ __forceinline__ float sigmoidf_(float v) { return __builtin_amdgcn_rcpf(1.0f + __expf(-v)); }
__device__ __forceinline__ float siluf_(float v) { return v * __builtin_amdgcn_rcpf(1.0f + __expf(-v)); }
__device__ __forceinline__ float bperm(float v, int srclane) { return __builtin_bit_cast(float, __builtin_amdgcn_ds_bpermute(srclane << 2, __builtin_bit_cast(int, v))); }
constexpr int DPP_QP1 = 0xB1, DPP_QP2 = 0x4E, DPP_ROR4 = 0x124, DPP_ROR8 = 0x128;
template <int CTRL> __device__ __forceinline__ float dppf(float v) {
    return __builtin_bit_cast(float, __builtin_amdgcn_update_dpp(0, __builtin_bit_cast(int, v), CTRL, 0xf, 0xf, true));
}
__device__ __forceinline__ void unpack8(u32x4 w, float* f) {
    f[0] = bflo(w.x); f[1] = bfhi(w.x); f[2] = bflo(w.y); f[3] = bfhi(w.y); f[4] = bflo(w.z); f[5] = bfhi(w.z); f[6] = bflo(w.w); f[7] = bfhi(w.w);
}
__device__ __forceinline__ u32x4 pack8(const float* f) {
    u32x4 w; w.x = cvt_pk_bf16(f[0], f[1]); w.y = cvt_pk_bf16(f[2], f[3]); w.z = cvt_pk_bf16(f[4], f[5]); w.w = cvt_pk_bf16(f[6], f[7]); return w;
}

namespace pg8 {
constexpr int BM = 256, BK = 64, HALF = 128, HTB = HALF * BK * 2, STAGE_BYTES = 8 * HTB, NXCD = 8, WGM = 8;
__device__ __forceinline__ int lds_byte(int r, int c) { const int st = (r >> 4) * 2 + (c >> 5), rr = r & 15, cc = c & 31, ob = rr * 64 + cc * 2; return st * 1024 + (ob ^ (((ob >> 9) & 1) << 5)); }
__device__ __forceinline__ void stage_rc(int b, int& R, int& C) { const int st = b / 1024, sb = b % 1024, swz = sb ^ (((sb >> 9) & 1) << 5); R = (st >> 1) * 16 + swz / 64; C = (st & 1) * 32 + (swz % 64) / 2; }
__device__ __forceinline__ int perm32(int rho) { const int n = rho >> 4, i = rho & 15; return 8 * (i >> 2) + 4 * n + (i & 3); }

struct Unit { int pm, pn, koff, nt, tag; };
struct Gemm { const bf16_t* A; const bf16_t* Bt; int M, N, ld; };

struct StaticOrder {
    int nM, nN, nwg, G, c, nt;
    __device__ void init(int M, int N, int K, int G_, int c_) { nM = M / BM; nN = N / BM; nwg = nM * nN; G = G_; c = c_; nt = K / BK; }
    __device__ bool next(int i, Unit& u) const {
        const long L = (long)i * G + c; if (L >= nwg) return false;
        int wgid = (int)L; { const int q = nwg / NXCD, r = nwg % NXCD, xcd = wgid % NXCD, off = wgid / NXCD; wgid = (xcd < r ? xcd * (q + 1) : r * (q + 1) + (xcd - r) * q) + off; }
        const int nig = WGM * nN, gid = wgid / nig, fm = gid * WGM, gsz = (nM - fm) < WGM ? (nM - fm) : WGM;
        u.pm = fm + ((wgid % nig) % gsz); u.pn = (wgid % nig) / gsz; u.koff = 0; u.nt = nt; u.tag = 0; return true;
    }
};
struct MergeOrder {
    int G, c;
    __device__ void init(int G_, int c_) { G = G_; c = c_; }
    __device__ bool next(int i, Unit& u) const {
        const int ti = i / 3, br = i - ti * 3; const int cx = (G == 256) ? ((c & 7) * 32 + (c >> 3)) : c;
        const long L = (long)ti * G + cx; if (L >= 512) return false;
        u.pm = (int)(L >> 2); u.pn = (int)(L & 3); u.tag = br;
        u.koff = br == 0 ? 0 : (br == 1 ? 1024 : 1792); u.nt = br == 0 ? 16 : (br == 1 ? 12 : 4); return true;
    }
};

template <class Epi, class Sched, bool HM = false>
__device__ __forceinline__ void gemm_phase(const int tid, LAS unsigned char* lds, const Gemm g, const Sched& S, const Epi& E) {
    const int wid = __builtin_amdgcn_readfirstlane(tid >> 6), lane = tid & 63, wr = wid >> 2, wc = wid & 3, fr = lane & 15, fq = lane >> 4;
    const int K = g.ld;
    unsigned voffA[2], voffB[2];
#pragma unroll
    for (int i = 0; i < 2; ++i) { int R, C; stage_rc(tid * 16 + i * 8192, R, C); const int Rb = Epi::PERM ? ((R & ~31) + perm32(R & 31)) : R;
        voffA[i] = (unsigned)(R * K + C) * 2u; voffB[i] = (unsigned)(Rb * K + C) * 2u; }
    const size_t kstep = (size_t)(BK * 2);
    const size_t hstep = (size_t)HALF * K * 2;
    const size_t tstep = 2 * hstep;
    const size_t astep = HM ? hstep : tstep;
    const size_t h1 = HM ? 0 : hstep;
    const unsigned ldsw = (unsigned)wid * 1024u;
    const int aoff = lds_byte(wr * 64 + fr, fq * 8), boff = lds_byte(wc * 32 + fr, fq * 8);
#define PG8_SA(b, h) (((b) * 2 + (h)) * HTB)
#define PG8_SB(b, h) ((4 + (b) * 2 + (h)) * HTB)
#define PG8_STAGE(bufoff, gbase, voff) do { _Pragma("unroll") for (int _i = 0; _i < 2; ++_i) \
        __builtin_amdgcn_global_load_lds((const unsigned*)((const char*)(gbase) + (voff)[_i]), (LAS unsigned*)(lds + (bufoff) + ldsw + _i * 8192), 16, 0, 0); } while (0)
#define PG8_LDA(dst, b, h) do { _Pragma("unroll") for (int m = 0; m < 4; ++m) _Pragma("unroll") for (int k = 0; k < 2; ++k) dst[m][k] = *(const LAS bf16x8*)(lds + PG8_SA(b, h) + aoff + m * 2048 + k * 1024); } while (0)
#define PG8_LDB(dst, b, h) do { _Pragma("unroll") for (int n = 0; n < 2; ++n) _Pragma("unroll") for (int k = 0; k < 2; ++k) dst[n][k] = *(const LAS bf16x8*)(lds + PG8_SB(b, h) + boff + n * 2048 + k * 1024); } while (0)
#define PG8_MMA(ai, bj, At, Bt) do { __builtin_amdgcn_s_setprio(1); _Pragma("unroll") for (int m = 0; m < 4; ++m) _Pragma("unroll") for (int n = 0; n < 2; ++n) _Pragma("unroll") for (int k = 0; k < 2; ++k) \
        acc[ai][bj][m][n] = __builtin_amdgcn_mfma_f32_16x16x32_bf16(Bt[n][k], At[m][k], acc[ai][bj][m][n], 0, 0, 0); __builtin_amdgcn_s_setprio(0); } while (0)
#define PG8_WAIT_V(n) asm volatile("s_waitcnt vmcnt(" #n ")" ::: "memory")
#define PG8_WAIT_L(n) asm volatile("s_waitcnt lgkmcnt(" #n ")" ::: "memory")
#define PG8_BAR __builtin_amdgcn_s_barrier()
#define PG8_SCHED __builtin_amdgcn_sched_barrier(0)
    Unit cur, nxt; int ui = 0;
    if (!S.next(0, cur)) return;
    f32x4 acc[2][2][4][2];
#pragma unroll
    for (int a = 0; a < 2; ++a)
#pragma unroll
        for (int b = 0; b < 2; ++b)
#pragma unroll
            for (int m = 0; m < 4; ++m)
#pragma unroll
                for (int n = 0; n < 2; ++n) acc[a][b][m][n] = (f32x4){0.f, 0.f, 0.f, 0.f};
    bf16x8 At[4][2], B0[2][2], B1[2][2];
    f32x4 tot[2][4][2];
    if constexpr (HM) {
#pragma unroll
        for (int b = 0; b < 2; ++b)
#pragma unroll
            for (int m = 0; m < 4; ++m)
#pragma unroll
                for (int n = 0; n < 2; ++n) tot[b][m][n] = (f32x4){0.f, 0.f, 0.f, 0.f}; }
    const char* cA = (const char*)g.A + (size_t)cur.pm * astep + (size_t)cur.koff * 2; const char* cB = (const char*)g.Bt + (size_t)cur.pn * tstep + (size_t)cur.koff * 2;
    PG8_STAGE(PG8_SB(0, 0), cB, voffB); PG8_STAGE(PG8_SA(0, 0), cA, voffA); PG8_STAGE(PG8_SB(0, 1), cB + hstep, voffB); PG8_STAGE(PG8_SA(0, 1), cA + h1, voffA);
    if (wr == 1) PG8_BAR;
    PG8_WAIT_V(4); PG8_BAR;
    PG8_STAGE(PG8_SB(1, 0), cB + kstep, voffB); PG8_STAGE(PG8_SA(1, 0), cA + kstep, voffA); PG8_STAGE(PG8_SB(1, 1), cB + hstep + kstep, voffB);
    PG8_WAIT_V(6); PG8_BAR;
    for (;;) {
        const bool has_next = S.next(ui + 1, nxt);
        const char* nA = has_next ? (const char*)g.A + (size_t)nxt.pm * astep + (size_t)nxt.koff * 2 : cA; const char* nB = has_next ? (const char*)g.Bt + (size_t)nxt.pn * tstep + (size_t)nxt.koff * 2 : cB;
        const int nt = cur.nt;
        for (int t = 0; t < nt; t += 2) {
            const bool last = (t == nt - 2);
            const char* a1 = cA + (size_t)(t + 1) * kstep;
            const char* a2 = last ? nA : cA + (size_t)(t + 2) * kstep; const char* b2 = last ? nB : cB + (size_t)(t + 2) * kstep;
            const char* a3 = a2 + kstep; const char* b3 = b2 + kstep;
            PG8_LDB(B0, 0, 0); PG8_SCHED; PG8_LDA(At, 0, 0); PG8_STAGE(PG8_SA(1, 1), a1 + h1, voffA);
            PG8_WAIT_L(8); PG8_BAR; PG8_WAIT_L(0); PG8_MMA(0, 0, At, B0); PG8_BAR; PG8_SCHED;
            PG8_LDB(B1, 0, 1); PG8_STAGE(PG8_SB(0, 0), b2, voffB);
            PG8_BAR; PG8_WAIT_L(0); PG8_MMA(0, 1, At, B1); PG8_BAR;
            if constexpr (!HM) PG8_LDA(At, 0, 1);
            PG8_STAGE(PG8_SA(0, 0), a2, voffA);
            PG8_BAR; PG8_WAIT_L(0); if constexpr (!HM) PG8_MMA(1, 0, At, B0); PG8_BAR; PG8_SCHED;
            PG8_STAGE(PG8_SB(0, 1), b2 + hstep, voffB);
            PG8_WAIT_V(6); PG8_BAR; if constexpr (!HM) PG8_MMA(1, 1, At, B1); PG8_BAR;
            PG8_LDB(B0, 1, 0); PG8_SCHED; PG8_LDA(At, 1, 0); PG8_STAGE(PG8_SA(0, 1), a2 + h1, voffA);
            PG8_WAIT_L(8); PG8_BAR; PG8_WAIT_L(0); PG8_MMA(0, 0, At, B0); PG8_BAR; PG8_SCHED;
            PG8_LDB(B1, 1, 1); PG8_STAGE(PG8_SB(1, 0), b3, voffB);
            PG8_BAR; PG8_WAIT_L(0); PG8_MMA(0, 1, At, B1); PG8_BAR;
            if constexpr (!HM) PG8_LDA(At, 1, 1);
            PG8_STAGE(PG8_SA(1, 0), a3, voffA);
            PG8_BAR; PG8_WAIT_L(0); if constexpr (!HM) PG8_MMA(1, 0, At, B0); PG8_BAR; PG8_SCHED;
            PG8_STAGE(PG8_SB(1, 1), b3 + hstep, voffB);
            PG8_WAIT_V(6); PG8_BAR; if constexpr (!HM) PG8_MMA(1, 1, At, B1); PG8_BAR;
        }
        if constexpr (HM) E(acc, tot, cur, wr, wc, fr, fq); else E(acc, cur, wr, wc, fr, fq);
        if (!has_next) break;
#pragma unroll
        for (int a = 0; a < 2; ++a)
#pragma unroll
            for (int b = 0; b < 2; ++b)
#pragma unroll
                for (int m = 0; m < 4; ++m)
#pragma unroll
                    for (int n = 0; n < 2; ++n) acc[a][b][m][n] = (f32x4){0.f, 0.f, 0.f, 0.f};
        cur = nxt; cA = nA; cB = nB; ++ui;
    }
    PG8_WAIT_V(0);
    if (wr == 0) PG8_BAR;
    PG8_BAR;
#undef PG8_SA
#undef PG8_SB
#undef PG8_STAGE
#undef PG8_LDA
#undef PG8_LDB
#undef PG8_MMA
#undef PG8_WAIT_V
#undef PG8_WAIT_L
#undef PG8_BAR
#undef PG8_SCHED
}

struct EpiBias {
    static constexpr bool PERM = true;
    bf16_t* O; int ldc; const float* bias;
    __device__ __forceinline__ void operator()(const f32x4 (&acc)[2][2][4][2], const Unit& u, int wr, int wc, int fr, int fq) const {
        const int row0 = u.pm * BM + wr * 64 + fr, col0 = u.pn * BM + wc * 32 + 8 * fq;
        f32x4 bv[2][2];
#pragma unroll
        for (int bj = 0; bj < 2; ++bj)
#pragma unroll
            for (int n = 0; n < 2; ++n) bv[bj][n] = *(const f32x4*)(bias + col0 + bj * HALF + 4 * n);
#pragma unroll
        for (int ai = 0; ai < 2; ++ai)
#pragma unroll
            for (int m = 0; m < 4; ++m) { bf16_t* rowp = O + (size_t)(row0 + ai * HALF + m * 16) * ldc + col0;
#pragma unroll
                for (int bj = 0; bj < 2; ++bj) { f32x4 v0 = acc[ai][bj][m][0] + bv[bj][0], v1 = acc[ai][bj][m][1] + bv[bj][1];
                    u32x4 w; w.x = cvt_pk_bf16(v0[0], v0[1]); w.y = cvt_pk_bf16(v0[2], v0[3]); w.z = cvt_pk_bf16(v1[0], v1[1]); w.w = cvt_pk_bf16(v1[2], v1[3]);
                    *(u32x4*)(rowp + bj * HALF) = w; } }
    }
};
struct EpiLora {
    static constexpr bool PERM = true;
    bf16_t* EA; const float* w0; const float* a0;
    __device__ __forceinline__ void operator()(const f32x4 (&acc)[2][2][4][2], const Unit& u, int wr, int wc, int fr, int fq) const {
        const int row0 = u.pm * BM + wr * 64 + fr, colt = u.pn * BM, seg = colt >> 10, col0 = (colt & 1023) + wc * 32 + 8 * fq;
        const float* bp = (seg < 2 ? w0 + seg * 1024 : a0 + (seg - 2) * 1024) + col0;
        const float sc = seg < 2 ? 0.60653065971f : 1.0f;
        bf16_t* base = EA + (size_t)seg * T_TOK * 1024;
        f32x4 bv[2][2];
#pragma unroll
        for (int bj = 0; bj < 2; ++bj)
#pragma unroll
            for (int n = 0; n < 2; ++n) bv[bj][n] = *(const f32x4*)(bp + bj * HALF + 4 * n);
#pragma unroll
        for (int ai = 0; ai < 2; ++ai)
#pragma unroll
            for (int m = 0; m < 4; ++m) { const int row = row0 + ai * HALF + m * 16;
#pragma unroll
                for (int bj = 0; bj < 2; ++bj) { f32x4 v0 = acc[ai][bj][m][0] + bv[bj][0], v1 = acc[ai][bj][m][1] + bv[bj][1];
#pragma unroll
                    for (int j = 0; j < 4; ++j) { v0[j] = sc * sigmoidf_(v0[j]); v1[j] = sc * sigmoidf_(v1[j]); }
                    u32x4 w; w.x = cvt_pk_bf16(v0[0], v0[1]); w.y = cvt_pk_bf16(v0[2], v0[3]); w.z = cvt_pk_bf16(v1[0], v1[1]); w.w = cvt_pk_bf16(v1[2], v1[3]);
                    const int cc = col0 + bj * HALF;
                    *(u32x4*)(base + ((size_t)((row >> 11) * 16 + (cc >> 6)) * SEQ + (row & 2047)) * 64 + (cc & 63)) = w; } }
    }
};
struct EpiPool {
    static constexpr bool PERM = true;
    bf16_t* O; const bf16_t* HE; const float* pb; const float* ps;
    __device__ __forceinline__ void operator()(const f32x4 (&acc)[2][2][4][2], const Unit& u, int wr, int wc, int fr, int fq) const {
        const int row0 = u.pm * BM + wr * 64 + fr, col0 = u.pn * BM + wc * 32 + 8 * fq;
        f32x4 bv[2][2], sv[2][2];
#pragma unroll
        for (int bj = 0; bj < 2; ++bj)
#pragma unroll
            for (int n = 0; n < 2; ++n) { bv[bj][n] = *(const f32x4*)(pb + col0 + bj * HALF + 4 * n); sv[bj][n] = *(const f32x4*)(ps + col0 + bj * HALF + 4 * n); }
#pragma unroll
        for (int ai = 0; ai < 2; ++ai) {
            u32x4 zv[4][2];
#pragma unroll
            for (int m = 0; m < 4; ++m)
#pragma unroll
                for (int bj = 0; bj < 2; ++bj) zv[m][bj] = *(const u32x4*)(O + (size_t)(row0 + ai * HALF + m * 16) * 2048 + col0 + bj * HALF);
            __builtin_amdgcn_sched_barrier(0);
#pragma unroll
            for (int m = 0; m < 4; ++m) { const size_t row = (size_t)(row0 + ai * HALF + m * 16);
#pragma unroll
                for (int bj = 0; bj < 2; ++bj) { const int c = col0 + bj * HALF;
                    float z[8]; unpack8(zv[m][bj], z);
                    f32x4 v0 = (acc[ai][bj][m][0] + bv[bj][0]) * sv[bj][0], v1 = (acc[ai][bj][m][1] + bv[bj][1]) * sv[bj][1];
#pragma unroll
                    for (int j = 0; j < 4; ++j) { v0[j] *= siluf_(z[j]); v1[j] *= siluf_(z[4 + j]); }
                    u32x4 w; w.x = cvt_pk_bf16(v0[0], v0[1]); w.y = cvt_pk_bf16(v0[2], v0[3]); w.z = cvt_pk_bf16(v1[0], v1[1]); w.w = cvt_pk_bf16(v1[2], v1[3]);
                    *(u32x4*)(O + row * 2048 + 1024 + c) = w; } }
        }
    }
};
struct EpiMerge {
    static constexpr bool PERM = true;
    bf16_t* MRGb; const bf16_t* HL;
    __device__ __forceinline__ void operator()(const f32x4 (&acc)[2][2][4][2], f32x4 (&tot)[2][4][2], const Unit& u, int wr, int wc, int fr, int fq) const {
        const int row0 = u.pm * HALF + wr * 64 + fr, col0 = u.pn * BM + wc * 32 + 8 * fq, br = u.tag;
        u32x4 gv[4][2];
#pragma unroll
        for (int m = 0; m < 4; ++m)
#pragma unroll
            for (int bj = 0; bj < 2; ++bj) gv[m][bj] = *(const u32x4*)(HL + (size_t)(row0 + m * 16) * NL + L_GA + br * 1024 + col0 + bj * HALF);
        __builtin_amdgcn_sched_barrier(0);
#pragma unroll
        for (int m = 0; m < 4; ++m) { const size_t row = (size_t)(row0 + m * 16);
#pragma unroll
            for (int bj = 0; bj < 2; ++bj) { const int c = col0 + bj * HALF;
                float gt[8]; unpack8(gv[m][bj], gt);
                f32x4 v0 = acc[0][bj][m][0], v1 = acc[0][bj][m][1];
#pragma unroll
                for (int j = 0; j < 4; ++j) { v0[j] *= sigmoidf_(gt[j]); v1[j] *= sigmoidf_(gt[4 + j]); }
                if (br > 0) { v0 += tot[bj][m][0]; v1 += tot[bj][m][1]; }
                tot[bj][m][0] = v0; tot[bj][m][1] = v1;
                if (br == 2) { u32x4 w; w.x = cvt_pk_bf16(v0[0], v0[1]); w.y = cvt_pk_bf16(v0[2], v0[3]); w.z = cvt_pk_bf16(v1[0], v1[1]); w.w = cvt_pk_bf16(v1[2], v1[3]);
                    *(u32x4*)(MRGb + row * 1024 + c) = w; } } }
    }
};
struct EpiOut {
    static constexpr bool PERM = false;
    float* PRE; const float* xres; float alpha;
    __device__ __forceinline__ void operator()(const f32x4 (&acc)[2][2][4][2], const Unit& u, int wr, int wc, int fr, int fq) const {
        const int row0 = u.pm * BM + wr * 64 + fr, col0 = u.pn * BM + wc * 32 + 4 * fq;
#pragma unroll
        for (int ai = 0; ai < 2; ++ai) {
            f32x4 xr[4][2][2];
#pragma unroll
            for (int m = 0; m < 4; ++m)
#pragma unroll
                for (int bj = 0; bj < 2; ++bj)
#pragma unroll
                    for (int n = 0; n < 2; ++n) xr[m][bj][n] = *(const f32x4*)(xres + (size_t)(row0 + ai * HALF + m * 16) * 1024 + col0 + bj * HALF + n * 16);
            __builtin_amdgcn_sched_barrier(0);
#pragma unroll
            for (int m = 0; m < 4; ++m) { const size_t ro = (size_t)(row0 + ai * HALF + m * 16) * 1024 + col0;
#pragma unroll
                for (int bj = 0; bj < 2; ++bj)
#pragma unroll
                    for (int n = 0; n < 2; ++n) *(f32x4*)(PRE + ro + bj * HALF + n * 16) = acc[ai][bj][m][n] + xr[m][bj][n] * alpha; }
        }
    }
};
}

__device__ __forceinline__ int early_orig(int e) { return e < 3328 ? e : (e < 4096 ? 4352 + (e - 3328) : (e < 6400 ? 5888 + (e - 4096) : 5120 + (e - 6400))); }
__device__ __forceinline__ int late_orig(int c) { return c < 1024 ? 3328 + c : (c < 1280 ? 8192 + (c - 1024) : 8448 + (c - 1280)); }
__device__ __forceinline__ int my_orig(int n) { return n < NE ? early_orig(n) : late_orig(n - NE); }

__device__ __forceinline__ void convert_tile(const int t, const float* src, int src_ld, bf16_t* dst, int dst_ld, float* lds) {
    const int c = t & 63, r0 = t >> 6;
#pragma unroll
    for (int i = 0; i < 8; ++i) { const int k = r0 + 8 * i; lds[k * 65 + c] = src ? src[(size_t)k * src_ld + c] : 0.f; }
    __syncthreads();
#pragma unroll
    for (int i = 0; i < 8; ++i) { const int n = r0 + 8 * i; dst[(size_t)n * dst_ld + c] = f2bf(lds[c * 65 + n]); }
    __syncthreads();
}

struct CvtTile { const float* src; bf16_t* dst; int src_ld, dst_ld; };
__device__ __forceinline__ CvtTile cvt_decode(const Params& P, unsigned char* ws, int l, int t) {
    bf16_t* WIN = (bf16_t*)(ws + OFF_WIN); bf16_t* LORA = (bf16_t*)(ws + OFF_LORA); bf16_t* POOLW = (bf16_t*)(ws + OFF_POOLW);
    bf16_t* PROJ = (bf16_t*)(ws + OFF_PROJ); bf16_t* WOUT = (bf16_t*)(ws + OFF_WOUT);
    constexpr int N_WIN = 180 * 16, N_LORA = 64 * 4, N_POOL = 12 * 12, N_PROJ = 16 * 32;
    CvtTile d;
    if (t < N_WIN) { const int nt = t >> 4, kt = t & 15; const int n0 = nt * 64, k0 = kt * 64;
        d.src = P.w_in + (size_t)l * 1024 * NIN + (size_t)k0 * NIN + my_orig(n0); d.src_ld = NIN; d.dst = WIN + (size_t)n0 * 1024 + k0; d.dst_ld = 1024; return d; }
    t -= N_WIN;
    if (t < N_LORA) { const int nt = t >> 2, kt = t & 3; const int n0 = nt * 64, seg = n0 >> 10, ch = n0 & 1023;
        d.src = nullptr;
        if (kt == seg) d.src = (seg < 2 ? P.w_up + ((size_t)(l * 2 + seg) * 64) * 1024 : P.a_up + ((size_t)(l * 2 + seg - 2) * 64) * 1024) + ch;
        d.src_ld = 1024; d.dst = LORA + (size_t)n0 * 256 + kt * 64; d.dst_ld = 256; return d; }
    t -= N_LORA;
    if (t < N_POOL) { const int nt = t / 12, kt = t % 12; const int n0 = nt * 64, k0 = kt * 64, gn = n0 / 192, gk = k0 / 192;
        d.src = nullptr;
        if (gn == gk) d.src = P.pool_w + ((size_t)(l * 4 + gn) * 192 + (k0 - 192 * gk)) * 192 + (n0 - 192 * gn);
        d.src_ld = 192; d.dst = POOLW + (size_t)n0 * 768 + k0; d.dst_ld = 768; return d; }
    t -= N_POOL;
    if (t < N_PROJ) { const int nt = t >> 5, kt = t & 31; const int n0 = nt * 64, k0 = kt * 64;
        d.src = k0 < 1024 ? P.proj_a + ((size_t)l * 1024 + k0) * 1024 + n0
                          : (k0 < 1792 ? P.proj_b + ((size_t)l * 768 + (k0 - 1024)) * 1024 + n0 : P.proj_c + ((size_t)l * 256 + (k0 - 1792)) * 1024 + n0);
        d.src_ld = 1024; d.dst = PROJ + (size_t)n0 * 2048 + k0; d.dst_ld = 2048; return d; }
    t -= N_PROJ;
    { const int nt = t >> 4, kt = t & 15; const int n0 = nt * 64, k0 = kt * 64;
        d.src = P.w_out + ((size_t)l * 1024 + k0) * 1024 + n0; d.src_ld = 1024; d.dst = WOUT + (size_t)n0 * 1024 + k0; d.dst_ld = 1024; return d; }
}
__device__ __forceinline__ void convert_weights(const int tid, const int bid, const Params& P, unsigned char* ws, int l, float* lds) {
    float* BIASP = (float*)(ws + OFF_BIASP);
    constexpr int NTILES = 180 * 16 + 64 * 4 + 12 * 12 + 16 * 32 + 16 * 16;
    constexpr int CB = 4;
    const int c = tid & 63, r0 = tid >> 6;
    for (int tile0 = bid; tile0 < NTILES; tile0 += CB * gridDim.x) {
        CvtTile d[CB]; float v[CB][8];
#pragma unroll
        for (int q = 0; q < CB; ++q) { const int t = tile0 + q * gridDim.x; d[q] = cvt_decode(P, ws, l, t < NTILES ? t : tile0); if (t >= NTILES) d[q].dst = nullptr; }
#pragma unroll
        for (int q = 0; q < CB; ++q)
#pragma unroll
            for (int i = 0; i < 8; ++i) { const int k = r0 + 8 * i; v[q][i] = d[q].src ? d[q].src[(size_t)k * d[q].src_ld + c] : 0.f; }
#pragma unroll
        for (int q = 0; q < CB; ++q)
#pragma unroll
            for (int i = 0; i < 8; ++i) { const int k = r0 + 8 * i; lds[q * 4160 + k * 65 + c] = v[q][i]; }
        __syncthreads();
#pragma unroll
        for (int q = 0; q < CB; ++q) if (d[q].dst) {
#pragma unroll
            for (int i = 0; i < 8; ++i) { const int n = r0 + 8 * i; d[q].dst[(size_t)n * d[q].dst_ld + c] = f2bf(lds[q * 4160 + c * 65 + n]); } }
        __syncthreads();
    }
    for (int i = bid * 512 + tid; i < NIN; i += gridDim.x * 512) BIASP[i] = P.b_in[(size_t)l * NIN + my_orig(i)];
}

__device__ __forceinline__ void phase_prepass(const int tid, const int bid, const Params& P, unsigned char* ws, float* lds) {
    bf16_t* XB = (bf16_t*)(ws + OFF_XB); float* ROPE = (float*)(ws + OFF_ROPE);
    const size_t gtid = (size_t)bid * 512 + tid, gsz = (size_t)gridDim.x * 512;
    for (size_t i = gtid; i < (size_t)T_TOK * 1024 / 4; i += gsz) { const f32x4 v = *(const f32x4*)(P.x + i * 4);
        u32x2 w; w.x = cvt_pk_bf16(v[0], v[1]); w.y = cvt_pk_bf16(v[2], v[3]); *(u32x2*)(XB + i * 4) = w; }
    for (size_t i = gtid; i < (size_t)SEQ * 32; i += gsz) { const int pos = (int)(i >> 5), fi = (int)(i & 31);
        double inv = 1.0; for (int j = 0; j < fi; ++j) inv *= 0.7498942093324559;
        const double ang = (double)pos * inv; const double n = rint(ang * 0.15915494309189535); const double r = ang - n * 6.283185307179586476925287;
        const double r2 = r * r; double sn = 1.0, cs = 1.0;
        for (int kk = 25; kk >= 3; kk -= 2) sn = 1.0 - sn * r2 / (double)(kk * (kk - 1));
        sn *= r;
        for (int kk = 24; kk >= 2; kk -= 2) cs = 1.0 - cs * r2 / (double)(kk * (kk - 1));
        ROPE[i * 2] = (float)cs; ROPE[i * 2 + 1] = (float)sn; }
    convert_weights(tid, bid, P, ws, 0, lds);
}

template <int H> __device__ __forceinline__ void pool_quad(const bf16_t* hp  , bf16_t* mp  , int pos0) {
    u32x4 rw[4 + 2 * H];
#pragma unroll
    for (int j = 0; j < 4 + 2 * H; ++j) { const int p = pos0 - H + j; rw[j] = (p >= 0 && p < SEQ) ? *(const u32x4*)(hp + (size_t)p * NE) : (u32x4){0u, 0u, 0u, 0u}; }
#pragma unroll
    for (int i = 0; i < 4; ++i) {
        float acc[8], t8[8], me[8];
#pragma unroll
        for (int j = 0; j < 8; ++j) acc[j] = 0.f;
#pragma unroll
        for (int j = i; j <= i + 2 * H; ++j) { unpack8(rw[j], t8);
#pragma unroll
            for (int q = 0; q < 8; ++q) acc[q] += t8[q]; }
        unpack8(rw[i + H], me);
        const int pos = pos0 + i, lo = max(pos - H, 0), hi = min(pos + H, SEQ - 1); const float ic = 1.0f / (float)(hi - lo + 1);
#pragma unroll
        for (int q = 0; q < 8; ++q) acc[q] = acc[q] * ic - me[q];
        *(u32x4*)(mp + (size_t)pos * 768) = pack8(acc);
    }
}
__device__ __forceinline__ void phase_prep(const int tid, const int bid, const Params& P, unsigned char* ws, int l, float* ldsf, const bool do_rope) {
    const bf16_t* HE = (const bf16_t*)(ws + OFF_A); bf16_t* RKV = (bf16_t*)(ws + OFF_B); float* RN = (float*)(ws + OFF_RN);
    bf16_t* LIN = (bf16_t*)(ws + OFF_LIN); bf16_t* MIX = (bf16_t*)(ws + OFF_MIX); bf16_t* VT = (bf16_t*)(ws + OFF_VT); const float* ROPE = (const float*)(ws + OFF_ROPE);
    bf16_t* QKH = (bf16_t*)(ws + OFF_QKH);
    const float* mu0 = P.mu + (size_t)l * 2 * 3328; const float* mu1 = mu0 + 3328; const float* kk_w = P.k_k + (size_t)l * 1024;
    const int gtid = bid * 512 + tid;
    if (gtid < 416 * 256) {
        const int cg8 = gtid % 416, tg = gtid / 416, c = cg8 * 8;
        float m0[8], m1[8], kw[8];
        { const f32x4 a = *(const f32x4*)(mu0 + c), b = *(const f32x4*)(mu0 + c + 4), d = *(const f32x4*)(mu1 + c), e = *(const f32x4*)(mu1 + c + 4);
#pragma unroll
          for (int j = 0; j < 4; ++j) { m0[j] = a[j]; m0[4 + j] = b[j]; m1[j] = d[j]; m1[4 + j] = e[j]; } }
        const bool is_k = (c >= 1024 && c < 2048);
        if (is_k) { const f32x4 a = *(const f32x4*)(kk_w + c - 1024), b = *(const f32x4*)(kk_w + c - 1024 + 4);
#pragma unroll
            for (int j = 0; j < 4; ++j) { kw[j] = a[j]; kw[4 + j] = b[j]; } }
        else {
#pragma unroll
            for (int j = 0; j < 8; ++j) kw[j] = 0.f; }
        for (int it0 = 0; it0 < 16; it0 += 2) {
            u32x4 rwb[2][6];
#pragma unroll
            for (int h = 0; h < 2; ++h) { const int tq = tg + 256 * (it0 + h), tok0 = tq * 4, pos0 = tok0 & (SEQ - 1); const bf16_t* hp = HE + (size_t)tok0 * NE + c;
#pragma unroll
                for (int j = 0; j < 6; ++j) { const int p = pos0 - 1 + j; rwb[h][j] = (p >= 0 && p < SEQ) ? *(const u32x4*)(hp + (long)(j - 1) * NE) : (u32x4){0u, 0u, 0u, 0u}; } }
            __builtin_amdgcn_sched_barrier(0);
#pragma unroll
            for (int h = 0; h < 2; ++h) {
            const int tq = tg + 256 * (it0 + h), tok0 = tq * 4, pos0 = tok0 & (SEQ - 1);
            float pv[8], cu[8], nx[8];
            unpack8(rwb[h][0], pv); unpack8(rwb[h][1], cu);
#pragma unroll
            for (int i = 0; i < 4; ++i) {
                unpack8(rwb[h][i + 2], nx);
                float o[8];
#pragma unroll
                for (int j = 0; j < 8; ++j) o[j] = cu[j] + m0[j] * (pv[j] - cu[j]) + m1[j] * (nx[j] - cu[j]);
                const int tok = tok0 + i, pos = pos0 + i;
                if (c < 3072) {
                    const int arr = c >> 10, chn = c & 1023;
                    *(u32x4*)(RKV + (size_t)arr * T_TOK * 1024 + ((size_t)((tok >> 11) * 16 + (chn >> 6)) * SEQ + pos) * 64 + (chn & 63)) = pack8(o);
                    if (is_k) { float ss = 0.f;
#pragma unroll
                        for (int j = 0; j < 8; ++j) { const float t = o[j] * kw[j]; ss += t * t; }
                        ss += dppf<DPP_QP1>(ss); ss += dppf<DPP_QP2>(ss); ss += dppf<0x141>(ss);
                        if ((cg8 & 7) == 0) RN[(size_t)((tok >> 11) * 16 + ((c - 1024) >> 6)) * SEQ + pos] = rsqrtf(ss + 1e-12f); }
                } else {
                    if (c < 3200) {
#pragma unroll
                        for (int j = 0; j < 8; ++j) { const float ax = fabsf(o[j]); const float e = __expf(-2.f * ax); const float th = (1.f - e) / (1.f + e); o[j] = o[j] < 0.f ? -th : th; } }
                    *(u32x4*)(LIN + (size_t)tok * 256 + (c - 3072)) = pack8(o);
                }
#pragma unroll
                for (int j = 0; j < 8; ++j) { pv[j] = cu[j]; cu[j] = nx[j]; }
            }
            }
        }
    }
    if (gtid < 96 * 1024) {
        const int cg8 = gtid % 96, tg = gtid / 96, c = cg8 * 8, g = c / 192;
        for (int it = 0; it < 4; ++it) {
            const int tq = tg + 1024 * it, tok0 = tq * 4, pos0 = tok0 & (SEQ - 1); const size_t tb = (size_t)(tok0 - pos0);
            const bf16_t* hp = HE + tb * NE + E_PB + c; bf16_t* mp = MIX + tb * 768 + c;
            if (g == 0) pool_quad<1>(hp, mp, pos0); else if (g == 1) pool_quad<2>(hp, mp, pos0); else if (g == 2) pool_quad<4>(hp, mp, pos0); else pool_quad<8>(hp, mp, pos0);
        }
    }
    if (do_rope && gtid < 96 * 1024) {
        const int r = gtid % 96, tg = gtid / 96, hd24 = r >> 2, jq = r & 3, dsh = 2 * ((hd24 % 12) >> 2);
        for (int it0 = 0; it0 < 16; it0 += 4) {
            u32x4 xa[4], xb[4]; f32x4 csb[4][4];
#pragma unroll
            for (int h = 0; h < 4; ++h) { const int tok = tg + 1024 * (it0 + h), pos = tok & (SEQ - 1);
                const bf16_t* p1 = HE + (size_t)tok * NE + E_Q + hd24 * 64 + jq * 8;
                xa[h] = *(const u32x4*)p1; xb[h] = *(const u32x4*)(p1 + 32);
                const float* rp = ROPE + ((size_t)pos * 32 + jq * 8) * 2;
#pragma unroll
                for (int j = 0; j < 4; ++j) csb[h][j] = *(const f32x4*)(rp + j * 4); }
            __builtin_amdgcn_sched_barrier(0);
#pragma unroll
            for (int h = 0; h < 4; ++h) { const int tok = tg + 1024 * (it0 + h), pos = tok & (SEQ - 1), b = tok >> 11;
                float x1[8], x2[8], o1[8], o2[8];
                unpack8(xa[h], x1); unpack8(xb[h], x2);
#pragma unroll
                for (int j = 0; j < 8; j += 2) { const f32x4 cs = csb[h][j >> 1];
                    o1[j] = x1[j] * cs[0] - x2[j] * cs[1]; o2[j] = x2[j] * cs[0] + x1[j] * cs[1];
                    o1[j + 1] = x1[j + 1] * cs[2] - x2[j + 1] * cs[3]; o2[j + 1] = x2[j + 1] * cs[2] + x1[j + 1] * cs[3]; }
                const int pp = ((pos & ((1 << dsh) - 1)) << (11 - dsh)) + (pos >> dsh);
                bf16_t* q1 = QKH + ((size_t)(b * 24 + hd24) * SEQ + pp) * 64 + jq * 8;
                *(u32x4*)q1 = pack8(o1); *(u32x4*)(q1 + 32) = pack8(o2); }
        }
    }
    if (gtid < 96 * 1024) {
        bf16_t* Op = (bf16_t*)(ws + OFF_O); const int r = gtid % 96, tg = gtid / 96, cz = r * 8;
        for (int it0 = 0; it0 < 16; it0 += 4) { u32x4 zz[4];
#pragma unroll
            for (int h = 0; h < 4; ++h) zz[h] = *(const u32x4*)(HE + (size_t)(tg + 1024 * (it0 + h)) * NE + E_ZB + cz);
#pragma unroll
            for (int h = 0; h < 4; ++h) *(u32x4*)(Op + (size_t)(tg + 1024 * (it0 + h)) * 2048 + cz) = zz[h]; }
    }
    {
        const int lane = tid & 63, wid = tid >> 6;
        bf16_t* lt = (bf16_t*)ldsf + wid * (64 * 72);
        for (int tile = bid * 8 + wid; tile < NB * 12 * 32; tile += gridDim.x * 8) {
            const int pt = tile & 31, bh = tile >> 5, hd = bh % 12, b = bh / 12, dsh = 2 * (hd >> 2), p0 = pt * 64;
            u32x4 w[8];
#pragma unroll
            for (int i = 0; i < 8; ++i) { const int e = lane + 64 * i, tk = e >> 3, c8 = (e & 7) * 8;
                w[i] = *(const u32x4*)(HE + ((size_t)b * SEQ + p0 + tk) * NE + E_V + hd * 64 + c8); }
#pragma unroll
            for (int i = 0; i < 8; ++i) { const int e = lane + 64 * i, tk = e >> 3, c8 = (e & 7) * 8; *(u32x4*)(lt + tk * 72 + c8) = w[i]; }
            asm volatile("s_waitcnt lgkmcnt(0)" ::: "memory");
            bf16_t* vrow = VT + ((size_t)(b * 12 + hd) * 64 + lane) * SEQ;
            const int d = 1 << dsh, run = 64 >> dsh;
#pragma unroll 1
            for (int res = 0; res < d; ++res) {
                const int ppb = (res << (11 - dsh)) + (p0 >> dsh);
#pragma unroll 1
                for (int m = 0; m < run; m += 4) {
                    const unsigned a0 = lt[(res + ((m + 0) << dsh)) * 72 + lane], a1 = lt[(res + ((m + 1) << dsh)) * 72 + lane],
                                   a2 = lt[(res + ((m + 2) << dsh)) * 72 + lane], a3 = lt[(res + ((m + 3) << dsh)) * 72 + lane];
                    u32x2 o; o.x = a0 | (a1 << 16); o.y = a2 | (a3 << 16);
                    *(u32x2*)(vrow + ppb + m) = o; }
            }
            asm volatile("s_waitcnt lgkmcnt(0)" ::: "memory");
        }
    }
}

__device__ __forceinline__ void attn_item(const bf16_t* QKH, const bf16_t* VT, bf16_t* AO, float* LSE, int item, int lane) {
    const int ti = item & 127, bh = item >> 7, hd = bh % 12, b = bh / 12;
    const int dsh = 2 * (hd >> 2), L = SEQ >> dsh, tpr = L >> 4;
    const int res = ti / tpr, m0 = (ti % tpr) << 4;
    const int fr = lane & 15, fq = lane >> 4;
    const size_t tokb = (size_t)b * SEQ + res;
    const bf16_t* qbase = QKH + ((size_t)(b * 24 + hd) * SEQ + (size_t)res * L) * 64 + fq * 8;
    const bf16_t* kbase = qbase + (size_t)12 * SEQ * 64;
    const bf16_t* qp = qbase + (size_t)(m0 + fr) * 64;
    const bf16x8 qf0 = *(const bf16x8*)qp, qf1 = *(const bf16x8*)(qp + 32);
    float sv[10][4];
    float mx = -1e30f;
    bf16x8 kf[10][2];
#pragma unroll
    for (int kt = 0; kt < 10; ++kt) {
        const int kb = m0 - 64 + 32 * (kt >> 1) + 4 * (kt & 1);
        const int mk = kb + 8 * (fr >> 2) + (fr & 3); const int mkc = min(max(mk, 0), L - 1);
        const bf16_t* kp = kbase + (size_t)mkc * 64;
        kf[kt][0] = *(const bf16x8*)kp; kf[kt][1] = *(const bf16x8*)(kp + 32);
    }
    __builtin_amdgcn_sched_barrier(0);
#pragma unroll
    for (int kt = 0; kt < 10; ++kt) {
        const int kb = m0 - 64 + 32 * (kt >> 1) + 4 * (kt & 1);
        f32x4 acc = {0.f, 0.f, 0.f, 0.f};
        acc = __builtin_amdgcn_mfma_f32_16x16x32_bf16(kf[kt][0], qf0, acc, 0, 0, 0);
        acc = __builtin_amdgcn_mfma_f32_16x16x32_bf16(kf[kt][1], qf1, acc, 0, 0, 0);
#pragma unroll
        for (int r = 0; r < 4; ++r) { const int mkk = kb + 8 * fq + r; const int dd = mkk - (m0 + fr);
            const bool valid = (mkk >= 0) && (mkk < L) && (dd <= 64) && (dd >= -64);
            const float s = valid ? acc[r] * 0.125f : -1e30f; sv[kt][r] = s; mx = fmaxf(mx, s); }
    }
    const bf16_t* vbase = VT + ((size_t)(b * 12 + hd) * 64 + fr) * SEQ + (size_t)res * L;
    bf16x8 vf[5][4];
#pragma unroll
    for (int pr = 0; pr < 5; ++pr) {
        const int mkb = m0 - 64 + 32 * pr + 8 * fq; const int k0 = (mkb >= 0 && mkb + 7 < L) ? mkb : 0;
#pragma unroll
        for (int nb = 0; nb < 4; ++nb) vf[pr][nb] = *(const bf16x8*)(vbase + (size_t)nb * 16 * SEQ + k0);
    }
    __builtin_amdgcn_sched_barrier(0);
    mx = fmaxf(mx, bperm(mx, lane ^ 16)); mx = fmaxf(mx, bperm(mx, lane ^ 32));
    float den = 0.f;
#pragma unroll
    for (int kt = 0; kt < 10; ++kt)
#pragma unroll
        for (int r = 0; r < 4; ++r) { const float p = __expf(sv[kt][r] - mx); sv[kt][r] = p; den += p; }
    den += bperm(den, lane ^ 16); den += bperm(den, lane ^ 32);
    f32x4 o[4];
#pragma unroll
    for (int nb = 0; nb < 4; ++nb) o[nb] = (f32x4){0.f, 0.f, 0.f, 0.f};
#pragma unroll
    for (int pr = 0; pr < 5; ++pr) {
        union { bf16x8 v; unsigned u[4]; } af;
        af.u[0] = cvt_pk_bf16(sv[2 * pr][0], sv[2 * pr][1]); af.u[1] = cvt_pk_bf16(sv[2 * pr][2], sv[2 * pr][3]);
        af.u[2] = cvt_pk_bf16(sv[2 * pr + 1][0], sv[2 * pr + 1][1]); af.u[3] = cvt_pk_bf16(sv[2 * pr + 1][2], sv[2 * pr + 1][3]);
#pragma unroll
        for (int nb = 0; nb < 4; ++nb) o[nb] = __builtin_amdgcn_mfma_f32_16x16x32_bf16(af.v, vf[pr][nb], o[nb], 0, 0, 0);
    }
#pragma unroll
    for (int r = 0; r < 4; ++r) { const float dq = bperm(den, 4 * fq + r); const float inv = 1.0f / dq;
        bf16_t* op = AO + (tokb + ((size_t)(m0 + 4 * fq + r) << dsh)) * 768 + hd * 64 + fr;
#pragma unroll
        for (int nb = 0; nb < 4; ++nb) op[nb * 16] = f2bf(o[nb][r] * inv); }
    if (fq == 0) LSE[(tokb + ((size_t)(m0 + fr) << dsh)) * 12 + hd] = mx + __logf(den);
}

#define DPPR8 " row_ror:8 row_mask:0xf bank_mask:0xf\n"
#define DPPQ1 " quad_perm:[1,0,3,2] row_mask:0xf bank_mask:0xf\n"
#define DPPQ2 " quad_perm:[2,3,0,1] row_mask:0xf bank_mask:0xf\n"
#define DPPHM " row_half_mirror row_mask:0xf bank_mask:0xf\n"
#define SCAN_STEP(y, N, W, Kd, Bv, R, vv, s) do { float _sa, _t, _y2; asm volatile( \
    "v_mul_f32 %0, %12, %4\n" "v_mul_f32 %1, %13, %5\n" "v_fmac_f32 %0, %14, %6\n" "v_fmac_f32 %1, %15, %7\n" \
    "v_fmac_f32_dpp %0, %12, %8" DPPR8 "v_fmac_f32_dpp %1, %13, %9" DPPR8 "v_fmac_f32_dpp %0, %14, %10" DPPR8 "v_fmac_f32_dpp %1, %15, %11" DPPR8 \
    "v_add_f32 %0, %0, %1\n" \
    "v_mul_f32 %4, %16, %4\n" "v_mul_f32 %5, %17, %5\n" \
    "v_add_f32_dpp %0, %0, %0" DPPQ1 \
    "v_mul_f32 %6, %18, %6\n" "v_mul_f32 %7, %19, %7\n" \
    "v_add_f32_dpp %0, %0, %0" DPPQ2 \
    "v_mul_f32_dpp %8, %16, %8" DPPR8 "v_mul_f32_dpp %9, %17, %9" DPPR8 \
    "v_add_f32_dpp %0, %0, %0" DPPHM \
    "v_mul_f32_dpp %10, %18, %10" DPPR8 "v_mul_f32_dpp %11, %19, %11" DPPR8 \
    "v_fmac_f32 %4, %20, %32\n" "v_fmac_f32 %5, %21, %32\n" "v_fmac_f32 %6, %22, %32\n" "v_fmac_f32 %7, %23, %32\n" \
    "v_fmac_f32_dpp %8, %20, %32" DPPR8 "v_fmac_f32_dpp %9, %21, %32" DPPR8 "v_fmac_f32_dpp %10, %22, %32" DPPR8 "v_fmac_f32_dpp %11, %23, %32" DPPR8 \
    "v_fmac_f32 %4, %24, %0\n" "v_fmac_f32 %5, %25, %0\n" "v_fmac_f32 %6, %26, %0\n" "v_fmac_f32 %7, %27, %0\n" \
    "v_fmac_f32_dpp %8, %24, %0" DPPR8 "v_fmac_f32_dpp %9, %25, %0" DPPR8 "v_fmac_f32_dpp %10, %26, %0" DPPR8 "v_fmac_f32_dpp %11, %27, %0" DPPR8 \
    "v_mul_f32 %2, %28, %4\n" "v_mul_f32 %3, %29, %5\n" "v_fmac_f32 %2, %30, %6\n" "v_fmac_f32 %3, %31, %7\n" \
    "v_fmac_f32_dpp %2, %28, %8" DPPR8 "v_fmac_f32_dpp %3, %29, %9" DPPR8 "v_fmac_f32_dpp %2, %30, %10" DPPR8 "v_fmac_f32_dpp %3, %31, %11" DPPR8 \
    "v_add_f32 %2, %2, %3\n" "s_nop 1\n" \
    "v_add_f32_dpp %2, %2, %2" DPPQ1 "s_nop 1\n" \
    "v_add_f32_dpp %2, %2, %2" DPPQ2 "s_nop 1\n" \
    "v_add_f32_dpp %2, %2, %2" DPPHM \
    : "=&v"(_sa), "=&v"(_t), "=&v"(y), "=&v"(_y2), "+v"(s[0]), "+v"(s[1]), "+v"(s[2]), "+v"(s[3]), "+v"(s[4]), "+v"(s[5]), "+v"(s[6]), "+v"(s[7]) \
    : "v"(N[0]), "v"(N[1]), "v"(N[2]), "v"(N[3]), "v"(W[0]), "v"(W[1]), "v"(W[2]), "v"(W[3]), "v"(Kd[0]), "v"(Kd[1]), "v"(Kd[2]), "v"(Kd[3]), \
      "v"(Bv[0]), "v"(Bv[1]), "v"(Bv[2]), "v"(Bv[3]), "v"(R[0]), "v"(R[1]), "v"(R[2]), "v"(R[3]), "v"(vv)); } while (0)

__device__ __forceinline__ float row16_sum2(float a, float b, bool odd) {
    float x = odd ? b : a; const float g = odd ? a : b;
    x += dppf<DPP_QP1>(g); x += dppf<DPP_QP2>(x); x += dppf<DPP_ROR4>(x); x += dppf<DPP_ROR8>(x);
    return x;
}
constexpr int SC_CH = 32;
constexpr int SC_STEP_F = 6 * 64;
constexpr int SC_BUF_F = SC_CH * SC_STEP_F;
constexpr int SC_YOFF_F = 2 * SC_BUF_F;
__device__ __forceinline__ void phase_scan_seq(const int tid, const int bid, const Params& P, unsigned char* ws, int l, float* ldsf) {
    const bf16_t* RKV = (const bf16_t*)(ws + OFF_B); const float* RN = (const float*)(ws + OFF_RN); const bf16_t* EA = (const bf16_t*)(ws + OFF_C);
    float* Y = (float*)(ws + OFF_A);
    const int lane = tid & 63, wid = tid >> 6;
    for (int st = bid; st < 256; st += gridDim.x) {
        const int dir = st >> 7, bt = (st >> 4) & 7, hh = st & 15;
        const size_t sbase = (size_t)(bt * 16 + hh) * SEQ;
        const int lp = tid >> 4, c4 = (tid & 15) * 4;
        const int lts = dir ? (SC_CH - 1 - lp) : lp;
        const bf16_t* pr = RKV + (sbase + lp) * 64 + c4; const bf16_t* pk = pr + (size_t)T_TOK * 1024; const bf16_t* pv = pk + (size_t)T_TOK * 1024;
        const bf16_t* pe = EA + (size_t)dir * T_TOK * 1024 + (sbase + lp) * 64 + c4; const bf16_t* pa = pe + (size_t)2 * T_TOK * 1024;
        const float* pn = RN + sbase + lp;
        float* py = Y + (size_t)dir * T_TOK * 1024 + (sbase + lp) * 64 + c4;
        const f32x4 kkc = *(const f32x4*)(P.k_k + (size_t)l * 1024 + hh * 64 + c4), kac = *(const f32x4*)(P.k_a + (size_t)l * 1024 + hh * 64 + c4);
        f32x2 sA[2], sB[2];
        sA[0] = sA[1] = sB[0] = sB[1] = (f32x2){0.f, 0.f};
        const int voff = 4 * (lane & 15);
        const int vrow = 8 * wid + 2 * (lane >> 4);
        const bool odd = (lane & 1) != 0;
        const int yoff = ((lane & 14) == 0) ? (vrow + (lane & 1)) : (2 * SC_CH * 64 + lane);
        u32x2 q_r, q_k, q_v, q_e, q_a; float q_n;
#define SC_P0(cc) (dir ? (SEQ - SC_CH * ((cc) + 1)) : SC_CH * (cc))
#define SC_ISSUE(cc) do { const size_t o_ = (size_t)SC_P0(cc) * 64; q_r = *(const u32x2*)(pr + o_); q_k = *(const u32x2*)(pk + o_); q_v = *(const u32x2*)(pv + o_); \
        q_e = *(const u32x2*)(pe + o_); q_a = *(const u32x2*)(pa + o_); q_n = pn[SC_P0(cc)]; } while (0)
#define SC_COMMIT(cc) do { float* bp_ = ldsf + ((cc) & 1) * SC_BUF_F + lts * SC_STEP_F + c4; \
        const f32x4 k_ = {bflo(q_k.x), bfhi(q_k.x), bflo(q_k.y), bfhi(q_k.y)}, a_ = {bflo(q_a.x), bfhi(q_a.x), bflo(q_a.y), bfhi(q_a.y)}; \
        const f32x4 e_ = {bflo(q_e.x), bfhi(q_e.x), bflo(q_e.y), bfhi(q_e.y)}; \
        const f32x4 kk_ = k_ * kkc * q_n; f32x4 w_; w_[0] = __expf(-e_[0]); w_[1] = __expf(-e_[1]); w_[2] = __expf(-e_[2]); w_[3] = __expf(-e_[3]); \
        *(f32x4*)(bp_) = kk_; *(f32x4*)(bp_ + 64) = w_; *(f32x4*)(bp_ + 128) = k_ * ((a_ - 1.f) * kac + 1.f); *(f32x4*)(bp_ + 192) = -kk_ * a_; \
        *(f32x4*)(bp_ + 256) = (f32x4){bflo(q_r.x), bfhi(q_r.x), bflo(q_r.y), bfhi(q_r.y)}; *(f32x4*)(bp_ + 320) = (f32x4){bflo(q_v.x), bfhi(q_v.x), bflo(q_v.y), bfhi(q_v.y)}; } while (0)
#define SC_FLUSH(cc) do { *(f32x4*)(py + (size_t)SC_P0(cc) * 64) = *(const f32x4*)(ldsf + SC_YOFF_F + ((cc) & 1) * (SC_CH * 64) + lts * 64 + c4); } while (0)
#define SC_BARRIER() do { asm volatile("s_waitcnt lgkmcnt(0)" ::: "memory"); __builtin_amdgcn_s_barrier(); asm volatile("" ::: "memory"); } while (0)
        __syncthreads();
        SC_ISSUE(0); SC_COMMIT(0);
        SC_BARRIER();
        for (int c = 0; c < SEQ / SC_CH; ++c) {
            if (c > 0) SC_FLUSH(c - 1);
            if (c + 1 < SEQ / SC_CH) SC_ISSUE(c + 1);
            const float* buf = ldsf + (c & 1) * SC_BUF_F;
            float* ybuf = ldsf + SC_YOFF_F + (c & 1) * (SC_CH * 64) + yoff;
            f32x4 cN = *(const f32x4*)(buf + voff), cW = *(const f32x4*)(buf + 64 + voff), cK = *(const f32x4*)(buf + 128 + voff), cB = *(const f32x4*)(buf + 192 + voff), cR = *(const f32x4*)(buf + 256 + voff);
            f32x2 cv = *(const f32x2*)(buf + 320 + vrow);
#pragma unroll
            for (int ts = 0; ts < SC_CH; ++ts) {
                f32x4 nN, nW, nK, nB, nR; f32x2 nv;
                if (ts + 1 < SC_CH) { const float* bp = buf + (ts + 1) * SC_STEP_F;
                    nN = *(const f32x4*)(bp + voff); nW = *(const f32x4*)(bp + 64 + voff); nK = *(const f32x4*)(bp + 128 + voff); nB = *(const f32x4*)(bp + 192 + voff); nR = *(const f32x4*)(bp + 256 + voff); nv = *(const f32x2*)(bp + 320 + vrow); }
                const f32x2 N0 = {cN[0], cN[1]}, N1 = {cN[2], cN[3]}, W0 = {cW[0], cW[1]}, W1 = {cW[2], cW[3]}, K0 = {cK[0], cK[1]}, K1 = {cK[2], cK[3]},
                            B0 = {cB[0], cB[1]}, B1 = {cB[2], cB[3]}, R0 = {cR[0], cR[1]}, R1 = {cR[2], cR[3]};
                const f32x2 pa = N0 * sA[0] + N1 * sA[1], pb = N0 * sB[0] + N1 * sB[1];
                const float x = row16_sum2(pa[0] + pa[1], pb[0] + pb[1], odd);
                const float o = dppf<DPP_QP1>(x);
                const float saA = odd ? o : x, saB = odd ? x : o;
                const f32x2 vA = {cv[0], cv[0]}, vB = {cv[1], cv[1]}, aA = {saA, saA}, aB = {saB, saB};
                sA[0] = W0 * sA[0] + K0 * vA + B0 * aA; sA[1] = W1 * sA[1] + K1 * vA + B1 * aA;
                sB[0] = W0 * sB[0] + K0 * vB + B0 * aB; sB[1] = W1 * sB[1] + K1 * vB + B1 * aB;
                const f32x2 qa = R0 * sA[0] + R1 * sA[1], qb = R0 * sB[0] + R1 * sB[1];
                ybuf[ts * 64] = row16_sum2(qa[0] + qa[1], qb[0] + qb[1], odd);
                if (ts + 1 < SC_CH) { cN = nN; cW = nW; cK = nK; cB = nB; cR = nR; cv = nv; }
            }
            if (c + 1 < SEQ / SC_CH) SC_COMMIT(c + 1);
            SC_BARRIER();
        }
        SC_FLUSH(SEQ / SC_CH - 1);
#undef SC_ISSUE
#undef SC_COMMIT
#undef SC_FLUSH
#undef SC_P0
    }
    __syncthreads();
}

namespace sc2 {
constexpr int C = 16;
constexpr int RAW_F = C * 6 * 64;
constexpr int O_RAW = 0;
constexpr int O_NT = 2 * RAW_F * 4;
constexpr int O_BT = O_NT + 2 * 2304, O_KT = O_BT + 2304, O_RT = O_KT + 2304;
constexpr int O_BK = O_RT + 2 * 2304;
constexpr int O_UV = O_BK + 2 * 5120;
constexpr int O_BRKR = O_UV + 2 * 5120;
constexpr int O_ZKN = O_BRKR + 2 * 1280;
constexpr int O_SB = O_ZKN + 1280;
constexpr int O_MB = O_SB + 9216;
constexpr int O_GL = O_MB + 1024;
constexpr int O_PC = O_GL + 4096;
constexpr int O_Y = O_PC + 512;
constexpr int O_END = O_Y + 8192;
}
__device__ __forceinline__ void phase_scan(const int tid, const int bid, const Params& P, unsigned char* ws, int l, float* ldsf) {
    using namespace sc2;
    const bf16_t* RKV = (const bf16_t*)(ws + OFF_B); const float* RN = (const float*)(ws + OFF_RN); const bf16_t* EA = (const bf16_t*)(ws + OFF_C);
    bf16_t* Y = (bf16_t*)(ws + OFF_Y);
    unsigned char* lb = (unsigned char*)ldsf;
    const int lane = tid & 63, wid = tid >> 6, fr = lane & 15, fq = lane >> 4;
    for (int st = bid; st < 256; st += gridDim.x) {
        const int dir = st >> 7, bt = (st >> 4) & 7, hh = st & 15;
        const size_t sbase = (size_t)(bt * 16 + hh) * SEQ;
        const int lp = tid >> 5, c2 = (tid & 31) * 2, lts = dir ? (C - 1 - lp) : lp;
        const unsigned eo = (unsigned)((sbase + lp) * 64 + c2);
        const bf16_t* RKk = RKV + (size_t)T_TOK * 1024; const bf16_t* RKv = RKV + (size_t)2 * T_TOK * 1024;
        const bf16_t* EAe = EA + (size_t)dir * T_TOK * 1024; const bf16_t* EAa = EA + (size_t)(2 + dir) * T_TOK * 1024;
        bf16_t* Yd = Y + (size_t)dir * T_TOK * 1024;
        const float kkc0 = P.k_k[(size_t)l * 1024 + hh * 64 + c2], kkc1 = P.k_k[(size_t)l * 1024 + hh * 64 + c2 + 1];
        const float kac0 = P.k_a[(size_t)l * 1024 + hh * 64 + c2], kac1 = P.k_a[(size_t)l * 1024 + hh * 64 + c2 + 1];
        unsigned qv[2][5]; float qn[2];
#define SC_P0(cc) (dir ? (SEQ - C * ((cc) + 1)) : C * (cc))
#define SC_ISSUE(cc, S) do { const unsigned o_ = eo + (unsigned)(SC_P0(cc) * 64); qv[S][0] = *(const unsigned*)(RKV + o_); qv[S][1] = *(const unsigned*)(RKk + o_); qv[S][2] = *(const unsigned*)(RKv + o_); \
        qv[S][3] = *(const unsigned*)(EAe + o_); qv[S][4] = *(const unsigned*)(EAa + o_); qn[S] = RN[(unsigned)(sbase + lp) + (unsigned)SC_P0(cc)]; } while (0)
#define SC_COMMIT(cc, S) do { float* bp_ = (float*)(lb + O_RAW) + ((cc) & 1) * RAW_F + lts * (6 * 64) + c2; \
        const float k0_ = bflo(qv[S][1]), k1_ = bfhi(qv[S][1]), a0_ = bflo(qv[S][4]), a1_ = bfhi(qv[S][4]); const float kk0_ = k0_ * kkc0 * qn[S], kk1_ = k1_ * kkc1 * qn[S]; \
        *(f32x2*)(bp_) = (f32x2){kk0_, kk1_}; *(f32x2*)(bp_ + 64) = (f32x2){bflo(qv[S][3]), bfhi(qv[S][3])}; \
        *(f32x2*)(bp_ + 128) = (f32x2){k0_ * (1.f + (a0_ - 1.f) * kac0), k1_ * (1.f + (a1_ - 1.f) * kac1)}; *(f32x2*)(bp_ + 192) = (f32x2){-kk0_ * a0_, -kk1_ * a1_}; \
        *(f32x2*)(bp_ + 256) = (f32x2){bflo(qv[S][0]), bfhi(qv[S][0])}; *(f32x2*)(bp_ + 320) = (f32x2){bflo(qv[S][2]), bfhi(qv[S][2])}; } while (0)
#define SC_FLUSH(cc) do { const f32x2 yv_ = *(const f32x2*)((const float*)(lb + O_Y) + ((cc) & 1) * (C * 64) + lts * 64 + c2); *(unsigned*)(Yd + (eo + (unsigned)(SC_P0(cc) * 64))) = cvt_pk_bf16(yv_[0], yv_[1]); } while (0)
#define SC_BARRIER() do { asm volatile("s_waitcnt lgkmcnt(0)" ::: "memory"); __builtin_amdgcn_s_barrier(); asm volatile("" ::: "memory"); } while (0)
#define SC_PREPG(cc, WLO, WHI, TLO, NK) do { if (wid >= (WLO) && wid < (WHI)) { const float* raw_ = (const float*)(lb + O_RAW) + ((cc) & 1) * RAW_F; const int j_ = lane; \
        unsigned char* bk_ = lb + O_BK + ((cc) & 1) * 5120 + j_ * 80; unsigned char* uv_ = lb + O_UV + ((cc) & 1) * 5120 + j_ * 80; \
        unsigned char* nt_b = lb + O_NT + ((cc) & 1) * 2304 + j_ * 2; unsigned char* rt_b = lb + O_RT + ((cc) & 1) * 2304 + j_ * 2; \
        float ev_[15]; _Pragma("unroll") for (int tau_ = 0; tau_ < 15; ++tau_) ev_[tau_] = raw_[tau_ * 384 + 64 + j_]; \
        _Pragma("unroll") for (int k_ = 0; k_ < (NK); ++k_) { const int t_ = (TLO) + (wid - (WLO)) + ((WHI) - (WLO)) * k_; if (t_ < C) { \
            const float* rp_ = raw_ + t_ * 384 + j_; const float i0_ = rp_[0], i1_ = rp_[64], i2_ = rp_[128], i3_ = rp_[192], i4_ = rp_[256], i5_ = rp_[320]; \
            float E_ = 0.f; _Pragma("unroll") for (int tau_ = 0; tau_ < 15; ++tau_) E_ += (tau_ < t_) ? ev_[tau_] : 0.f; \
            const float pprev_ = __expf(-E_); E_ += i1_; const float pc_ = __expf(-E_), ipc_ = __expf(E_); \
            const bf16_t nt_ = f2bf(pprev_ * i0_), bt_ = f2bf(ipc_ * i3_), kt_ = f2bf(ipc_ * i2_), rt_ = f2bf(pc_ * i4_), vv_ = f2bf(i5_); \
            *(bf16_t*)(nt_b + t_ * 144) = nt_; *(bf16_t*)(lb + O_BT + t_ * 144 + j_ * 2) = bt_; *(bf16_t*)(lb + O_KT + t_ * 144 + j_ * 2) = kt_; *(bf16_t*)(rt_b + t_ * 144) = rt_; \
            *(bf16_t*)(bk_ + t_ * 2) = bt_; *(bf16_t*)(bk_ + (16 + t_) * 2) = kt_; *(bf16_t*)(uv_ + (16 + t_) * 2) = vv_; \
            if (t_ == C - 1) *(float*)(lb + O_PC + ((cc) & 1) * 256 + j_ * 4) = pc_; } } } } while (0)
#define SC_PREP(cc) SC_PREPG(cc, 0, 8, 0, 2)
#define SC_PREP_A(cc) SC_PREPG(cc, 0, 4, 0, 1)
#define SC_PREP_B(cc) SC_PREPG(cc, 1, 8, 4, 2)
#define SC_P1(cc) do { if (wid < 4) { \
        const unsigned char* xa_ = lb + ((wid & 1) ? O_KT : O_BT) + fr * 144 + fq * 16; const unsigned char* yb_ = lb + ((wid >> 1) ? O_RT : O_NT) + ((cc) & 1) * 2304 + fr * 144 + fq * 16; \
        f32x4 acc_ = {0.f, 0.f, 0.f, 0.f}; \
        acc_ = __builtin_amdgcn_mfma_f32_16x16x32_bf16(*(const bf16x8*)xa_, *(const bf16x8*)yb_, acc_, 0, 0, 0); \
        acc_ = __builtin_amdgcn_mfma_f32_16x16x32_bf16(*(const bf16x8*)(xa_ + 64), *(const bf16x8*)(yb_ + 64), acc_, 0, 0, 0); \
        _Pragma("unroll") for (int r_ = 0; r_ < 4; ++r_) { const int tau_ = 4 * fq + r_; const bool keep_ = (wid < 2) ? (tau_ < fr) : (tau_ <= fr); acc_[r_] = keep_ ? acc_[r_] : 0.f; } \
        if (wid == 0) *(f32x4*)(lb + O_MB + fr * 64 + fq * 16) = acc_; \
        else { u32x2 w_; w_.x = cvt_pk_bf16(acc_[0], acc_[1]); w_.y = cvt_pk_bf16(acc_[2], acc_[3]); \
            if (wid == 1) { *(u32x2*)(lb + O_ZKN + fr * 80 + (16 + 4 * fq) * 2) = w_; *(u32x2*)(lb + O_ZKN + fr * 80 + (4 * fq) * 2) = (u32x2){0u, 0u}; } \
            else *(u32x2*)(lb + O_BRKR + ((cc) & 1) * 1280 + fr * 80 + ((wid - 2) * 16 + 4 * fq) * 2) = w_; } } } while (0)
        f32x4 sacc[2]; sacc[0] = sacc[1] = (f32x4){0.f, 0.f, 0.f, 0.f};
        const int ib = wid >> 1, jb0 = 2 * (wid & 1);
        __syncthreads();
        for (int i = tid; i < 576; i += 512) *(u32x4*)(lb + O_SB + i * 16) = (u32x4){0u, 0u, 0u, 0u};
        for (int i = tid; i < 640; i += 512) *(u32x4*)(lb + O_UV + i * 16) = (u32x4){0u, 0u, 0u, 0u};
        SC_ISSUE(0, 0); SC_COMMIT(0, 0);
        SC_ISSUE(1, 1); SC_COMMIT(1, 1);
        SC_ISSUE(2, 0); SC_ISSUE(3, 1);
        SC_BARRIER();
        SC_PREP(0);
        SC_BARRIER();
        SC_P1(0);
        SC_BARRIER();
        for (int ch = 0; ch < SEQ / C / 2; ++ch) {
#pragma unroll
        for (int cc = 0; cc < 2; ++cc) {
            const int c = 2 * ch + cc;
            if (c > 0) SC_FLUSH(c - 1);
            if (c + 1 < SEQ / C) SC_PREP_A(c + 1);
            f32x4 hacc = {0.f, 0.f, 0.f, 0.f};
            if (wid >= 4) {
                const int ibb = wid - 4;
                const unsigned char* sa_ = lb + O_SB + (16 * ibb + fr) * 144 + fq * 16;
                const bf16x8 a0 = *(const bf16x8*)sa_, a1 = *(const bf16x8*)(sa_ + 64);
                const bf16x8 av = *(const bf16x8*)(lb + O_UV + (c & 1) * 5120 + (16 * ibb + fr) * 80 + fq * 16);
                const unsigned char* nb_ = lb + O_NT + (c & 1) * 2304 + fr * 144 + fq * 16; const unsigned char* rb_ = lb + O_RT + (c & 1) * 2304 + fr * 144 + fq * 16;
                f32x4 g = {0.f, 0.f, 0.f, 0.f};
                g = __builtin_amdgcn_mfma_f32_16x16x32_bf16(a0, *(const bf16x8*)nb_, g, 0, 0, 0);
                g = __builtin_amdgcn_mfma_f32_16x16x32_bf16(a1, *(const bf16x8*)(nb_ + 64), g, 0, 0, 0);
                g = __builtin_amdgcn_mfma_f32_16x16x32_bf16(av, *(const bf16x8*)(lb + O_ZKN + fr * 80 + fq * 16), g, 0, 0, 0);
                hacc = __builtin_amdgcn_mfma_f32_16x16x32_bf16(a0, *(const bf16x8*)rb_, hacc, 0, 0, 0);
                hacc = __builtin_amdgcn_mfma_f32_16x16x32_bf16(a1, *(const bf16x8*)(rb_ + 64), hacc, 0, 0, 0);
                *(f32x4*)(lb + O_GL + fr * 256 + (16 * ibb + 4 * fq) * 4) = g;
            }
            SC_BARRIER();
            if (wid == 0) {
                const int i = lane; float u[C];
#pragma unroll
                for (int t = 0; t < C; ++t) {
                    float a0 = *(const float*)(lb + O_GL + t * 256 + i * 4), a1 = 0.f;
                    f32x4 m[4];
#pragma unroll
                    for (int q = 0; q < 4; ++q) if (4 * q < t) m[q] = *(const f32x4*)(lb + O_MB + t * 64 + q * 16);
#pragma unroll
                    for (int tau = 0; tau < t; ++tau) { if (tau & 1) a1 += u[tau] * m[tau >> 2][tau & 3]; else a0 += u[tau] * m[tau >> 2][tau & 3]; }
                    u[t] = a0 + a1;
                }
                u32x4 w0, w1;
                w0.x = cvt_pk_bf16(u[0], u[1]); w0.y = cvt_pk_bf16(u[2], u[3]); w0.z = cvt_pk_bf16(u[4], u[5]); w0.w = cvt_pk_bf16(u[6], u[7]);
                w1.x = cvt_pk_bf16(u[8], u[9]); w1.y = cvt_pk_bf16(u[10], u[11]); w1.z = cvt_pk_bf16(u[12], u[13]); w1.w = cvt_pk_bf16(u[14], u[15]);
                *(u32x4*)(lb + O_UV + (c & 1) * 5120 + i * 80) = w0; *(u32x4*)(lb + O_UV + (c & 1) * 5120 + i * 80 + 16) = w1;
            }
            if (c + 1 < SEQ / C) SC_PREP_B(c + 1);
            SC_BARRIER();
            if (wid >= 4) {
                const int ibb = wid - 4;
                const bf16x8 af = *(const bf16x8*)(lb + O_UV + (c & 1) * 5120 + (16 * ibb + fr) * 80 + fq * 16), bf_ = *(const bf16x8*)(lb + O_BRKR + (c & 1) * 1280 + fr * 80 + fq * 16);
                hacc = __builtin_amdgcn_mfma_f32_16x16x32_bf16(af, bf_, hacc, 0, 0, 0);
                *(f32x4*)(lb + O_Y + (c & 1) * (C * 64 * 4) + fr * 256 + (16 * ibb + 4 * fq) * 4) = hacc;
            }
            {
                const bf16x8 af = *(const bf16x8*)(lb + O_UV + (c & 1) * 5120 + (16 * ib + fr) * 80 + fq * 16);
#pragma unroll
                for (int q = 0; q < 2; ++q) {
                    const int j = 16 * (jb0 + q) + fr;
                    const bf16x8 bf_ = *(const bf16x8*)(lb + O_BK + (c & 1) * 5120 + j * 80 + fq * 16);
                    sacc[q] = __builtin_amdgcn_mfma_f32_16x16x32_bf16(af, bf_, sacc[q], 0, 0, 0);
                    const float pc = *(const float*)(lb + O_PC + (c & 1) * 256 + j * 4);
                    sacc[q] *= pc;
#pragma unroll
                    for (int r = 0; r < 4; ++r) *(bf16_t*)(lb + O_SB + (16 * ib + 4 * fq + r) * 144 + j * 2) = f2bf(sacc[q][r]);
                }
            }
            if (c + 1 < SEQ / C) SC_P1(c + 1);
            if (c + 2 < SEQ / C) SC_COMMIT(c + 2, cc);
            if (c + 4 < SEQ / C) SC_ISSUE(c + 4, cc);
            SC_BARRIER();
        }
        }
        SC_FLUSH(SEQ / C - 1);
#undef SC_ISSUE
#undef SC_COMMIT
#undef SC_FLUSH
#undef SC_P0
#undef SC_BARRIER
#undef SC_PREP
#undef SC_P1
    }
    __syncthreads();
}

__device__ __forceinline__ void phase_post(const int tid, const int bid, const Params& P, unsigned char* ws, int l) {
    const bf16_t* Y = (const bf16_t*)(ws + OFF_Y); const bf16_t* RKV = (const bf16_t*)(ws + OFF_B); const bf16_t* HL = (const bf16_t*)(ws + OFF_HL);
    const bf16_t* AO = (const bf16_t*)(ws + OFF_AO); const float* LSE = (const float*)(ws + OFF_LSE); bf16_t* O = (bf16_t*)(ws + OFF_O);
    const float* gg = P.gn_g + (size_t)l * 1024; const float* gb = P.gn_b + (size_t)l * 1024; const float* rk = P.r_k + (size_t)l * 1024;
    const size_t gtid = (size_t)bid * 512 + tid, gsz = (size_t)gridDim.x * 512;
    constexpr int PB = 8;
    for (size_t u0 = gtid; u0 < (size_t)T_TOK * 256; u0 += PB * gsz) {
        u32x2 ya[PB], yb[PB]; u32x2 rw[PB], kw[PB], vw[PB], zw[PB];
#pragma unroll
        for (int k = 0; k < PB; ++k) { size_t u = u0 + k * gsz; if (u >= (size_t)T_TOK * 256) u = u0;
            const size_t tok = u >> 8; const int c = (int)(u & 255) * 4;
            const size_t hm = ((size_t)((tok >> 11) * 16 + (c >> 6)) * SEQ + (tok & 2047)) * 64 + (c & 63);
            ya[k] = *(const u32x2*)(Y + hm); yb[k] = *(const u32x2*)(Y + (size_t)T_TOK * 1024 + hm);
            rw[k] = *(const u32x2*)(RKV + hm); kw[k] = *(const u32x2*)(RKV + (size_t)T_TOK * 1024 + hm); vw[k] = *(const u32x2*)(RKV + (size_t)2 * T_TOK * 1024 + hm);
            zw[k] = *(const u32x2*)(HL + tok * NL + L_ZA + c); }
        __builtin_amdgcn_sched_barrier(0);
#pragma unroll
        for (int k = 0; k < PB; ++k) { const size_t u = u0 + k * gsz; if (u < (size_t)T_TOK * 256) {
            const size_t tok = u >> 8; const int c = (int)(u & 255) * 4;
            const f32x4 y = {bflo(ya[k].x) + bflo(yb[k].x), bfhi(ya[k].x) + bfhi(yb[k].x), bflo(ya[k].y) + bflo(yb[k].y), bfhi(ya[k].y) + bfhi(yb[k].y)};
            const f32x4 rkv = *(const f32x4*)(rk + c);
            const float r4[4] = {bflo(rw[k].x), bfhi(rw[k].x), bflo(rw[k].y), bfhi(rw[k].y)}, k4[4] = {bflo(kw[k].x), bfhi(kw[k].x), bflo(kw[k].y), bfhi(kw[k].y)}, v4[4] = {bflo(vw[k].x), bfhi(vw[k].x), bflo(vw[k].y), bfhi(vw[k].y)};
            float s1 = y[0] + y[1] + y[2] + y[3], bd = r4[0] * k4[0] * rkv[0] + r4[1] * k4[1] * rkv[1] + r4[2] * k4[2] * rkv[2] + r4[3] * k4[3] * rkv[3];
            s1 += dppf<DPP_QP1>(s1); bd += dppf<DPP_QP1>(bd); s1 += dppf<DPP_QP2>(s1); bd += dppf<DPP_QP2>(bd);
            s1 += dppf<DPP_ROR4>(s1); bd += dppf<DPP_ROR4>(bd); s1 += dppf<DPP_ROR8>(s1); bd += dppf<DPP_ROR8>(bd);
            const float mean = s1 * (1.f / 64.f);
            float s2 = 0.f;
#pragma unroll
            for (int j = 0; j < 4; ++j) { const float d = y[j] - mean; s2 += d * d; }
            s2 += dppf<DPP_QP1>(s2); s2 += dppf<DPP_QP2>(s2); s2 += dppf<DPP_ROR4>(s2); s2 += dppf<DPP_ROR8>(s2);
            const float rstd = rsqrtf(s2 * (1.f / 64.f) + 64e-5f);
            const f32x4 g4 = *(const f32x4*)(gg + c), b4 = *(const f32x4*)(gb + c);
            const float z4[4] = {bflo(zw[k].x), bfhi(zw[k].x), bflo(zw[k].y), bfhi(zw[k].y)};
            float o[4];
#pragma unroll
            for (int j = 0; j < 4; ++j) o[j] = ((y[j] - mean) * rstd * g4[j] + b4[j] + bd * v4[j]) * siluf_(z4[j]);
            u32x2 w; w.x = cvt_pk_bf16(o[0], o[1]); w.y = cvt_pk_bf16(o[2], o[3]);
            *(u32x2*)(O + tok * 2048 + c) = w; } }
    }
    for (size_t u0 = gtid; u0 < (size_t)T_TOK * 64; u0 += PB * gsz) {
        float l0[PB], l1[PB], l2[PB]; u32x2 a0[PB], a1[PB], a2[PB], zc[PB];
#pragma unroll
        for (int k = 0; k < PB; ++k) { size_t u = u0 + k * gsz; if (u >= (size_t)T_TOK * 64) u = u0;
            const size_t tok = u >> 6; const int r = (int)(u & 63), hs = r >> 4, d4 = (r & 15) * 4;
            l0[k] = LSE[tok * 12 + hs]; l1[k] = LSE[tok * 12 + 4 + hs]; l2[k] = LSE[tok * 12 + 8 + hs];
            a0[k] = *(const u32x2*)(AO + tok * 768 + hs * 64 + d4); a1[k] = *(const u32x2*)(AO + tok * 768 + (4 + hs) * 64 + d4); a2[k] = *(const u32x2*)(AO + tok * 768 + (8 + hs) * 64 + d4);
            zc[k] = *(const u32x2*)(HL + tok * NL + L_ZC + hs * 64 + d4); }
        __builtin_amdgcn_sched_barrier(0);
#pragma unroll
        for (int k = 0; k < PB; ++k) { const size_t u = u0 + k * gsz; if (u < (size_t)T_TOK * 64) {
            const size_t tok = u >> 6; const int r = (int)(u & 63), hs = r >> 4, d4 = (r & 15) * 4;
            const float lm = fmaxf(l0[k], fmaxf(l1[k], l2[k])); const float e0 = __expf(l0[k] - lm), e1 = __expf(l1[k] - lm), e2 = __expf(l2[k] - lm); const float inv = __builtin_amdgcn_rcpf(e0 + e1 + e2);
            float o[4];
            o[0] = (e0 * bflo(a0[k].x) + e1 * bflo(a1[k].x) + e2 * bflo(a2[k].x)) * inv * siluf_(bflo(zc[k].x));
            o[1] = (e0 * bfhi(a0[k].x) + e1 * bfhi(a1[k].x) + e2 * bfhi(a2[k].x)) * inv * siluf_(bfhi(zc[k].x));
            o[2] = (e0 * bflo(a0[k].y) + e1 * bflo(a1[k].y) + e2 * bflo(a2[k].y)) * inv * siluf_(bflo(zc[k].y));
            o[3] = (e0 * bfhi(a0[k].y) + e1 * bfhi(a1[k].y) + e2 * bfhi(a2[k].y)) * inv * siluf_(bfhi(zc[k].y));
            u32x2 w; w.x = cvt_pk_bf16(o[0], o[1]); w.y = cvt_pk_bf16(o[2], o[3]);
            *(u32x2*)(O + tok * 2048 + 1792 + hs * 64 + d4) = w; } }
    }
}

__device__ __forceinline__ void phase_ln(const int tid, const int bid, const Params& P, unsigned char* ws, int l) {
    const float* PRE = (const float*)(ws + OFF_A); bf16_t* XB = (bf16_t*)(ws + OFF_XB);
    const float* g = P.ln_g + (size_t)l * 1024; const float* bb = P.ln_b + (size_t)l * 1024;
    const int lane = tid & 63, wid = tid >> 6;
    constexpr int LR = 8;
    for (int row0 = (bid * 8 + wid) * LR; row0 < T_TOK; row0 += gridDim.x * 8 * LR) {
        f32x4 v[LR][4]; float s[LR], s2[LR], mean[LR], rstd[LR];
#pragma unroll
        for (int q = 0; q < LR; ++q) { const float* pr = PRE + (size_t)(row0 + q) * 1024;
#pragma unroll
            for (int i = 0; i < 4; ++i) v[q][i] = *(const f32x4*)(pr + i * 256 + lane * 4); }
        __builtin_amdgcn_sched_barrier(0);
#pragma unroll
        for (int q = 0; q < LR; ++q) { s[q] = 0.f;
#pragma unroll
            for (int i = 0; i < 4; ++i) s[q] += v[q][i][0] + v[q][i][1] + v[q][i][2] + v[q][i][3]; }
#pragma unroll
        for (int q = 0; q < LR; ++q) { float t = s[q]; t += dppf<DPP_QP1>(t); t += dppf<DPP_QP2>(t); t += dppf<DPP_ROR4>(t); t += dppf<DPP_ROR8>(t); t += bperm(t, lane ^ 16); t += bperm(t, lane ^ 32); mean[q] = t * (1.f / 1024.f); }
#pragma unroll
        for (int q = 0; q < LR; ++q) { float t = 0.f;
#pragma unroll
            for (int i = 0; i < 4; ++i)
#pragma unroll
                for (int j = 0; j < 4; ++j) { const float d = v[q][i][j] - mean[q]; t += d * d; }
            s2[q] = t; }
#pragma unroll
        for (int q = 0; q < LR; ++q) { float t = s2[q]; t += dppf<DPP_QP1>(t); t += dppf<DPP_QP2>(t); t += dppf<DPP_ROR4>(t); t += dppf<DPP_ROR8>(t); t += bperm(t, lane ^ 16); t += bperm(t, lane ^ 32); rstd[q] = rsqrtf(t * (1.f / 1024.f) + 1e-5f); }
#pragma unroll
        for (int q = 0; q < LR; ++q)
#pragma unroll
            for (int i = 0; i < 4; ++i) { const int c = i * 256 + lane * 4; const f32x4 g4 = *(const f32x4*)(g + c), b4 = *(const f32x4*)(bb + c);
                f32x4 o; for (int j = 0; j < 4; ++j) o[j] = (v[q][i][j] - mean[q]) * rstd[q] * g4[j] + b4[j];
                *(f32x4*)(P.out + (size_t)(row0 + q) * 1024 + c) = o;
                u32x2 w; w.x = cvt_pk_bf16(o[0], o[1]); w.y = cvt_pk_bf16(o[2], o[3]); *(u32x2*)(XB + (size_t)(row0 + q) * 1024 + c) = w; }
    }
}

#define XB_TMO      128
#define XB_XCNT(j)  (256  + 64 * (j))
#define XB_XSUB(j)  (1280 + 64 * (j))
#define XB_XGEN(j)  (2304 + 64 * (j))
#define XB_TOP      3328
#define XB_TOPGEN   3392
#define XCD_BAR_WORDS 3456
#define XB_SPIN_CAP (1u << 20)
__device__ __forceinline__ unsigned xb_ld(unsigned* p)              { return __hip_atomic_load(p, __ATOMIC_RELAXED, __HIP_MEMORY_SCOPE_AGENT); }
__device__ __forceinline__ unsigned xb_add(unsigned* p, unsigned v) { return __hip_atomic_fetch_add(p, v, __ATOMIC_RELAXED, __HIP_MEMORY_SCOPE_AGENT); }
__device__ __forceinline__ unsigned xb_xcc_id() { return (unsigned)__builtin_amdgcn_s_getreg((3 << 11) | 20) & 0xFu; }
#define XB_SPIN(cond, bar) do { unsigned _sp = 0; while (cond) { __builtin_amdgcn_s_sleep(1); \
    if ((++_sp & 255u) == 0u) { if (xb_ld(&(bar)[XB_TMO])) break; if (_sp > XB_SPIN_CAP) { atomicAdd(&(bar)[XB_TMO], 1u); break; } } } } while (0)
struct XcdBarrier { unsigned* bar; unsigned x; volatile LAS unsigned* st; };
__device__ __forceinline__ XcdBarrier xcd_barrier_post(unsigned* bar, volatile LAS unsigned* st) {
    XcdBarrier b; b.bar = bar; b.x = xb_xcc_id(); b.st = st;
    if (threadIdx.x == 0) (void)xb_add(&bar[XB_XCNT(b.x)], 1u);
    return b;
}
__device__ __forceinline__ void xcd_barrier_complete(unsigned* bar, unsigned x, unsigned& nloc, unsigned& nx) {
    const unsigned G = gridDim.x * gridDim.y * gridDim.z;
    unsigned sum, cnt, mine, sp = 0u;
    for (;;) {
        sum = 0u; cnt = 0u; mine = 0u;
#pragma unroll
        for (unsigned j = 0; j < 16; ++j) { const unsigned c = xb_ld(&bar[XB_XCNT(j)]); sum += c; cnt += (c > 0u) ? 1u : 0u; mine = (j == x) ? c : mine; }
        if (sum == G) break;
        __builtin_amdgcn_s_sleep(1);
        if ((++sp & 255u) == 0u) { if (xb_ld(&bar[XB_TMO])) break; if (sp > XB_SPIN_CAP) { atomicAdd(&bar[XB_TMO], 1u); break; } }
    }
    nloc = mine > 0u ? mine : 1u; nx = cnt > 0u ? cnt : 1u;
}
__device__ __forceinline__ void xcd_barrier(const XcdBarrier& b) {
    asm volatile("s_waitcnt vmcnt(0)" ::: "memory");
    __syncthreads();
    if (threadIdx.x == 0) {
        unsigned* bar = b.bar;
        __builtin_amdgcn_s_waitcnt(0);
        unsigned nloc = b.st[0], nx = b.st[1];
        if (nloc == 0u) { xcd_barrier_complete(bar, b.x, nloc, nx); b.st[0] = nloc; b.st[1] = nx; }
        const unsigned old = xb_add(&bar[XB_XSUB(b.x)], 1u);
        const unsigned gen = old / nloc;
        if (old + 1u == (gen + 1u) * nloc) {
            __builtin_amdgcn_fence(__ATOMIC_RELEASE, "agent");
            asm volatile("s_waitcnt vmcnt(0)" ::: "memory");
            const unsigned og = xb_add(&bar[XB_TOP], 1u);
            const unsigned tg = og / nx;
            if (og + 1u == (tg + 1u) * nx) xb_add(&bar[XB_TOPGEN], 1u);
            else XB_SPIN(xb_ld(&bar[XB_TOPGEN]) == tg, bar);
            __builtin_amdgcn_fence(__ATOMIC_ACQUIRE, "agent");
            xb_add(&bar[XB_XGEN(b.x)], 1u);
            asm volatile("s_waitcnt vmcnt(0)" ::: "memory");
        } else {
            XB_SPIN(xb_ld(&bar[XB_XGEN(b.x)]) == gen, bar);
            __builtin_amdgcn_fence(__ATOMIC_ACQUIRE, "agent");
            asm volatile("s_waitcnt vmcnt(0)" ::: "memory");
        }
    }
    __syncthreads();
}

constexpr int PER = 8;
constexpr int N_PH = 1 + PER * DEPTH;
__global__ void __launch_bounds__(512, 2) fwd_kernel(Params P) {
    extern __shared__ __attribute__((aligned(16))) unsigned char shm[];
    LAS unsigned char* lds = (LAS unsigned char*)shm; float* ldsf = (float*)shm;
    const int G = (int)gridDim.x;
#if !MK_MULTI
    volatile LAS unsigned* xst = (volatile LAS unsigned*)(lds + 131072);
    if (threadIdx.x == 0) { xst[0] = 0u; xst[1] = 0u; }
    __syncthreads();
    const XcdBarrier xb = xcd_barrier_post((unsigned*)(P.ws + OFF_BAR), xst);
#endif
    for (int ph = P.ph_lo; ph < P.ph_hi; ++ph) {
        int tid = threadIdx.x; asm volatile("" : "+v"(tid));
        int c = blockIdx.x; asm volatile("" : "+s"(c));
        size_t wz = 0; asm volatile("" : "+s"(wz)); const Params& PP = *(const Params*)((const char*)&P + wz); unsigned char* ws = PP.ws;
        if (ph == 0) { phase_prepass(tid, c, PP, ws, ldsf); }
        else {
            const int l = (ph - 1) / PER, slot = (ph - 1) % PER, k = slot < 4 ? slot : slot + 1;
            const int rep = 0;
            switch (k) {
            case 0: {
                pg8::Gemm g{(const bf16_t*)(ws + OFF_XB), (const bf16_t*)(ws + OFF_WIN), T_TOK, NE, 1024};
                pg8::StaticOrder S; S.init(T_TOK, NE, 1024, G, c);
                pg8::EpiBias E{(bf16_t*)(ws + OFF_A), NE, (const float*)(ws + OFF_BIASP)};
                pg8::gemm_phase(tid, lds, g, S, E); } break;
            case 1: phase_prep(tid, c, PP, ws, l, ldsf, rep == 0); break;
            case 2: {
                if (!rep || MK_SUB < 0 || MK_SUB == 0) { pg8::Gemm g{(const bf16_t*)(ws + OFF_LIN), (const bf16_t*)(ws + OFF_LORA), T_TOK, 4096, 256};
                  pg8::StaticOrder S; S.init(T_TOK, 4096, 256, G, c);
                  pg8::EpiLora E{(bf16_t*)(ws + OFF_C), PP.w0 + (size_t)l * 2048, PP.a0 + (size_t)l * 2048};
                  pg8::gemm_phase(tid, lds, g, S, E); }
                {
                  pg8::Gemm g{(const bf16_t*)(ws + OFF_XB), (const bf16_t*)(ws + OFF_WIN) + (size_t)NE * 1024, T_TOK, NL, 1024};
                  pg8::StaticOrder S; S.init(T_TOK, NL, 1024, G, c);
                  pg8::EpiBias E{(bf16_t*)(ws + OFF_HL), NL, (const float*)(ws + OFF_BIASP) + NE};
                  pg8::gemm_phase(tid, lds, g, S, E); }
                if (!rep || MK_SUB < 0 || MK_SUB == 1) { pg8::Gemm g{(const bf16_t*)(ws + OFF_MIX), (const bf16_t*)(ws + OFF_POOLW), T_TOK, 768, 768};
                  pg8::StaticOrder S; S.init(T_TOK, 768, 768, G, G - 1 - c);
                  pg8::EpiPool E{(bf16_t*)(ws + OFF_O), (const bf16_t*)(ws + OFF_A), PP.pool_b + (size_t)l * 768, PP.pool_scale + (size_t)l * 768};
                  pg8::gemm_phase(tid, lds, g, S, E); }
                if (!rep || MK_SUB < 0 || MK_SUB == 2) { const int lane = tid & 63, wid = tid >> 6;
                  if (G == 256) {
                      for (int k6 = 0; k6 < 6; ++k6)
                          attn_item((const bf16_t*)(ws + OFF_QKH), (const bf16_t*)(ws + OFF_VT), (bf16_t*)(ws + OFF_AO), (float*)(ws + OFF_LSE), (c * 8 + wid) * 6 + k6, lane);
                  } else
                  for (int item = c * 8 + wid; item < NB * 12 * 128; item += G * 8)
                      attn_item((const bf16_t*)(ws + OFF_QKH), (const bf16_t*)(ws + OFF_VT), (bf16_t*)(ws + OFF_AO), (float*)(ws + OFF_LSE), item, lane); }
                } break;
            case 3: phase_scan(tid, c, PP, ws, l, ldsf); break;
            case 5: phase_post(tid, c, PP, ws, l); break;
            case 6: {
                pg8::Gemm g{(const bf16_t*)(ws + OFF_O), (const bf16_t*)(ws + OFF_PROJ), T_TOK, 1024, 2048};
                pg8::MergeOrder S; S.init(G, c);
                pg8::EpiMerge E{(bf16_t*)(ws + OFF_D), (const bf16_t*)(ws + OFF_HL)};
                pg8::gemm_phase<pg8::EpiMerge, pg8::MergeOrder, true>(tid, lds, g, S, E); } break;
            case 7: {
                pg8::Gemm g{(const bf16_t*)(ws + OFF_D), (const bf16_t*)(ws + OFF_WOUT), T_TOK, 1024, 1024};
                pg8::StaticOrder S; S.init(T_TOK, 1024, 1024, G, c);
                pg8::EpiOut E{(float*)(ws + OFF_A), l == 0 ? PP.x : (const float*)PP.out, 1.681792830507429f};
                pg8::gemm_phase(tid, lds, g, S, E); } break;
            case 8: phase_ln(tid, c, PP, ws, l); if (l + 1 < DEPTH) convert_weights(tid, c, PP, ws, l + 1, ldsf); break;
            }
        }
#if !MK_MULTI
        if (ph + 1 < P.ph_hi) { if (ph == 0) cg::this_grid().sync(); else xcd_barrier(xb); }
#endif
    }
}

extern "C" void kernel_launch(void* const* d_in, const int* in_sizes, int n_in, void* d_out, int out_size, void* d_ws, size_t ws_size, hipStream_t stream) {
    constexpr size_t kDynLds = 131072 + 64;
    static int grid_blocks = 0;
    if (!grid_blocks) {
        hipFuncSetAttribute((const void*)fwd_kernel, hipFuncAttributeMaxDynamicSharedMemorySize, (int)kDynLds);
        int dev = 0, cus = 0, per_cu = 0;
        hipGetDevice(&dev);
        hipDeviceGetAttribute(&cus, hipDeviceAttributeMultiprocessorCount, dev);
        hipOccupancyMaxActiveBlocksPerMultiprocessor(&per_cu, fwd_kernel, 512, kDynLds);
        if (per_cu < 1) per_cu = 1;
        grid_blocks = cus * per_cu;
        if (grid_blocks > 256) grid_blocks = 256;
        if (ws_size < WS_TOTAL) fprintf(stderr, "workspace too small: %zu < %zu\n", ws_size, (size_t)WS_TOTAL);
    }
    Params p{};
    p.x = (const float*)d_in[0]; p.w_in = (const float*)d_in[1]; p.b_in = (const float*)d_in[2]; p.mu = (const float*)d_in[3]; p.w0 = (const float*)d_in[4];
    p.w_up = (const float*)d_in[5]; p.a0 = (const float*)d_in[6]; p.a_up = (const float*)d_in[7]; p.k_k = (const float*)d_in[8]; p.k_a = (const float*)d_in[9];
    p.r_k = (const float*)d_in[10]; p.gn_g = (const float*)d_in[11]; p.gn_b = (const float*)d_in[12]; p.pool_w = (const float*)d_in[13]; p.pool_b = (const float*)d_in[14];
    p.pool_scale = (const float*)d_in[15]; p.proj_a = (const float*)d_in[16]; p.proj_b = (const float*)d_in[17]; p.proj_c = (const float*)d_in[18]; p.w_out = (const float*)d_in[19];
    p.ln_g = (const float*)d_in[20]; p.ln_b = (const float*)d_in[21];
    p.out = (float*)d_out; p.ws = (unsigned char*)d_ws;
#if MK_MULTI
    for (int ph = 0; ph < N_PH; ++ph) { p.ph_lo = ph; p.ph_hi = ph + 1;
        hipLaunchKernelGGL(fwd_kernel, dim3(grid_blocks), dim3(512), kDynLds, stream, p); }
#else
    p.ph_lo = 0; p.ph_hi = N_PH;
    hipMemsetAsync((unsigned char*)d_ws + OFF_BAR, 0, 16384, stream);
    void* args[] = {&p};
    hipError_t e = hipLaunchCooperativeKernel((void*)fwd_kernel, dim3(grid_blocks), dim3(512), args, kDynLds, stream);
    if (e != hipSuccess) fprintf(stderr, "cooperative launch failed: %s (grid %d)\n", hipGetErrorString(e), grid_blocks);
#endif
}
```

```cpp
#include <hip/hip_runtime.h>
#include <hip/hip_cooperative_groups.h>
#include <cstdio>
namespace cg = cooperative_groups;

#ifndef MK_REP
#define MK_REP -1
#endif
#ifndef MK_SUB
#define MK_SUB -1
#endif
#ifndef MK_MULTI
#define MK_MULTI 0
#endif

typedef unsigned short bf16_t;
typedef short bf16x8 __attribute__((ext_vector_type(8)));
typedef short bf16x4 __attribute__((ext_vector_type(4)));
typedef float f32x4 __attribute__((ext_vector_type(4)));
typedef unsigned u32x4 __attribute__((ext_vector_type(4)));
typedef unsigned u32x2 __attribute__((ext_vector_type(2)));
typedef float f32x2 __attribute__((ext_vector_type(2)));
#define LAS __attribute__((address_space(3)))

constexpr int T_TOK = 16384, SEQ = 2048, NB = 8, DM = 1024, DEPTH = 4;
constexpr int NE = 7168, NL = 4352, NIN = 11520;
constexpr int E_PB = 3328, E_Q = 4096, E_K = 4864, E_V = 5632, E_ZB = 6400;
constexpr int L_ZA = 0, L_ZC = 1024, L_GA = 1280;

constexpr size_t OFF_WIN = 0;
constexpr size_t OFF_LORA = OFF_WIN + (size_t)NIN * 1024 * 2;
constexpr size_t OFF_POOLW = OFF_LORA + (size_t)4096 * 256 * 2;
constexpr size_t OFF_PROJ = OFF_POOLW + (size_t)768 * 768 * 2;
constexpr size_t OFF_WOUT = OFF_PROJ + (size_t)1024 * 2048 * 2;
constexpr size_t OFF_BIASP = OFF_WOUT + (size_t)1024 * 1024 * 2;
constexpr size_t OFF_ROPE = OFF_BIASP + (size_t)NIN * 4;
constexpr size_t OFF_XB = OFF_ROPE + (size_t)SEQ * 64 * 4;
constexpr size_t OFF_A = OFF_XB + (size_t)T_TOK * 1024 * 2;
constexpr size_t OFF_HL = OFF_A;
constexpr size_t OFF_Y = OFF_A + (size_t)T_TOK * NL * 2;
constexpr size_t OFF_B = OFF_A + (size_t)T_TOK * NE * 2;
constexpr size_t OFF_RN = OFF_B + (size_t)T_TOK * 3072 * 2;
constexpr size_t OFF_C = OFF_RN + (size_t)T_TOK * 16 * 4;
constexpr size_t OFF_D = OFF_C + (size_t)T_TOK * NL * 2;
constexpr size_t OFF_LIN = OFF_D;
constexpr size_t OFF_MIX = OFF_LIN + (size_t)T_TOK * 256 * 2;
constexpr size_t OFF_VT = OFF_MIX + (size_t)T_TOK * 768 * 2;
constexpr size_t OFF_AO = OFF_VT + (size_t)T_TOK * 768 * 2;
constexpr size_t OFF_LSE = OFF_AO + (size_t)T_TOK * 768 * 2;
constexpr size_t OFF_O = OFF_LSE + (size_t)T_TOK * 12 * 4;
constexpr size_t OFF_QKH = OFF_O + (size_t)T_TOK * 2048 * 2;
constexpr size_t OFF_BAR = OFF_QKH + (size_t)T_TOK * 1536 * 2;
constexpr size_t WS_TOTAL = OFF_BAR + 16384;

struct Params {
    const float* x; const float* w_in; const float* b_in; const float* mu; const float* w0; const float* w_up; const float* a0; const float* a_up;
    const float* k_k; const float* k_a; const float* r_k; const float* gn_g; const float* gn_b; const float* pool_w; const float* pool_b; const float* pool_scale;
    const float* proj_a; const float* proj_b; const float* proj_c; const float* w_out; const float* ln_g; const float* ln_b;
    float* out; unsigned char* ws; int ph_lo, ph_hi;
};

__device__ __forceinline__ float bf2f(bf16_t v) { return __uint_as_float(((unsigned)v) << 16); }
__device__ __forceinline__ float bflo(unsigned w) { return __uint_as_float(w << 16); }
__device__ __forceinline__ float bfhi(unsigned w) { return __uint_as_float(w & 0xffff0000u); }
__device__ __forceinline__ unsigned cvt_pk_bf16(float lo, float hi) { unsigned r; asm volatile("v_cvt_pk_bf16_f32 %0, %1, %2" : "=v"(r) : "v"(lo), "v"(hi)); return r; }
__device__ __forceinline__ bf16_t f2bf(float f) { return (bf16_t)(cvt_pk_bf16(f, 0.f) & 0xffffu); }
__device__ __forceinline__ float sigmoidf_(float v) { return __builtin_amdgcn_rcpf(1.0f + __expf(-v)); }
__device__ __forceinline__ float siluf_(float v) { return v * __builtin_amdgcn_rcpf(1.0f + __expf(-v)); }
__device__ __forceinline__ float bperm(float v, int srclane) { return __builtin_bit_cast(float, __builtin_amdgcn_ds_bpermute(srclane << 2, __builtin_bit_cast(int, v))); }
constexpr int DPP_QP1 = 0xB1, DPP_QP2 = 0x4E, DPP_ROR4 = 0x124, DPP_ROR8 = 0x128;
template <int CTRL> __device__ __forceinline__ float dppf(float v) {
    return __builtin_bit_cast(float, __builtin_amdgcn_update_dpp(0, __builtin_bit_cast(int, v), CTRL, 0xf, 0xf, true));
}
__device__ __forceinline__ void unpack8(u32x4 w, float* f) {
    f[0] = bflo(w.x); f[1] = bfhi(w.x); f[2] = bflo(w.y); f[3] = bfhi(w.y); f[4] = bflo(w.z); f[5] = bfhi(w.z); f[6] = bflo(w.w); f[7] = bfhi(w.w);
}
__device__ __forceinline__ u32x4 pack8(const float* f) {
    u32x4 w; w.x = cvt_pk_bf16(f[0], f[1]); w.y = cvt_pk_bf16(f[2], f[3]); w.z = cvt_pk_bf16(f[4], f[5]); w.w = cvt_pk_bf16(f[6], f[7]); return w;
}

namespace pg8 {
constexpr int BM = 256, BK = 64, HALF = 128, HTB = HALF * BK * 2, STAGE_BYTES = 8 * HTB, NXCD = 8, WGM = 8;
__device__ __forceinline__ int lds_byte(int r, int c) { const int st = (r >> 4) * 2 + (c >> 5), rr = r & 15, cc = c & 31, ob = rr * 64 + cc * 2; return st * 1024 + (ob ^ (((ob >> 9) & 1) << 5)); }
__device__ __forceinline__ void stage_rc(int b, int& R, int& C) { const int st = b / 1024, sb = b % 1024, swz = sb ^ (((sb >> 9) & 1) << 5); R = (st >> 1) * 16 + swz / 64; C = (st & 1) * 32 + (swz % 64) / 2; }
__device__ __forceinline__ int perm32(int rho) { const int n = rho >> 4, i = rho & 15; return 8 * (i >> 2) + 4 * n + (i & 3); }

struct Unit { int pm, pn, koff, nt, tag; };
struct Gemm { const bf16_t* A; const bf16_t* Bt; int M, N, ld; };

struct StaticOrder {
    int nM, nN, nwg, G, c, nt;
    __device__ void init(int M, int N, int K, int G_, int c_) { nM = M / BM; nN = N / BM; nwg = nM * nN; G = G_; c = c_; nt = K / BK; }
    __device__ bool next(int i, Unit& u) const {
        const long L = (long)i * G + c; if (L >= nwg) return false;
        int wgid = (int)L; { const int q = nwg / NXCD, r = nwg % NXCD, xcd = wgid % NXCD, off = wgid / NXCD; wgid = (xcd < r ? xcd * (q + 1) : r * (q + 1) + (xcd - r) * q) + off; }
        const int nig = WGM * nN, gid = wgid / nig, fm = gid * WGM, gsz = (nM - fm) < WGM ? (nM - fm) : WGM;
        u.pm = fm + ((wgid % nig) % gsz); u.pn = (wgid % nig) / gsz; u.koff = 0; u.nt = nt; u.tag = 0; return true;
    }
};
struct MergeOrder {
    int G, c;
    __device__ void init(int G_, int c_) { G = G_; c = c_; }
    __device__ bool next(int i, Unit& u) const {
        const int ti = i / 3, br = i - ti * 3; const int cx = (G == 256) ? ((c & 7) * 32 + (c >> 3)) : c;
        const long L = (long)ti * G + cx; if (L >= 512) return false;
        u.pm = (int)(L >> 2); u.pn = (int)(L & 3); u.tag = br;
        u.koff = br == 0 ? 0 : (br == 1 ? 1024 : 1792); u.nt = br == 0 ? 16 : (br == 1 ? 12 : 4); return true;
    }
};

template <class Epi, class Sched, bool HM = false>
__device__ __forceinline__ void gemm_phase(const int tid, LAS unsigned char* lds, const Gemm g, const Sched& S, const Epi& E) {
    const int wid = __builtin_amdgcn_readfirstlane(tid >> 6), lane = tid & 63, wr = wid >> 2, wc = wid & 3, fr = lane & 15, fq = lane >> 4;
    const int K = g.ld;
    unsigned voffA[2], voffB[2];
#pragma unroll
    for (int i = 0; i < 2; ++i) { int R, C; stage_rc(tid * 16 + i * 8192, R, C); const int Rb = Epi::PERM ? ((R & ~31) + perm32(R & 31)) : R;
        voffA[i] = (unsigned)(R * K + C) * 2u; voffB[i] = (unsigned)(Rb * K + C) * 2u; }
    const size_t kstep = (size_t)(BK * 2);
    const size_t hstep = (size_t)HALF * K * 2;
    const size_t tstep = 2 * hstep;
    const size_t astep = HM ? hstep : tstep;
    const size_t h1 = HM ? 0 : hstep;
    const unsigned ldsw = (unsigned)wid * 1024u;
    const int aoff = lds_byte(wr * 64 + fr, fq * 8), boff = lds_byte(wc * 32 + fr, fq * 8);
#define PG8_SA(b, h) (((b) * 2 + (h)) * HTB)
#define PG8_SB(b, h) ((4 + (b) * 2 + (h)) * HTB)
#define PG8_STAGE(bufoff, gbase, voff) do { _Pragma("unroll") for (int _i = 0; _i < 2; ++_i) \
        __builtin_amdgcn_global_load_lds((const unsigned*)((const char*)(gbase) + (voff)[_i]), (LAS unsigned*)(lds + (bufoff) + ldsw + _i * 8192), 16, 0, 0); } while (0)
#define PG8_LDA(dst, b, h) do { _Pragma("unroll") for (int m = 0; m < 4; ++m) _Pragma("unroll") for (int k = 0; k < 2; ++k) dst[m][k] = *(const LAS bf16x8*)(lds + PG8_SA(b, h) + aoff + m * 2048 + k * 1024); } while (0)
#define PG8_LDB(dst, b, h) do { _Pragma("unroll") for (int n = 0; n < 2; ++n) _Pragma("unroll") for (int k = 0; k < 2; ++k) dst[n][k] = *(const LAS bf16x8*)(lds + PG8_SB(b, h) + boff + n * 2048 + k * 1024); } while (0)
#define PG8_MMA(ai, bj, At, Bt) do { __builtin_amdgcn_s_setprio(1); _Pragma("unroll") for (int m = 0; m < 4; ++m) _Pragma("unroll") for (int n = 0; n < 2; ++n) _Pragma("unroll") for (int k = 0; k < 2; ++k) \
        acc[ai][bj][m][n] = __builtin_amdgcn_mfma_f32_16x16x32_bf16(Bt[n][k], At[m][k], acc[ai][bj][m][n], 0, 0, 0); __builtin_amdgcn_s_setprio(0); } while (0)
#define PG8_WAIT_V(n) asm volatile("s_waitcnt vmcnt(" #n ")" ::: "memory")
#define PG8_WAIT_L(n) asm volatile("s_waitcnt lgkmcnt(" #n ")" ::: "memory")
#define PG8_BAR __builtin_amdgcn_s_barrier()
#define PG8_SCHED __builtin_amdgcn_sched_barrier(0)
    Unit cur, nxt; int ui = 0;
    if (!S.next(0, cur)) return;
    f32x4 acc[2][2][4][2];
#pragma unroll
    for (int a = 0; a < 2; ++a)
#pragma unroll
        for (int b = 0; b < 2; ++b)
#pragma unroll
            for (int m = 0; m < 4; ++m)
#pragma unroll
                for (int n = 0; n < 2; ++n) acc[a][b][m][n] = (f32x4){0.f, 0.f, 0.f, 0.f};
    bf16x8 At[4][2], B0[2][2], B1[2][2];
    f32x4 tot[2][4][2];
    if constexpr (HM) {
#pragma unroll
        for (int b = 0; b < 2; ++b)
#pragma unroll
            for (int m = 0; m < 4; ++m)
#pragma unroll
                for (int n = 0; n < 2; ++n) tot[b][m][n] = (f32x4){0.f, 0.f, 0.f, 0.f}; }
    const char* cA = (const char*)g.A + (size_t)cur.pm * astep + (size_t)cur.koff * 2; const char* cB = (const char*)g.Bt + (size_t)cur.pn * tstep + (size_t)cur.koff * 2;
    PG8_STAGE(PG8_SB(0, 0), cB, voffB); PG8_STAGE(PG8_SA(0, 0), cA, voffA); PG8_STAGE(PG8_SB(0, 1), cB + hstep, voffB); PG8_STAGE(PG8_SA(0, 1), cA + h1, voffA);
    if (wr == 1) PG8_BAR;
    PG8_WAIT_V(4); PG8_BAR;
    PG8_STAGE(PG8_SB(1, 0), cB + kstep, voffB); PG8_STAGE(PG8_SA(1, 0), cA + kstep, voffA); PG8_STAGE(PG8_SB(1, 1), cB + hstep + kstep, voffB);
    PG8_WAIT_V(6); PG8_BAR;
    for (;;) {
        const bool has_next = S.next(ui + 1, nxt);
        const char* nA = has_next ? (const char*)g.A + (size_t)nxt.pm * astep + (size_t)nxt.koff * 2 : cA; const char* nB = has_next ? (const char*)g.Bt + (size_t)nxt.pn * tstep + (size_t)nxt.koff * 2 : cB;
        const int nt = cur.nt;
        for (int t = 0; t < nt; t += 2) {
            const bool last = (t == nt - 2);
            const char* a1 = cA + (size_t)(t + 1) * kstep;
            const char* a2 = last ? nA : cA + (size_t)(t + 2) * kstep; const char* b2 = last ? nB : cB + (size_t)(t + 2) * kstep;
            const char* a3 = a2 + kstep; const char* b3 = b2 + kstep;
            PG8_LDB(B0, 0, 0); PG8_SCHED; PG8_LDA(At, 0, 0); PG8_STAGE(PG8_SA(1, 1), a1 + h1, voffA);
            PG8_WAIT_L(8); PG8_BAR; PG8_WAIT_L(0); PG8_MMA(0, 0, At, B0); PG8_BAR; PG8_SCHED;
            PG8_LDB(B1, 0, 1); PG8_STAGE(PG8_SB(0, 0), b2, voffB);
            PG8_BAR; PG8_WAIT_L(0); PG8_MMA(0, 1, At, B1); PG8_BAR;
            if constexpr (!HM) PG8_LDA(At, 0, 1);
            PG8_STAGE(PG8_SA(0, 0), a2, voffA);
            PG8_BAR; PG8_WAIT_L(0); if constexpr (!HM) PG8_MMA(1, 0, At, B0); PG8_BAR; PG8_SCHED;
            PG8_STAGE(PG8_SB(0, 1), b2 + hstep, voffB);
            PG8_WAIT_V(6); PG8_BAR; if constexpr (!HM) PG8_MMA(1, 1, At, B1); PG8_BAR;
            PG8_LDB(B0, 1, 0); PG8_SCHED; PG8_LDA(At, 1, 0); PG8_STAGE(PG8_SA(0, 1), a2 + h1, voffA);
            PG8_WAIT_L(8); PG8_BAR; PG8_WAIT_L(0); PG8_MMA(0, 0, At, B0); PG8_BAR; PG8_SCHED;
            PG8_LDB(B1, 1, 1); PG8_STAGE(PG8_SB(1, 0), b3, voffB);
            PG8_BAR; PG8_WAIT_L(0); PG8_MMA(0, 1, At, B1); PG8_BAR;
            if constexpr (!HM) PG8_LDA(At, 1, 1);
            PG8_STAGE(PG8_SA(1, 0), a3, voffA);
            PG8_BAR; PG8_WAIT_L(0); if constexpr (!HM) PG8_MMA(1, 0, At, B0); PG8_BAR; PG8_SCHED;
            PG8_STAGE(PG8_SB(1, 1), b3 + hstep, voffB);
            PG8_WAIT_V(6); PG8_BAR; if constexpr (!HM) PG8_MMA(1, 1, At, B1); PG8_BAR;
        }
        if constexpr (HM) E(acc, tot, cur, wr, wc, fr, fq); else E(acc, cur, wr, wc, fr, fq);
        if (!has_next) break;
#pragma unroll
        for (int a = 0; a < 2; ++a)
#pragma unroll
            for (int b = 0; b < 2; ++b)
#pragma unroll
                for (int m = 0; m < 4; ++m)
#pragma unroll
                    for (int n = 0; n < 2; ++n) acc[a][b][m][n] = (f32x4){0.f, 0.f, 0.f, 0.f};
        cur = nxt; cA = nA; cB = nB; ++ui;
    }
    PG8_WAIT_V(0);
    if (wr == 0) PG8_BAR;
    PG8_BAR;
#undef PG8_SA
#undef PG8_SB
#undef PG8_STAGE
#undef PG8_LDA
#undef PG8_LDB
#undef PG8_MMA
#undef PG8_WAIT_V
#undef PG8_WAIT_L
#undef PG8_BAR
#undef PG8_SCHED
}

struct EpiBias {
    static constexpr bool PERM = true;
    bf16_t* O; int ldc; const float* bias;
    __device__ __forceinline__ void operator()(const f32x4 (&acc)[2][2][4][2], const Unit& u, int wr, int wc, int fr, int fq) const {
        const int row0 = u.pm * BM + wr * 64 + fr, col0 = u.pn * BM + wc * 32 + 8 * fq;
        f32x4 bv[2][2];
#pragma unroll
        for (int bj = 0; bj < 2; ++bj)
#pragma unroll
            for (int n = 0; n < 2; ++n) bv[bj][n] = *(const f32x4*)(bias + col0 + bj * HALF + 4 * n);
#pragma unroll
        for (int ai = 0; ai < 2; ++ai)
#pragma unroll
            for (int m = 0; m < 4; ++m) { bf16_t* rowp = O + (size_t)(row0 + ai * HALF + m * 16) * ldc + col0;
#pragma unroll
                for (int bj = 0; bj < 2; ++bj) { f32x4 v0 = acc[ai][bj][m][0] + bv[bj][0], v1 = acc[ai][bj][m][1] + bv[bj][1];
                    u32x4 w; w.x = cvt_pk_bf16(v0[0], v0[1]); w.y = cvt_pk_bf16(v0[2], v0[3]); w.z = cvt_pk_bf16(v1[0], v1[1]); w.w = cvt_pk_bf16(v1[2], v1[3]);
                    *(u32x4*)(rowp + bj * HALF) = w; } }
    }
};
struct EpiLora {
    static constexpr bool PERM = true;
    bf16_t* EA; const float* w0; const float* a0;
    __device__ __forceinline__ void operator()(const f32x4 (&acc)[2][2][4][2], const Unit& u, int wr, int wc, int fr, int fq) const {
        const int row0 = u.pm * BM + wr * 64 + fr, colt = u.pn * BM, seg = colt >> 10, col0 = (colt & 1023) + wc * 32 + 8 * fq;
        const float* bp = (seg < 2 ? w0 + seg * 1024 : a0 + (seg - 2) * 1024) + col0;
        const float sc = seg < 2 ? 0.60653065971f : 1.0f;
        bf16_t* base = EA + (size_t)seg * T_TOK * 1024;
        f32x4 bv[2][2];
#pragma unroll
        for (int bj = 0; bj < 2; ++bj)
#pragma unroll
            for (int n = 0; n < 2; ++n) bv[bj][n] = *(const f32x4*)(bp + bj * HALF + 4 * n);
#pragma unroll
        for (int ai = 0; ai < 2; ++ai)
#pragma unroll
            for (int m = 0; m < 4; ++m) { const int row = row0 + ai * HALF + m * 16;
#pragma unroll
                for (int bj = 0; bj < 2; ++bj) { f32x4 v0 = acc[ai][bj][m][0] + bv[bj][0], v1 = acc[ai][bj][m][1] + bv[bj][1];
#pragma unroll
                    for (int j = 0; j < 4; ++j) { v0[j] = sc * sigmoidf_(v0[j]); v1[j] = sc * sigmoidf_(v1[j]); }
                    u32x4 w; w.x = cvt_pk_bf16(v0[0], v0[1]); w.y = cvt_pk_bf16(v0[2], v0[3]); w.z = cvt_pk_bf16(v1[0], v1[1]); w.w = cvt_pk_bf16(v1[2], v1[3]);
                    const int cc = col0 + bj * HALF;
                    *(u32x4*)(base + ((size_t)((row >> 11) * 16 + (cc >> 6)) * SEQ + (row & 2047)) * 64 + (cc & 63)) = w; } }
    }
};
struct EpiPool {
    static constexpr bool PERM = true;
    bf16_t* O; const bf16_t* HE; const float* pb; const float* ps;
    __device__ __forceinline__ void operator()(const f32x4 (&acc)[2][2][4][2], const Unit& u, int wr, int wc, int fr, int fq) const {
        const int row0 = u.pm * BM + wr * 64 + fr, col0 = u.pn * BM + wc * 32 + 8 * fq;
        f32x4 bv[2][2], sv[2][2];
#pragma unroll
        for (int bj = 0; bj < 2; ++bj)
#pragma unroll
            for (int n = 0; n < 2; ++n) { bv[bj][n] = *(const f32x4*)(pb + col0 + bj * HALF + 4 * n); sv[bj][n] = *(const f32x4*)(ps + col0 + bj * HALF + 4 * n); }
#pragma unroll
        for (int ai = 0; ai < 2; ++ai) {
            u32x4 zv[4][2];
#pragma unroll
            for (int m = 0; m < 4; ++m)
#pragma unroll
                for (int bj = 0; bj < 2; ++bj) zv[m][bj] = *(const u32x4*)(O + (size_t)(row0 + ai * HALF + m * 16) * 2048 + col0 + bj * HALF);
            __builtin_amdgcn_sched_barrier(0);
#pragma unroll
            for (int m = 0; m < 4; ++m) { const size_t row = (size_t)(row0 + ai * HALF + m * 16);
#pragma unroll
                for (int bj = 0; bj < 2; ++bj) { const int c = col0 + bj * HALF;
                    float z[8]; unpack8(zv[m][bj], z);
                    f32x4 v0 = (acc[ai][bj][m][0] + bv[bj][0]) * sv[bj][0], v1 = (acc[ai][bj][m][1] + bv[bj][1]) * sv[bj][1];
#pragma unroll
                    for (int j = 0; j < 4; ++j) { v0[j] *= siluf_(z[j]); v1[j] *= siluf_(z[4 + j]); }
                    u32x4 w; w.x = cvt_pk_bf16(v0[0], v0[1]); w.y = cvt_pk_bf16(v0[2], v0[3]); w.z = cvt_pk_bf16(v1[0], v1[1]); w.w = cvt_pk_bf16(v1[2], v1[3]);
                    *(u32x4*)(O + row * 2048 + 1024 + c) = w; } }
        }
    }
};
struct EpiMerge {
    static constexpr bool PERM = true;
    bf16_t* MRGb; const bf16_t* HL;
    __device__ __forceinline__ void operator()(const f32x4 (&acc)[2][2][4][2], f32x4 (&tot)[2][4][2], const Unit& u, int wr, int wc, int fr, int fq) const {
        const int row0 = u.pm * HALF + wr * 64 + fr, col0 = u.pn * BM + wc * 32 + 8 * fq, br = u.tag;
        u32x4 gv[4][2];
#pragma unroll
        for (int m = 0; m < 4; ++m)
#pragma unroll
            for (int bj = 0; bj < 2; ++bj) gv[m][bj] = *(const u32x4*)(HL + (size_t)(row0 + m * 16) * NL + L_GA + br * 1024 + col0 + bj * HALF);
        __builtin_amdgcn_sched_barrier(0);
#pragma unroll
        for (int m = 0; m < 4; ++m) { const size_t row = (size_t)(row0 + m * 16);
#pragma unroll
            for (int bj = 0; bj < 2; ++bj) { const int c = col0 + bj * HALF;
                float gt[8]; unpack8(gv[m][bj], gt);
                f32x4 v0 = acc[0][bj][m][0], v1 = acc[0][bj][m][1];
#pragma unroll
                for (int j = 0; j < 4; ++j) { v0[j] *= sigmoidf_(gt[j]); v1[j] *= sigmoidf_(gt[4 + j]); }
                if (br > 0) { v0 += tot[bj][m][0]; v1 += tot[bj][m][1]; }
                tot[bj][m][0] = v0; tot[bj][m][1] = v1;
                if (br == 2) { u32x4 w; w.x = cvt_pk_bf16(v0[0], v0[1]); w.y = cvt_pk_bf16(v0[2], v0[3]); w.z = cvt_pk_bf16(v1[0], v1[1]); w.w = cvt_pk_bf16(v1[2], v1[3]);
                    *(u32x4*)(MRGb + row * 1024 + c) = w; } } }
    }
};
struct EpiOut {
    static constexpr bool PERM = false;
    float* PRE; const float* xres; float alpha;
    __device__ __forceinline__ void operator()(const f32x4 (&acc)[2][2][4][2], const Unit& u, int wr, int wc, int fr, int fq) const {
        const int row0 = u.pm * BM + wr * 64 + fr, col0 = u.pn * BM + wc * 32 + 4 * fq;
#pragma unroll
        for (int ai = 0; ai < 2; ++ai) {
            f32x4 xr[4][2][2];
#pragma unroll
            for (int m = 0; m < 4; ++m)
#pragma unroll
                for (int bj = 0; bj < 2; ++bj)
#pragma unroll
                    for (int n = 0; n < 2; ++n) xr[m][bj][n] = *(const f32x4*)(xres + (size_t)(row0 + ai * HALF + m * 16) * 1024 + col0 + bj * HALF + n * 16);
            __builtin_amdgcn_sched_barrier(0);
#pragma unroll
            for (int m = 0; m < 4; ++m) { const size_t ro = (size_t)(row0 + ai * HALF + m * 16) * 1024 + col0;
#pragma unroll
                for (int bj = 0; bj < 2; ++bj)
#pragma unroll
                    for (int n = 0; n < 2; ++n) *(f32x4*)(PRE + ro + bj * HALF + n * 16) = acc[ai][bj][m][n] + xr[m][bj][n] * alpha; }
        }
    }
};
}

__device__ __forceinline__ int early_orig(int e) { return e < 3328 ? e : (e < 4096 ? 4352 + (e - 3328) : (e < 6400 ? 5888 + (e - 4096) : 5120 + (e - 6400))); }
__device__ __forceinline__ int late_orig(int c) { return c < 1024 ? 3328 + c : (c < 1280 ? 8192 + (c - 1024) : 8448 + (c - 1280)); }
__device__ __forceinline__ int my_orig(int n) { return n < NE ? early_orig(n) : late_orig(n - NE); }

__device__ __forceinline__ void convert_tile(const int t, const float* src, int src_ld, bf16_t* dst, int dst_ld, float* lds) {
    const int c = t & 63, r0 = t >> 6;
#pragma unroll
    for (int i = 0; i < 8; ++i) { const int k = r0 + 8 * i; lds[k * 65 + c] = src ? src[(size_t)k * src_ld + c] : 0.f; }
    __syncthreads();
#pragma unroll
    for (int i = 0; i < 8; ++i) { const int n = r0 + 8 * i; dst[(size_t)n * dst_ld + c] = f2bf(lds[c * 65 + n]); }
    __syncthreads();
}

struct CvtTile { const float* src; bf16_t* dst; int src_ld, dst_ld; };
__device__ __forceinline__ CvtTile cvt_decode(const Params& P, unsigned char* ws, int l, int t) {
    bf16_t* WIN = (bf16_t*)(ws + OFF_WIN); bf16_t* LORA = (bf16_t*)(ws + OFF_LORA); bf16_t* POOLW = (bf16_t*)(ws + OFF_POOLW);
    bf16_t* PROJ = (bf16_t*)(ws + OFF_PROJ); bf16_t* WOUT = (bf16_t*)(ws + OFF_WOUT);
    constexpr int N_WIN = 180 * 16, N_LORA = 64 * 4, N_POOL = 12 * 12, N_PROJ = 16 * 32;
    CvtTile d;
    if (t < N_WIN) { const int nt = t >> 4, kt = t & 15; const int n0 = nt * 64, k0 = kt * 64;
        d.src = P.w_in + (size_t)l * 1024 * NIN + (size_t)k0 * NIN + my_orig(n0); d.src_ld = NIN; d.dst = WIN + (size_t)n0 * 1024 + k0; d.dst_ld = 1024; return d; }
    t -= N_WIN;
    if (t < N_LORA) { const int nt = t >> 2, kt = t & 3; const int n0 = nt * 64, seg = n0 >> 10, ch = n0 & 1023;
        d.src = nullptr;
        if (kt == seg) d.src = (seg < 2 ? P.w_up + ((size_t)(l * 2 + seg) * 64) * 1024 : P.a_up + ((size_t)(l * 2 + seg - 2) * 64) * 1024) + ch;
        d.src_ld = 1024; d.dst = LORA + (size_t)n0 * 256 + kt * 64; d.dst_ld = 256; return d; }
    t -= N_LORA;
    if (t < N_POOL) { const int nt = t / 12, kt = t % 12; const int n0 = nt * 64, k0 = kt * 64, gn = n0 / 192, gk = k0 / 192;
        d.src = nullptr;
        if (gn == gk) d.src = P.pool_w + ((size_t)(l * 4 + gn) * 192 + (k0 - 192 * gk)) * 192 + (n0 - 192 * gn);
        d.src_ld = 192; d.dst = POOLW + (size_t)n0 * 768 + k0; d.dst_ld = 768; return d; }
    t -= N_POOL;
    if (t < N_PROJ) { const int nt = t >> 5, kt = t & 31; const int n0 = nt * 64, k0 = kt * 64;
        d.src = k0 < 1024 ? P.proj_a + ((size_t)l * 1024 + k0) * 1024 + n0
                          : (k0 < 1792 ? P.proj_b + ((size_t)l * 768 + (k0 - 1024)) * 1024 + n0 : P.proj_c + ((size_t)l * 256 + (k0 - 1792)) * 1024 + n0);
        d.src_ld = 1024; d.dst = PROJ + (size_t)n0 * 2048 + k0; d.dst_ld = 2048; return d; }
    t -= N_PROJ;
    { const int nt = t >> 4, kt = t & 15; const int n0 = nt * 64, k0 = kt * 64;
        d.src = P.w_out + ((size_t)l * 1024 + k0) * 1024 + n0; d.src_ld = 1024; d.dst = WOUT + (size_t)n0 * 1024 + k0; d.dst_ld = 1024; return d; }
}
__device__ __forceinline__ void convert_weights(const int tid, const int bid, const Params& P, unsigned char* ws, int l, float* lds) {
    float* BIASP = (float*)(ws + OFF_BIASP);
    constexpr int NTILES = 180 * 16 + 64 * 4 + 12 * 12 + 16 * 32 + 16 * 16;
    constexpr int CB = 4;
    const int c = tid & 63, r0 = tid >> 6;
    for (int tile0 = bid; tile0 < NTILES; tile0 += CB * gridDim.x) {
        CvtTile d[CB]; float v[CB][8];
#pragma unroll
        for (int q = 0; q < CB; ++q) { const int t = tile0 + q * gridDim.x; d[q] = cvt_decode(P, ws, l, t < NTILES ? t : tile0); if (t >= NTILES) d[q].dst = nullptr; }
#pragma unroll
        for (int q = 0; q < CB; ++q)
#pragma unroll
            for (int i = 0; i < 8; ++i) { const int k = r0 + 8 * i; v[q][i] = d[q].src ? d[q].src[(size_t)k * d[q].src_ld + c] : 0.f; }
#pragma unroll
        for (int q = 0; q < CB; ++q)
#pragma unroll
            for (int i = 0; i < 8; ++i) { const int k = r0 + 8 * i; lds[q * 4160 + k * 65 + c] = v[q][i]; }
        __syncthreads();
#pragma unroll
        for (int q = 0; q < CB; ++q) if (d[q].dst) {
#pragma unroll
            for (int i = 0; i < 8; ++i) { const int n = r0 + 8 * i; d[q].dst[(size_t)n * d[q].dst_ld + c] = f2bf(lds[q * 4160 + c * 65 + n]); } }
        __syncthreads();
    }
    for (int i = bid * 512 + tid; i < NIN; i += gridDim.x * 512) BIASP[i] = P.b_in[(size_t)l * NIN + my_orig(i)];
}

__device__ __forceinline__ void phase_prepass(const int tid, const int bid, const Params& P, unsigned char* ws, float* lds) {
    bf16_t* XB = (bf16_t*)(ws + OFF_XB); float* ROPE = (float*)(ws + OFF_ROPE);
    const size_t gtid = (size_t)bid * 512 + tid, gsz = (size_t)gridDim.x * 512;
    for (size_t i = gtid; i < (size_t)T_TOK * 1024 / 4; i += gsz) { const f32x4 v = *(const f32x4*)(P.x + i * 4);
        u32x2 w; w.x = cvt_pk_bf16(v[0], v[1]); w.y = cvt_pk_bf16(v[2], v[3]); *(u32x2*)(XB + i * 4) = w; }
    for (size_t i = gtid; i < (size_t)SEQ * 32; i += gsz) { const int pos = (int)(i >> 5), fi = (int)(i & 31);
        double inv = 1.0; for (int j = 0; j < fi; ++j) inv *= 0.7498942093324559;
        const double ang = (double)pos * inv; const double n = rint(ang * 0.15915494309189535); const double r = ang - n * 6.283185307179586476925287;
        const double r2 = r * r; double sn = 1.0, cs = 1.0;
        for (int kk = 25; kk >= 3; kk -= 2) sn = 1.0 - sn * r2 / (double)(kk * (kk - 1));
        sn *= r;
        for (int kk = 24; kk >= 2; kk -= 2) cs = 1.0 - cs * r2 / (double)(kk * (kk - 1));
        ROPE[i * 2] = (float)cs; ROPE[i * 2 + 1] = (float)sn; }
    convert_weights(tid, bid, P, ws, 0, lds);
}

template <int H> __device__ __forceinline__ void pool_quad(const bf16_t* hp  , bf16_t* mp  , int pos0) {
    u32x4 rw[4 + 2 * H];
#pragma unroll
    for (int j = 0; j < 4 + 2 * H; ++j) { const int p = pos0 - H + j; rw[j] = (p >= 0 && p < SEQ) ? *(const u32x4*)(hp + (size_t)p * NE) : (u32x4){0u, 0u, 0u, 0u}; }
#pragma unroll
    for (int i = 0; i < 4; ++i) {
        float acc[8], t8[8], me[8];
#pragma unroll
        for (int j = 0; j < 8; ++j) acc[j] = 0.f;
#pragma unroll
        for (int j = i; j <= i + 2 * H; ++j) { unpack8(rw[j], t8);
#pragma unroll
            for (int q = 0; q < 8; ++q) acc[q] += t8[q]; }
        unpack8(rw[i + H], me);
        const int pos = pos0 + i, lo = max(pos - H, 0), hi = min(pos + H, SEQ - 1); const float ic = 1.0f / (float)(hi - lo + 1);
#pragma unroll
        for (int q = 0; q < 8; ++q) acc[q] = acc[q] * ic - me[q];
        *(u32x4*)(mp + (size_t)pos * 768) = pack8(acc);
    }
}
__device__ __forceinline__ void phase_prep(const int tid, const int bid, const Params& P, unsigned char* ws, int l, float* ldsf, const bool do_rope) {
    const bf16_t* HE = (const bf16_t*)(ws + OFF_A); bf16_t* RKV = (bf16_t*)(ws + OFF_B); float* RN = (float*)(ws + OFF_RN);
    bf16_t* LIN = (bf16_t*)(ws + OFF_LIN); bf16_t* MIX = (bf16_t*)(ws + OFF_MIX); bf16_t* VT = (bf16_t*)(ws + OFF_VT); const float* ROPE = (const float*)(ws + OFF_ROPE);
    bf16_t* QKH = (bf16_t*)(ws + OFF_QKH);
    const float* mu0 = P.mu + (size_t)l * 2 * 3328; const float* mu1 = mu0 + 3328; const float* kk_w = P.k_k + (size_t)l * 1024;
    const int gtid = bid * 512 + tid;
    if (gtid < 416 * 256) {
        const int cg8 = gtid % 416, tg = gtid / 416, c = cg8 * 8;
        float m0[8], m1[8], kw[8];
        { const f32x4 a = *(const f32x4*)(mu0 + c), b = *(const f32x4*)(mu0 + c + 4), d = *(const f32x4*)(mu1 + c), e = *(const f32x4*)(mu1 + c + 4);
#pragma unroll
          for (int j = 0; j < 4; ++j) { m0[j] = a[j]; m0[4 + j] = b[j]; m1[j] = d[j]; m1[4 + j] = e[j]; } }
        const bool is_k = (c >= 1024 && c < 2048);
        if (is_k) { const f32x4 a = *(const f32x4*)(kk_w + c - 1024), b = *(const f32x4*)(kk_w + c - 1024 + 4);
#pragma unroll
            for (int j = 0; j < 4; ++j) { kw[j] = a[j]; kw[4 + j] = b[j]; } }
        else {
#pragma unroll
            for (int j = 0; j < 8; ++j) kw[j] = 0.f; }
        for (int it0 = 0; it0 < 16; it0 += 2) {
            u32x4 rwb[2][6];
#pragma unroll
            for (int h = 0; h < 2; ++h) { const int tq = tg + 256 * (it0 + h), tok0 = tq * 4, pos0 = tok0 & (SEQ - 1); const bf16_t* hp = HE + (size_t)tok0 * NE + c;
#pragma unroll
                for (int j = 0; j < 6; ++j) { const int p = pos0 - 1 + j; rwb[h][j] = (p >= 0 && p < SEQ) ? *(const u32x4*)(hp + (long)(j - 1) * NE) : (u32x4){0u, 0u, 0u, 0u}; } }
            __builtin_amdgcn_sched_barrier(0);
#pragma unroll
            for (int h = 0; h < 2; ++h) {
            const int tq = tg + 256 * (it0 + h), tok0 = tq * 4, pos0 = tok0 & (SEQ - 1);
            float pv[8], cu[8], nx[8];
            unpack8(rwb[h][0], pv); unpack8(rwb[h][1], cu);
#pragma unroll
            for (int i = 0; i < 4; ++i) {
                unpack8(rwb[h][i + 2], nx);
                float o[8];
#pragma unroll
                for (int j = 0; j < 8; ++j) o[j] = cu[j] + m0[j] * (pv[j] - cu[j]) + m1[j] * (nx[j] - cu[j]);
                const int tok = tok0 + i, pos = pos0 + i;
                if (c < 3072) {
                    const int arr = c >> 10, chn = c & 1023;
                    *(u32x4*)(RKV + (size_t)arr * T_TOK * 1024 + ((size_t)((tok >> 11) * 16 + (chn >> 6)) * SEQ + pos) * 64 + (chn & 63)) = pack8(o);
                    if (is_k) { float ss = 0.f;
#pragma unroll
                        for (int j = 0; j < 8; ++j) { const float t = o[j] * kw[j]; ss += t * t; }
                        ss += dppf<DPP_QP1>(ss); ss += dppf<DPP_QP2>(ss); ss += dppf<0x141>(ss);
                        if ((cg8 & 7) == 0) RN[(size_t)((tok >> 11) * 16 + ((c - 1024) >> 6)) * SEQ + pos] = rsqrtf(ss + 1e-12f); }
                } else {
                    if (c < 3200) {
#pragma unroll
                        for (int j = 0; j < 8; ++j) { const float ax = fabsf(o[j]); const float e = __expf(-2.f * ax); const float th = (1.f - e) / (1.f + e); o[j] = o[j] < 0.f ? -th : th; } }
                    *(u32x4*)(LIN + (size_t)tok * 256 + (c - 3072)) = pack8(o);
                }
#pragma unroll
                for (int j = 0; j < 8; ++j) { pv[j] = cu[j]; cu[j] = nx[j]; }
            }
            }
        }
    }
    if (gtid < 96 * 1024) {
        const int cg8 = gtid % 96, tg = gtid / 96, c = cg8 * 8, g = c / 192;
        for (int it = 0; it < 4; ++it) {
            const int tq = tg + 1024 * it, tok0 = tq * 4, pos0 = tok0 & (SEQ - 1); const size_t tb = (size_t)(tok0 - pos0);
            const bf16_t* hp = HE + tb * NE + E_PB + c; bf16_t* mp = MIX + tb * 768 + c;
            if (g == 0) pool_quad<1>(hp, mp, pos0); else if (g == 1) pool_quad<2>(hp, mp, pos0); else if (g == 2) pool_quad<4>(hp, mp, pos0); else pool_quad<8>(hp, mp, pos0);
        }
    }
    if (do_rope && gtid < 96 * 1024) {
        const int r = gtid % 96, tg = gtid / 96, hd24 = r >> 2, jq = r & 3, dsh = 2 * ((hd24 % 12) >> 2);
        for (int it0 = 0; it0 < 16; it0 += 4) {
            u32x4 xa[4], xb[4]; f32x4 csb[4][4];
#pragma unroll
            for (int h = 0; h < 4; ++h) { const int tok = tg + 1024 * (it0 + h), pos = tok & (SEQ - 1);
                const bf16_t* p1 = HE + (size_t)tok * NE + E_Q + hd24 * 64 + jq * 8;
                xa[h] = *(const u32x4*)p1; xb[h] = *(const u32x4*)(p1 + 32);
                const float* rp = ROPE + ((size_t)pos * 32 + jq * 8) * 2;
#pragma unroll
                for (int j = 0; j < 4; ++j) csb[h][j] = *(const f32x4*)(rp + j * 4); }
            __builtin_amdgcn_sched_barrier(0);
#pragma unroll
            for (int h = 0; h < 4; ++h) { const int tok = tg + 1024 * (it0 + h), pos = tok & (SEQ - 1), b = tok >> 11;
                float x1[8], x2[8], o1[8], o2[8];
                unpack8(xa[h], x1); unpack8(xb[h], x2);
#pragma unroll
                for (int j = 0; j < 8; j += 2) { const f32x4 cs = csb[h][j >> 1];
                    o1[j] = x1[j] * cs[0] - x2[j] * cs[1]; o2[j] = x2[j] * cs[0] + x1[j] * cs[1];
                    o1[j + 1] = x1[j + 1] * cs[2] - x2[j + 1] * cs[3]; o2[j + 1] = x2[j + 1] * cs[2] + x1[j + 1] * cs[3]; }
                const int pp = ((pos & ((1 << dsh) - 1)) << (11 - dsh)) + (pos >> dsh);
                bf16_t* q1 = QKH + ((size_t)(b * 24 + hd24) * SEQ + pp) * 64 + jq * 8;
                *(u32x4*)q1 = pack8(o1); *(u32x4*)(q1 + 32) = pack8(o2); }
        }
    }
    if (gtid < 96 * 1024) {
        bf16_t* Op = (bf16_t*)(ws + OFF_O); const int r = gtid % 96, tg = gtid / 96, cz = r * 8;
        for (int it0 = 0; it0 < 16; it0 += 4) { u32x4 zz[4];
#pragma unroll
            for (int h = 0; h < 4; ++h) zz[h] = *(const u32x4*)(HE + (size_t)(tg + 1024 * (it0 + h)) * NE + E_ZB + cz);
#pragma unroll
            for (int h = 0; h < 4; ++h) *(u32x4*)(Op + (size_t)(tg + 1024 * (it0 + h)) * 2048 + cz) = zz[h]; }
    }
    {
        const int lane = tid & 63, wid = tid >> 6;
        bf16_t* lt = (bf16_t*)ldsf + wid * (64 * 72);
        for (int tile = bid * 8 + wid; tile < NB * 12 * 32; tile += gridDim.x * 8) {
            const int pt = tile & 31, bh = tile >> 5, hd = bh % 12, b = bh / 12, dsh = 2 * (hd >> 2), p0 = pt * 64;
            u32x4 w[8];
#pragma unroll
            for (int i = 0; i < 8; ++i) { const int e = lane + 64 * i, tk = e >> 3, c8 = (e & 7) * 8;
                w[i] = *(const u32x4*)(HE + ((size_t)b * SEQ + p0 + tk) * NE + E_V + hd * 64 + c8); }
#pragma unroll
            for (int i = 0; i < 8; ++i) { const int e = lane + 64 * i, tk = e >> 3, c8 = (e & 7) * 8; *(u32x4*)(lt + tk * 72 + c8) = w[i]; }
            asm volatile("s_waitcnt lgkmcnt(0)" ::: "memory");
            bf16_t* vrow = VT + ((size_t)(b * 12 + hd) * 64 + lane) * SEQ;
            const int d = 1 << dsh, run = 64 >> dsh;
#pragma unroll 1
            for (int res = 0; res < d; ++res) {
                const int ppb = (res << (11 - dsh)) + (p0 >> dsh);
#pragma unroll 1
                for (int m = 0; m < run; m += 4) {
                    const unsigned a0 = lt[(res + ((m + 0) << dsh)) * 72 + lane], a1 = lt[(res + ((m + 1) << dsh)) * 72 + lane],
                                   a2 = lt[(res + ((m + 2) << dsh)) * 72 + lane], a3 = lt[(res + ((m + 3) << dsh)) * 72 + lane];
                    u32x2 o; o.x = a0 | (a1 << 16); o.y = a2 | (a3 << 16);
                    *(u32x2*)(vrow + ppb + m) = o; }
            }
            asm volatile("s_waitcnt lgkmcnt(0)" ::: "memory");
        }
    }
}

__device__ __forceinline__ void attn_item(const bf16_t* QKH, const bf16_t* VT, bf16_t* AO, float* LSE, int item, int lane) {
    const int ti = item & 127, bh = item >> 7, hd = bh % 12, b = bh / 12;
    const int dsh = 2 * (hd >> 2), L = SEQ >> dsh, tpr = L >> 4;
    const int res = ti / tpr, m0 = (ti % tpr) << 4;
    const int fr = lane & 15, fq = lane >> 4;
    const size_t tokb = (size_t)b * SEQ + res;
    const bf16_t* qbase = QKH + ((size_t)(b * 24 + hd) * SEQ + (size_t)res * L) * 64 + fq * 8;
    const bf16_t* kbase = qbase + (size_t)12 * SEQ * 64;
    const bf16_t* qp = qbase + (size_t)(m0 + fr) * 64;
    const bf16x8 qf0 = *(const bf16x8*)qp, qf1 = *(const bf16x8*)(qp + 32);
    float sv[10][4];
    float mx = -1e30f;
    bf16x8 kf[10][2];
#pragma unroll
    for (int kt = 0; kt < 10; ++kt) {
        const int kb = m0 - 64 + 32 * (kt >> 1) + 4 * (kt & 1);
        const int mk = kb + 8 * (fr >> 2) + (fr & 3); const int mkc = min(max(mk, 0), L - 1);
        const bf16_t* kp = kbase + (size_t)mkc * 64;
        kf[kt][0] = *(const bf16x8*)kp; kf[kt][1] = *(const bf16x8*)(kp + 32);
    }
    __builtin_amdgcn_sched_barrier(0);
#pragma unroll
    for (int kt = 0; kt < 10; ++kt) {
        const int kb = m0 - 64 + 32 * (kt >> 1) + 4 * (kt & 1);
        f32x4 acc = {0.f, 0.f, 0.f, 0.f};
        acc = __builtin_amdgcn_mfma_f32_16x16x32_bf16(kf[kt][0], qf0, acc, 0, 0, 0);
        acc = __builtin_amdgcn_mfma_f32_16x16x32_bf16(kf[kt][1], qf1, acc, 0, 0, 0);
#pragma unroll
        for (int r = 0; r < 4; ++r) { const int mkk = kb + 8 * fq + r; const int dd = mkk - (m0 + fr);
            const bool valid = (mkk >= 0) && (mkk < L) && (dd <= 64) && (dd >= -64);
            const float s = valid ? acc[r] * 0.125f : -1e30f; sv[kt][r] = s; mx = fmaxf(mx, s); }
    }
    const bf16_t* vbase = VT + ((size_t)(b * 12 + hd) * 64 + fr) * SEQ + (size_t)res * L;
    bf16x8 vf[5][4];
#pragma unroll
    for (int pr = 0; pr < 5; ++pr) {
        const int mkb = m0 - 64 + 32 * pr + 8 * fq; const int k0 = (mkb >= 0 && mkb + 7 < L) ? mkb : 0;
#pragma unroll
        for (int nb = 0; nb < 4; ++nb) vf[pr][nb] = *(const bf16x8*)(vbase + (size_t)nb * 16 * SEQ + k0);
    }
    __builtin_amdgcn_sched_barrier(0);
    mx = fmaxf(mx, bperm(mx, lane ^ 16)); mx = fmaxf(mx, bperm(mx, lane ^ 32));
    float den = 0.f;
#pragma unroll
    for (int kt = 0; kt < 10; ++kt)
#pragma unroll
        for (int r = 0; r < 4; ++r) { const float p = __expf(sv[kt][r] - mx); sv[kt][r] = p; den += p; }
    den += bperm(den, lane ^ 16); den += bperm(den, lane ^ 32);
    f32x4 o[4];
#pragma unroll
    for (int nb = 0; nb < 4; ++nb) o[nb] = (f32x4){0.f, 0.f, 0.f, 0.f};
#pragma unroll
    for (int pr = 0; pr < 5; ++pr) {
        union { bf16x8 v; unsigned u[4]; } af;
        af.u[0] = cvt_pk_bf16(sv[2 * pr][0], sv[2 * pr][1]); af.u[1] = cvt_pk_bf16(sv[2 * pr][2], sv[2 * pr][3]);
        af.u[2] = cvt_pk_bf16(sv[2 * pr + 1][0], sv[2 * pr + 1][1]); af.u[3] = cvt_pk_bf16(sv[2 * pr + 1][2], sv[2 * pr + 1][3]);
#pragma unroll
        for (int nb = 0; nb < 4; ++nb) o[nb] = __builtin_amdgcn_mfma_f32_16x16x32_bf16(af.v, vf[pr][nb], o[nb], 0, 0, 0);
    }
#pragma unroll
    for (int r = 0; r < 4; ++r) { const float dq = bperm(den, 4 * fq + r); const float inv = 1.0f / dq;
        bf16_t* op = AO + (tokb + ((size_t)(m0 + 4 * fq + r) << dsh)) * 768 + hd * 64 + fr;
#pragma unroll
        for (int nb = 0; nb < 4; ++nb) op[nb * 16] = f2bf(o[nb][r] * inv); }
    if (fq == 0) LSE[(tokb + ((size_t)(m0 + fr) << dsh)) * 12 + hd] = mx + __logf(den);
}

#define DPPR8 " row_ror:8 row_mask:0xf bank_mask:0xf\n"
#define DPPQ1 " quad_perm:[1,0,3,2] row_mask:0xf bank_mask:0xf\n"
#define DPPQ2 " quad_perm:[2,3,0,1] row_mask:0xf bank_mask:0xf\n"
#define DPPHM " row_half_mirror row_mask:0xf bank_mask:0xf\n"
#define SCAN_STEP(y, N, W, Kd, Bv, R, vv, s) do { float _sa, _t, _y2; asm volatile( \
    "v_mul_f32 %0, %12, %4\n" "v_mul_f32 %1, %13, %5\n" "v_fmac_f32 %0, %14, %6\n" "v_fmac_f32 %1, %15, %7\n" \
    "v_fmac_f32_dpp %0, %12, %8" DPPR8 "v_fmac_f32_dpp %1, %13, %9" DPPR8 "v_fmac_f32_dpp %0, %14, %10" DPPR8 "v_fmac_f32_dpp %1, %15, %11" DPPR8 \
    "v_add_f32 %0, %0, %1\n" \
    "v_mul_f32 %4, %16, %4\n" "v_mul_f32 %5, %17, %5\n" \
    "v_add_f32_dpp %0, %0, %0" DPPQ1 \
    "v_mul_f32 %6, %18, %6\n" "v_mul_f32 %7, %19, %7\n" \
    "v_add_f32_dpp %0, %0, %0" DPPQ2 \
    "v_mul_f32_dpp %8, %16, %8" DPPR8 "v_mul_f32_dpp %9, %17, %9" DPPR8 \
    "v_add_f32_dpp %0, %0, %0" DPPHM \
    "v_mul_f32_dpp %10, %18, %10" DPPR8 "v_mul_f32_dpp %11, %19, %11" DPPR8 \
    "v_fmac_f32 %4, %20, %32\n" "v_fmac_f32 %5, %21, %32\n" "v_fmac_f32 %6, %22, %32\n" "v_fmac_f32 %7, %23, %32\n" \
    "v_fmac_f32_dpp %8, %20, %32" DPPR8 "v_fmac_f32_dpp %9, %21, %32" DPPR8 "v_fmac_f32_dpp %10, %22, %32" DPPR8 "v_fmac_f32_dpp %11, %23, %32" DPPR8 \
    "v_fmac_f32 %4, %24, %0\n" "v_fmac_f32 %5, %25, %0\n" "v_fmac_f32 %6, %26, %0\n" "v_fmac_f32 %7, %27, %0\n" \
    "v_fmac_f32_dpp %8, %24, %0" DPPR8 "v_fmac_f32_dpp %9, %25, %0" DPPR8 "v_fmac_f32_dpp %10, %26, %0" DPPR8 "v_fmac_f32_dpp %11, %27, %0" DPPR8 \
    "v_mul_f32 %2, %28, %4\n" "v_mul_f32 %3, %29, %5\n" "v_fmac_f32 %2, %30, %6\n" "v_fmac_f32 %3, %31, %7\n" \
    "v_fmac_f32_dpp %2, %28, %8" DPPR8 "v_fmac_f32_dpp %3, %29, %9" DPPR8 "v_fmac_f32_dpp %2, %30, %10" DPPR8 "v_fmac_f32_dpp %3, %31, %11" DPPR8 \
    "v_add_f32 %2, %2, %3\n" "s_nop 1\n" \
    "v_add_f32_dpp %2, %2, %2" DPPQ1 "s_nop 1\n" \
    "v_add_f32_dpp %2, %2, %2" DPPQ2 "s_nop 1\n" \
    "v_add_f32_dpp %2, %2, %2" DPPHM \
    : "=&v"(_sa), "=&v"(_t), "=&v"(y), "=&v"(_y2), "+v"(s[0]), "+v"(s[1]), "+v"(s[2]), "+v"(s[3]), "+v"(s[4]), "+v"(s[5]), "+v"(s[6]), "+v"(s[7]) \
    : "v"(N[0]), "v"(N[1]), "v"(N[2]), "v"(N[3]), "v"(W[0]), "v"(W[1]), "v"(W[2]), "v"(W[3]), "v"(Kd[0]), "v"(Kd[1]), "v"(Kd[2]), "v"(Kd[3]), \
      "v"(Bv[0]), "v"(Bv[1]), "v"(Bv[2]), "v"(Bv[3]), "v"(R[0]), "v"(R[1]), "v"(R[2]), "v"(R[3]), "v"(vv)); } while (0)

__device__ __forceinline__ float row16_sum2(float a, float b, bool odd) {
    float x = odd ? b : a; const float g = odd ? a : b;
    x += dppf<DPP_QP1>(g); x += dppf<DPP_QP2>(x); x += dppf<DPP_ROR4>(x); x += dppf<DPP_ROR8>(x);
    return x;
}
constexpr int SC_CH = 32;
constexpr int SC_STEP_F = 6 * 64;
constexpr int SC_BUF_F = SC_CH * SC_STEP_F;
constexpr int SC_YOFF_F = 2 * SC_BUF_F;
__device__ __forceinline__ void phase_scan_seq(const int tid, const int bid, const Params& P, unsigned char* ws, int l, float* ldsf) {
    const bf16_t* RKV = (const bf16_t*)(ws + OFF_B); const float* RN = (const float*)(ws + OFF_RN); const bf16_t* EA = (const bf16_t*)(ws + OFF_C);
    float* Y = (float*)(ws + OFF_A);
    const int lane = tid & 63, wid = tid >> 6;
    for (int st = bid; st < 256; st += gridDim.x) {
        const int dir = st >> 7, bt = (st >> 4) & 7, hh = st & 15;
        const size_t sbase = (size_t)(bt * 16 + hh) * SEQ;
        const int lp = tid >> 4, c4 = (tid & 15) * 4;
        const int lts = dir ? (SC_CH - 1 - lp) : lp;
        const bf16_t* pr = RKV + (sbase + lp) * 64 + c4; const bf16_t* pk = pr + (size_t)T_TOK * 1024; const bf16_t* pv = pk + (size_t)T_TOK * 1024;
        const bf16_t* pe = EA + (size_t)dir * T_TOK * 1024 + (sbase + lp) * 64 + c4; const bf16_t* pa = pe + (size_t)2 * T_TOK * 1024;
        const float* pn = RN + sbase + lp;
        float* py = Y + (size_t)dir * T_TOK * 1024 + (sbase + lp) * 64 + c4;
        const f32x4 kkc = *(const f32x4*)(P.k_k + (size_t)l * 1024 + hh * 64 + c4), kac = *(const f32x4*)(P.k_a + (size_t)l * 1024 + hh * 64 + c4);
        f32x2 sA[2], sB[2];
        sA[0] = sA[1] = sB[0] = sB[1] = (f32x2){0.f, 0.f};
        const int voff = 4 * (lane & 15);
        const int vrow = 8 * wid + 2 * (lane >> 4);
        const bool odd = (lane & 1) != 0;
        const int yoff = ((lane & 14) == 0) ? (vrow + (lane & 1)) : (2 * SC_CH * 64 + lane);
        u32x2 q_r, q_k, q_v, q_e, q_a; float q_n;
#define SC_P0(cc) (dir ? (SEQ - SC_CH * ((cc) + 1)) : SC_CH * (cc))
#define SC_ISSUE(cc) do { const size_t o_ = (size_t)SC_P0(cc) * 64; q_r = *(const u32x2*)(pr + o_); q_k = *(const u32x2*)(pk + o_); q_v = *(const u32x2*)(pv + o_); \
        q_e = *(const u32x2*)(pe + o_); q_a = *(const u32x2*)(pa + o_); q_n = pn[SC_P0(cc)]; } while (0)
#define SC_COMMIT(cc) do { float* bp_ = ldsf + ((cc) & 1) * SC_BUF_F + lts * SC_STEP_F + c4; \
        const f32x4 k_ = {bflo(q_k.x), bfhi(q_k.x), bflo(q_k.y), bfhi(q_k.y)}, a_ = {bflo(q_a.x), bfhi(q_a.x), bflo(q_a.y), bfhi(q_a.y)}; \
        const f32x4 e_ = {bflo(q_e.x), bfhi(q_e.x), bflo(q_e.y), bfhi(q_e.y)}; \
        const f32x4 kk_ = k_ * kkc * q_n; f32x4 w_; w_[0] = __expf(-e_[0]); w_[1] = __expf(-e_[1]); w_[2] = __expf(-e_[2]); w_[3] = __expf(-e_[3]); \
        *(f32x4*)(bp_) = kk_; *(f32x4*)(bp_ + 64) = w_; *(f32x4*)(bp_ + 128) = k_ * ((a_ - 1.f) * kac + 1.f); *(f32x4*)(bp_ + 192) = -kk_ * a_; \
        *(f32x4*)(bp_ + 256) = (f32x4){bflo(q_r.x), bfhi(q_r.x), bflo(q_r.y), bfhi(q_r.y)}; *(f32x4*)(bp_ + 320) = (f32x4){bflo(q_v.x), bfhi(q_v.x), bflo(q_v.y), bfhi(q_v.y)}; } while (0)
#define SC_FLUSH(cc) do { *(f32x4*)(py + (size_t)SC_P0(cc) * 64) = *(const f32x4*)(ldsf + SC_YOFF_F + ((cc) & 1) * (SC_CH * 64) + lts * 64 + c4); } while (0)
#define SC_BARRIER() do { asm volatile("s_waitcnt lgkmcnt(0)" ::: "memory"); __builtin_amdgcn_s_barrier(); asm volatile("" ::: "memory"); } while (0)
        __syncthreads();
        SC_ISSUE(0); SC_COMMIT(0);
        SC_BARRIER();
        for (int c = 0; c < SEQ / SC_CH; ++c) {
            if (c > 0) SC_FLUSH(c - 1);
            if (c + 1 < SEQ / SC_CH) SC_ISSUE(c + 1);
            const float* buf = ldsf + (c & 1) * SC_BUF_F;
            float* ybuf = ldsf + SC_YOFF_F + (c & 1) * (SC_CH * 64) + yoff;
            f32x4 cN = *(const f32x4*)(buf + voff), cW = *(const f32x4*)(buf + 64 + voff), cK = *(const f32x4*)(buf + 128 + voff), cB = *(const f32x4*)(buf + 192 + voff), cR = *(const f32x4*)(buf + 256 + voff);
            f32x2 cv = *(const f32x2*)(buf + 320 + vrow);
#pragma unroll
            for (int ts = 0; ts < SC_CH; ++ts) {
                f32x4 nN, nW, nK, nB, nR; f32x2 nv;
                if (ts + 1 < SC_CH) { const float* bp = buf + (ts + 1) * SC_STEP_F;
                    nN = *(const f32x4*)(bp + voff); nW = *(const f32x4*)(bp + 64 + voff); nK = *(const f32x4*)(bp + 128 + voff); nB = *(const f32x4*)(bp + 192 + voff); nR = *(const f32x4*)(bp + 256 + voff); nv = *(const f32x2*)(bp + 320 + vrow); }
                const f32x2 N0 = {cN[0], cN[1]}, N1 = {cN[2], cN[3]}, W0 = {cW[0], cW[1]}, W1 = {cW[2], cW[3]}, K0 = {cK[0], cK[1]}, K1 = {cK[2], cK[3]},
                            B0 = {cB[0], cB[1]}, B1 = {cB[2], cB[3]}, R0 = {cR[0], cR[1]}, R1 = {cR[2], cR[3]};
                const f32x2 pa = N0 * sA[0] + N1 * sA[1], pb = N0 * sB[0] + N1 * sB[1];
                const float x = row16_sum2(pa[0] + pa[1], pb[0] + pb[1], odd);
                const float o = dppf<DPP_QP1>(x);
                const float saA = odd ? o : x, saB = odd ? x : o;
                const f32x2 vA = {cv[0], cv[0]}, vB = {cv[1], cv[1]}, aA = {saA, saA}, aB = {saB, saB};
                sA[0] = W0 * sA[0] + K0 * vA + B0 * aA; sA[1] = W1 * sA[1] + K1 * vA + B1 * aA;
                sB[0] = W0 * sB[0] + K0 * vB + B0 * aB; sB[1] = W1 * sB[1] + K1 * vB + B1 * aB;
                const f32x2 qa = R0 * sA[0] + R1 * sA[1], qb = R0 * sB[0] + R1 * sB[1];
                ybuf[ts * 64] = row16_sum2(qa[0] + qa[1], qb[0] + qb[1], odd);
                if (ts + 1 < SC_CH) { cN = nN; cW = nW; cK = nK; cB = nB; cR = nR; cv = nv; }
            }
            if (c + 1 < SEQ / SC_CH) SC_COMMIT(c + 1);
            SC_BARRIER();
        }
        SC_FLUSH(SEQ / SC_CH - 1);
#undef SC_ISSUE
#undef SC_COMMIT
#undef SC_FLUSH
#undef SC_P0
    }
    __syncthreads();
}

namespace sc2 {
constexpr int C = 16;
constexpr int RAW_F = C * 6 * 64;
constexpr int O_RAW = 0;
constexpr int O_NT = 2 * RAW_F * 4;
constexpr int O_BT = O_NT + 2 * 2304, O_KT = O_BT + 2304, O_RT = O_KT + 2304;
constexpr int O_BK = O_RT + 2 * 2304;
constexpr int O_UV = O_BK + 2 * 5120;
constexpr int O_BRKR = O_UV + 2 * 5120;
constexpr int O_ZKN = O_BRKR + 2 * 1280;
constexpr int O_SB = O_ZKN + 1280;
constexpr int O_MB = O_SB + 9216;
constexpr int O_GL = O_MB + 1024;
constexpr int O_PC = O_GL + 4096;
constexpr int O_Y = O_PC + 512;
constexpr int O_END = O_Y + 8192;
}
__device__ __forceinline__ void phase_scan(const int tid, const int bid, const Params& P, unsigned char* ws, int l, float* ldsf) {
    using namespace sc2;
    const bf16_t* RKV = (const bf16_t*)(ws + OFF_B); const float* RN = (const float*)(ws + OFF_RN); const bf16_t* EA = (const bf16_t*)(ws + OFF_C);
    bf16_t* Y = (bf16_t*)(ws + OFF_Y);
    unsigned char* lb = (unsigned char*)ldsf;
    const int lane = tid & 63, wid = tid >> 6, fr = lane & 15, fq = lane >> 4;
    for (int st = bid; st < 256; st += gridDim.x) {
        const int dir = st >> 7, bt = (st >> 4) & 7, hh = st & 15;
        const size_t sbase = (size_t)(bt * 16 + hh) * SEQ;
        const int lp = tid >> 5, c2 = (tid & 31) * 2, lts = dir ? (C - 1 - lp) : lp;
        const unsigned eo = (unsigned)((sbase + lp) * 64 + c2);
        const bf16_t* RKk = RKV + (size_t)T_TOK * 1024; const bf16_t* RKv = RKV + (size_t)2 * T_TOK * 1024;
        const bf16_t* EAe = EA + (size_t)dir * T_TOK * 1024; const bf16_t* EAa = EA + (size_t)(2 + dir) * T_TOK * 1024;
        bf16_t* Yd = Y + (size_t)dir * T_TOK * 1024;
        const float kkc0 = P.k_k[(size_t)l * 1024 + hh * 64 + c2], kkc1 = P.k_k[(size_t)l * 1024 + hh * 64 + c2 + 1];
        const float kac0 = P.k_a[(size_t)l * 1024 + hh * 64 + c2], kac1 = P.k_a[(size_t)l * 1024 + hh * 64 + c2 + 1];
        unsigned qv[2][5]; float qn[2];
#define SC_P0(cc) (dir ? (SEQ - C * ((cc) + 1)) : C * (cc))
#define SC_ISSUE(cc, S) do { const unsigned o_ = eo + (unsigned)(SC_P0(cc) * 64); qv[S][0] = *(const unsigned*)(RKV + o_); qv[S][1] = *(const unsigned*)(RKk + o_); qv[S][2] = *(const unsigned*)(RKv + o_); \
        qv[S][3] = *(const unsigned*)(EAe + o_); qv[S][4] = *(const unsigned*)(EAa + o_); qn[S] = RN[(unsigned)(sbase + lp) + (unsigned)SC_P0(cc)]; } while (0)
#define SC_COMMIT(cc, S) do { float* bp_ = (float*)(lb + O_RAW) + ((cc) & 1) * RAW_F + lts * (6 * 64) + c2; \
        const float k0_ = bflo(qv[S][1]), k1_ = bfhi(qv[S][1]), a0_ = bflo(qv[S][4]), a1_ = bfhi(qv[S][4]); const float kk0_ = k0_ * kkc0 * qn[S], kk1_ = k1_ * kkc1 * qn[S]; \
        *(f32x2*)(bp_) = (f32x2){kk0_, kk1_}; *(f32x2*)(bp_ + 64) = (f32x2){bflo(qv[S][3]), bfhi(qv[S][3])}; \
        *(f32x2*)(bp_ + 128) = (f32x2){k0_ * (1.f + (a0_ - 1.f) * kac0), k1_ * (1.f + (a1_ - 1.f) * kac1)}; *(f32x2*)(bp_ + 192) = (f32x2){-kk0_ * a0_, -kk1_ * a1_}; \
        *(f32x2*)(bp_ + 256) = (f32x2){bflo(qv[S][0]), bfhi(qv[S][0])}; *(f32x2*)(bp_ + 320) = (f32x2){bflo(qv[S][2]), bfhi(qv[S][2])}; } while (0)
#define SC_FLUSH(cc) do { const f32x2 yv_ = *(const f32x2*)((const float*)(lb + O_Y) + ((cc) & 1) * (C * 64) + lts * 64 + c2); *(unsigned*)(Yd + (eo + (unsigned)(SC_P0(cc) * 64))) = cvt_pk_bf16(yv_[0], yv_[1]); } while (0)
#define SC_BARRIER() do { asm volatile("s_waitcnt lgkmcnt(0)" ::: "memory"); __builtin_amdgcn_s_barrier(); asm volatile("" ::: "memory"); } while (0)
#define SC_PREPG(cc, WLO, WHI, TLO, NK) do { if (wid >= (WLO) && wid < (WHI)) { const float* raw_ = (const float*)(lb + O_RAW) + ((cc) & 1) * RAW_F; const int j_ = lane; \
        unsigned char* bk_ = lb + O_BK + ((cc) & 1) * 5120 + j_ * 80; unsigned char* uv_ = lb + O_UV + ((cc) & 1) * 5120 + j_ * 80; \
        unsigned char* nt_b = lb + O_NT + ((cc) & 1) * 2304 + j_ * 2; unsigned char* rt_b = lb + O_RT + ((cc) & 1) * 2304 + j_ * 2; \
        float ev_[15]; _Pragma("unroll") for (int tau_ = 0; tau_ < 15; ++tau_) ev_[tau_] = raw_[tau_ * 384 + 64 + j_]; \
        _Pragma("unroll") for (int k_ = 0; k_ < (NK); ++k_) { const int t_ = (TLO) + (wid - (WLO)) + ((WHI) - (WLO)) * k_; if (t_ < C) { \
            const float* rp_ = raw_ + t_ * 384 + j_; const float i0_ = rp_[0], i1_ = rp_[64], i2_ = rp_[128], i3_ = rp_[192], i4_ = rp_[256], i5_ = rp_[320]; \
            float E_ = 0.f; _Pragma("unroll") for (int tau_ = 0; tau_ < 15; ++tau_) E_ += (tau_ < t_) ? ev_[tau_] : 0.f; \
            const float pprev_ = __expf(-E_); E_ += i1_; const float pc_ = __expf(-E_), ipc_ = __expf(E_); \
            const bf16_t nt_ = f2bf(pprev_ * i0_), bt_ = f2bf(ipc_ * i3_), kt_ = f2bf(ipc_ * i2_), rt_ = f2bf(pc_ * i4_), vv_ = f2bf(i5_); \
            *(bf16_t*)(nt_b + t_ * 144) = nt_; *(bf16_t*)(lb + O_BT + t_ * 144 + j_ * 2) = bt_; *(bf16_t*)(lb + O_KT + t_ * 144 + j_ * 2) = kt_; *(bf16_t*)(rt_b + t_ * 144) = rt_; \
            *(bf16_t*)(bk_ + t_ * 2) = bt_; *(bf16_t*)(bk_ + (16 + t_) * 2) = kt_; *(bf16_t*)(uv_ + (16 + t_) * 2) = vv_; \
            if (t_ == C - 1) *(float*)(lb + O_PC + ((cc) & 1) * 256 + j_ * 4) = pc_; } } } } while (0)
#define SC_PREP(cc) SC_PREPG(cc, 0, 8, 0, 2)
#define SC_PREP_A(cc) SC_PREPG(cc, 0, 4, 0, 1)
#define SC_PREP_B(cc) SC_PREPG(cc, 1, 8, 4, 2)
#define SC_P1(cc) do { if (wid < 4) { \
        const unsigned char* xa_ = lb + ((wid & 1) ? O_KT : O_BT) + fr * 144 + fq * 16; const unsigned char* yb_ = lb + ((wid >> 1) ? O_RT : O_NT) + ((cc) & 1) * 2304 + fr * 144 + fq * 16; \
        f32x4 acc_ = {0.f, 0.f, 0.f, 0.f}; \
        acc_ = __builtin_amdgcn_mfma_f32_16x16x32_bf16(*(const bf16x8*)xa_, *(const bf16x8*)yb_, acc_, 0, 0, 0); \
        acc_ = __builtin_amdgcn_mfma_f32_16x16x32_bf16(*(const bf16x8*)(xa_ + 64), *(const bf16x8*)(yb_ + 64), acc_, 0, 0, 0); \
        _Pragma("unroll") for (int r_ = 0; r_ < 4; ++r_) { const int tau_ = 4 * fq + r_; const bool keep_ = (wid < 2) ? (tau_ < fr) : (tau_ <= fr); acc_[r_] = keep_ ? acc_[r_] : 0.f; } \
        if (wid == 0) *(f32x4*)(lb + O_MB + fr * 64 + fq * 16) = acc_; \
        else { u32x2 w_; w_.x = cvt_pk_bf16(acc_[0], acc_[1]); w_.y = cvt_pk_bf16(acc_[2], acc_[3]); \
            if (wid == 1) { *(u32x2*)(lb + O_ZKN + fr * 80 + (16 + 4 * fq) * 2) = w_; *(u32x2*)(lb + O_ZKN + fr * 80 + (4 * fq) * 2) = (u32x2){0u, 0u}; } \
            else *(u32x2*)(lb + O_BRKR + ((cc) & 1) * 1280 + fr * 80 + ((wid - 2) * 16 + 4 * fq) * 2) = w_; } } } while (0)
        f32x4 sacc[2]; sacc[0] = sacc[1] = (f32x4){0.f, 0.f, 0.f, 0.f};
        const int ib = wid >> 1, jb0 = 2 * (wid & 1);
        __syncthreads();
        for (int i = tid; i < 576; i += 512) *(u32x4*)(lb + O_SB + i * 16) = (u32x4){0u, 0u, 0u, 0u};
        for (int i = tid; i < 640; i += 512) *(u32x4*)(lb + O_UV + i * 16) = (u32x4){0u, 0u, 0u, 0u};
        SC_ISSUE(0, 0); SC_COMMIT(0, 0);
        SC_ISSUE(1, 1); SC_COMMIT(1, 1);
        SC_ISSUE(2, 0); SC_ISSUE(3, 1);
        SC_BARRIER();
        SC_PREP(0);
        SC_BARRIER();
        SC_P1(0);
        SC_BARRIER();
        for (int ch = 0; ch < SEQ / C / 2; ++ch) {
#pragma unroll
        for (int cc = 0; cc < 2; ++cc) {
            const int c = 2 * ch + cc;
            if (c > 0) SC_FLUSH(c - 1);
            if (c + 1 < SEQ / C) SC_PREP_A(c + 1);
            f32x4 hacc = {0.f, 0.f, 0.f, 0.f};
            if (wid >= 4) {
                const int ibb = wid - 4;
                const unsigned char* sa_ = lb + O_SB + (16 * ibb + fr) * 144 + fq * 16;
                const bf16x8 a0 = *(const bf16x8*)sa_, a1 = *(const bf16x8*)(sa_ + 64);
                const bf16x8 av = *(const bf16x8*)(lb + O_UV + (c & 1) * 5120 + (16 * ibb + fr) * 80 + fq * 16);
                const unsigned char* nb_ = lb + O_NT + (c & 1) * 2304 + fr * 144 + fq * 16; const unsigned char* rb_ = lb + O_RT + (c & 1) * 2304 + fr * 144 + fq * 16;
                f32x4 g = {0.f, 0.f, 0.f, 0.f};
                g = __builtin_amdgcn_mfma_f32_16x16x32_bf16(a0, *(const bf16x8*)nb_, g, 0, 0, 0);
                g = __builtin_amdgcn_mfma_f32_16x16x32_bf16(a1, *(const bf16x8*)(nb_ + 64), g, 0, 0, 0);
                g = __builtin_amdgcn_mfma_f32_16x16x32_bf16(av, *(const bf16x8*)(lb + O_ZKN + fr * 80 + fq * 16), g, 0, 0, 0);
                hacc = __builtin_amdgcn_mfma_f32_16x16x32_bf16(a0, *(const bf16x8*)rb_, hacc, 0, 0, 0);
                hacc = __builtin_amdgcn_mfma_f32_16x16x32_bf16(a1, *(const bf16x8*)(rb_ + 64), hacc, 0, 0, 0);
                *(f32x4*)(lb + O_GL + fr * 256 + (16 * ibb + 4 * fq) * 4) = g;
            }
            SC_BARRIER();
            if (wid == 0) {
                const int i = lane; float u[C];
#pragma unroll
                for (int t = 0; t < C; ++t) {
                    float a0 = *(const float*)(lb + O_GL + t * 256 + i * 4), a1 = 0.f;
                    f32x4 m[4];
#pragma unroll
                    for (int q = 0; q < 4; ++q) if (4 * q < t) m[q] = *(const f32x4*)(lb + O_MB + t * 64 + q * 16);
#pragma unroll
                    for (int tau = 0; tau < t; ++tau) { if (tau & 1) a1 += u[tau] * m[tau >> 2][tau & 3]; else a0 += u[tau] * m[tau >> 2][tau & 3]; }
                    u[t] = a0 + a1;
                }
                u32x4 w0, w1;
                w0.x = cvt_pk_bf16(u[0], u[1]); w0.y = cvt_pk_bf16(u[2], u[3]); w0.z = cvt_pk_bf16(u[4], u[5]); w0.w = cvt_pk_bf16(u[6], u[7]);
                w1.x = cvt_pk_bf16(u[8], u[9]); w1.y = cvt_pk_bf16(u[10], u[11]); w1.z = cvt_pk_bf16(u[12], u[13]); w1.w = cvt_pk_bf16(u[14], u[15]);
                *(u32x4*)(lb + O_UV + (c & 1) * 5120 + i * 80) = w0; *(u32x4*)(lb + O_UV + (c & 1) * 5120 + i * 80 + 16) = w1;
            }
            if (c + 1 < SEQ / C) SC_PREP_B(c + 1);
            SC_BARRIER();
            if (wid >= 4) {
                const int ibb = wid - 4;
                const bf16x8 af = *(const bf16x8*)(lb + O_UV + (c & 1) * 5120 + (16 * ibb + fr) * 80 + fq * 16), bf_ = *(const bf16x8*)(lb + O_BRKR + (c & 1) * 1280 + fr * 80 + fq * 16);
                hacc = __builtin_amdgcn_mfma_f32_16x16x32_bf16(af, bf_, hacc, 0, 0, 0);
                *(f32x4*)(lb + O_Y + (c & 1) * (C * 64 * 4) + fr * 256 + (16 * ibb + 4 * fq) * 4) = hacc;
            }
            {
                const bf16x8 af = *(const bf16x8*)(lb + O_UV + (c & 1) * 5120 + (16 * ib + fr) * 80 + fq * 16);
#pragma unroll
                for (int q = 0; q < 2; ++q) {
                    const int j = 16 * (jb0 + q) + fr;
                    const bf16x8 bf_ = *(const bf16x8*)(lb + O_BK + (c & 1) * 5120 + j * 80 + fq * 16);
                    sacc[q] = __builtin_amdgcn_mfma_f32_16x16x32_bf16(af, bf_, sacc[q], 0, 0, 0);
                    const float pc = *(const float*)(lb + O_PC + (c & 1) * 256 + j * 4);
                    sacc[q] *= pc;
#pragma unroll
                    for (int r = 0; r < 4; ++r) *(bf16_t*)(lb + O_SB + (16 * ib + 4 * fq + r) * 144 + j * 2) = f2bf(sacc[q][r]);
                }
            }
            if (c + 1 < SEQ / C) SC_P1(c + 1);
            if (c + 2 < SEQ / C) SC_COMMIT(c + 2, cc);
            if (c + 4 < SEQ / C) SC_ISSUE(c + 4, cc);
            SC_BARRIER();
        }
        }
        SC_FLUSH(SEQ / C - 1);
#undef SC_ISSUE
#undef SC_COMMIT
#undef SC_FLUSH
#undef SC_P0
#undef SC_BARRIER
#undef SC_PREP
#undef SC_P1
    }
    __syncthreads();
}

__device__ __forceinline__ void phase_post(const int tid, const int bid, const Params& P, unsigned char* ws, int l) {
    const bf16_t* Y = (const bf16_t*)(ws + OFF_Y); const bf16_t* RKV = (const bf16_t*)(ws + OFF_B); const bf16_t* HL = (const bf16_t*)(ws + OFF_HL);
    const bf16_t* AO = (const bf16_t*)(ws + OFF_AO); const float* LSE = (const float*)(ws + OFF_LSE); bf16_t* O = (bf16_t*)(ws + OFF_O);
    const float* gg = P.gn_g + (size_t)l * 1024; const float* gb = P.gn_b + (size_t)l * 1024; const float* rk = P.r_k + (size_t)l * 1024;
    const size_t gtid = (size_t)bid * 512 + tid, gsz = (size_t)gridDim.x * 512;
    constexpr int PB = 8;
    for (size_t u0 = gtid; u0 < (size_t)T_TOK * 256; u0 += PB * gsz) {
        u32x2 ya[PB], yb[PB]; u32x2 rw[PB], kw[PB], vw[PB], zw[PB];
#pragma unroll
        for (int k = 0; k < PB; ++k) { size_t u = u0 + k * gsz; if (u >= (size_t)T_TOK * 256) u = u0;
            const size_t tok = u >> 8; const int c = (int)(u & 255) * 4;
            const size_t hm = ((size_t)((tok >> 11) * 16 + (c >> 6)) * SEQ + (tok & 2047)) * 64 + (c & 63);
            ya[k] = *(const u32x2*)(Y + hm); yb[k] = *(const u32x2*)(Y + (size_t)T_TOK * 1024 + hm);
            rw[k] = *(const u32x2*)(RKV + hm); kw[k] = *(const u32x2*)(RKV + (size_t)T_TOK * 1024 + hm); vw[k] = *(const u32x2*)(RKV + (size_t)2 * T_TOK * 1024 + hm);
            zw[k] = *(const u32x2*)(HL + tok * NL + L_ZA + c); }
        __builtin_amdgcn_sched_barrier(0);
#pragma unroll
        for (int k = 0; k < PB; ++k) { const size_t u = u0 + k * gsz; if (u < (size_t)T_TOK * 256) {
            const size_t tok = u >> 8; const int c = (int)(u & 255) * 4;
            const f32x4 y = {bflo(ya[k].x) + bflo(yb[k].x), bfhi(ya[k].x) + bfhi(yb[k].x), bflo(ya[k].y) + bflo(yb[k].y), bfhi(ya[k].y) + bfhi(yb[k].y)};
            const f32x4 rkv = *(const f32x4*)(rk + c);
            const float r4[4] = {bflo(rw[k].x), bfhi(rw[k].x), bflo(rw[k].y), bfhi(rw[k].y)}, k4[4] = {bflo(kw[k].x), bfhi(kw[k].x), bflo(kw[k].y), bfhi(kw[k].y)}, v4[4] = {bflo(vw[k].x), bfhi(vw[k].x), bflo(vw[k].y), bfhi(vw[k].y)};
            float s1 = y[0] + y[1] + y[2] + y[3], bd = r4[0] * k4[0] * rkv[0] + r4[1] * k4[1] * rkv[1] + r4[2] * k4[2] * rkv[2] + r4[3] * k4[3] * rkv[3];
            s1 += dppf<DPP_QP1>(s1); bd += dppf<DPP_QP1>(bd); s1 += dppf<DPP_QP2>(s1); bd += dppf<DPP_QP2>(bd);
            s1 += dppf<DPP_ROR4>(s1); bd += dppf<DPP_ROR4>(bd); s1 += dppf<DPP_ROR8>(s1); bd += dppf<DPP_ROR8>(bd);
            const float mean = s1 * (1.f / 64.f);
            float s2 = 0.f;
#pragma unroll
            for (int j = 0; j < 4; ++j) { const float d = y[j] - mean; s2 += d * d; }
            s2 += dppf<DPP_QP1>(s2); s2 += dppf<DPP_QP2>(s2); s2 += dppf<DPP_ROR4>(s2); s2 += dppf<DPP_ROR8>(s2);
            const float rstd = rsqrtf(s2 * (1.f / 64.f) + 64e-5f);
            const f32x4 g4 = *(const f32x4*)(gg + c), b4 = *(const f32x4*)(gb + c);
            const float z4[4] = {bflo(zw[k].x), bfhi(zw[k].x), bflo(zw[k].y), bfhi(zw[k].y)};
            float o[4];
#pragma unroll
            for (int j = 0; j < 4; ++j) o[j] = ((y[j] - mean) * rstd * g4[j] + b4[j] + bd * v4[j]) * siluf_(z4[j]);
            u32x2 w; w.x = cvt_pk_bf16(o[0], o[1]); w.y = cvt_pk_bf16(o[2], o[3]);
            *(u32x2*)(O + tok * 2048 + c) = w; } }
    }
    for (size_t u0 = gtid; u0 < (size_t)T_TOK * 64; u0 += PB * gsz) {
        float l0[PB], l1[PB], l2[PB]; u32x2 a0[PB], a1[PB], a2[PB], zc[PB];
#pragma unroll
        for (int k = 0; k < PB; ++k) { size_t u = u0 + k * gsz; if (u >= (size_t)T_TOK * 64) u = u0;
            const size_t tok = u >> 6; const int r = (int)(u & 63), hs = r >> 4, d4 = (r & 15) * 4;
            l0[k] = LSE[tok * 12 + hs]; l1[k] = LSE[tok * 12 + 4 + hs]; l2[k] = LSE[tok * 12 + 8 + hs];
            a0[k] = *(const u32x2*)(AO + tok * 768 + hs * 64 + d4); a1[k] = *(const u32x2*)(AO + tok * 768 + (4 + hs) * 64 + d4); a2[k] = *(const u32x2*)(AO + tok * 768 + (8 + hs) * 64 + d4);
            zc[k] = *(const u32x2*)(HL + tok * NL + L_ZC + hs * 64 + d4); }
        __builtin_amdgcn_sched_barrier(0);
#pragma unroll
        for (int k = 0; k < PB; ++k) { const size_t u = u0 + k * gsz; if (u < (size_t)T_TOK * 64) {
            const size_t tok = u >> 6; const int r = (int)(u & 63), hs = r >> 4, d4 = (r & 15) * 4;
            const float lm = fmaxf(l0[k], fmaxf(l1[k], l2[k])); const float e0 = __expf(l0[k] - lm), e1 = __expf(l1[k] - lm), e2 = __expf(l2[k] - lm); const float inv = __builtin_amdgcn_rcpf(e0 + e1 + e2);
            float o[4];
            o[0] = (e0 * bflo(a0[k].x) + e1 * bflo(a1[k].x) + e2 * bflo(a2[k].x)) * inv * siluf_(bflo(zc[k].x));
            o[1] = (e0 * bfhi(a0[k].x) + e1 * bfhi(a1[k].x) + e2 * bfhi(a2[k].x)) * inv * siluf_(bfhi(zc[k].x));
            o[2] = (e0 * bflo(a0[k].y) + e1 * bflo(a1[k].y) + e2 * bflo(a2[k].y)) * inv * siluf_(bflo(zc[k].y));
            o[3] = (e0 * bfhi(a0[k].y) + e1 * bfhi(a1[k].y) + e2 * bfhi(a2[k].y)) * inv * siluf_(bfhi(zc[k].y));
            u32x2 w; w.x = cvt_pk_bf16(o[0], o[1]); w.y = cvt_pk_bf16(o[2], o[3]);
            *(u32x2*)(O + tok * 2048 + 1792 + hs * 64 + d4) = w; } }
    }
}

__device__ __forceinline__ void phase_ln(const int tid, const int bid, const Params& P, unsigned char* ws, int l) {
    const float* PRE = (const float*)(ws + OFF_A); bf16_t* XB = (bf16_t*)(ws + OFF_XB);
    const float* g = P.ln_g + (size_t)l * 1024; const float* bb = P.ln_b + (size_t)l * 1024;
    const int lane = tid & 63, wid = tid >> 6;
    constexpr int LR = 8;
    for (int row0 = (bid * 8 + wid) * LR; row0 < T_TOK; row0 += gridDim.x * 8 * LR) {
        f32x4 v[LR][4]; float s[LR], s2[LR], mean[LR], rstd[LR];
#pragma unroll
        for (int q = 0; q < LR; ++q) { const float* pr = PRE + (size_t)(row0 + q) * 1024;
#pragma unroll
            for (int i = 0; i < 4; ++i) v[q][i] = *(const f32x4*)(pr + i * 256 + lane * 4); }
        __builtin_amdgcn_sched_barrier(0);
#pragma unroll
        for (int q = 0; q < LR; ++q) { s[q] = 0.f;
#pragma unroll
            for (int i = 0; i < 4; ++i) s[q] += v[q][i][0] + v[q][i][1] + v[q][i][2] + v[q][i][3]; }
#pragma unroll
        for (int q = 0; q < LR; ++q) { float t = s[q]; t += dppf<DPP_QP1>(t); t += dppf<DPP_QP2>(t); t += dppf<DPP_ROR4>(t); t += dppf<DPP_ROR8>(t); t += bperm(t, lane ^ 16); t += bperm(t, lane ^ 32); mean[q] = t * (1.f / 1024.f); }
#pragma unroll
        for (int q = 0; q < LR; ++q) { float t = 0.f;
#pragma unroll
            for (int i = 0; i < 4; ++i)
#pragma unroll
                for (int j = 0; j < 4; ++j) { const float d = v[q][i][j] - mean[q]; t += d * d; }
            s2[q] = t; }
#pragma unroll
        for (int q = 0; q < LR; ++q) { float t = s2[q]; t += dppf<DPP_QP1>(t); t += dppf<DPP_QP2>(t); t += dppf<DPP_ROR4>(t); t += dppf<DPP_ROR8>(t); t += bperm(t, lane ^ 16); t += bperm(t, lane ^ 32); rstd[q] = rsqrtf(t * (1.f / 1024.f) + 1e-5f); }
#pragma unroll
        for (int q = 0; q < LR; ++q)
#pragma unroll
            for (int i = 0; i < 4; ++i) { const int c = i * 256 + lane * 4; const f32x4 g4 = *(const f32x4*)(g + c), b4 = *(const f32x4*)(bb + c);
                f32x4 o; for (int j = 0; j < 4; ++j) o[j] = (v[q][i][j] - mean[q]) * rstd[q] * g4[j] + b4[j];
                *(f32x4*)(P.out + (size_t)(row0 + q) * 1024 + c) = o;
                u32x2 w; w.x = cvt_pk_bf16(o[0], o[1]); w.y = cvt_pk_bf16(o[2], o[3]); *(u32x2*)(XB + (size_t)(row0 + q) * 1024 + c) = w; }
    }
}

#define XB_TMO      128
#define XB_XCNT(j)  (256  + 64 * (j))
#define XB_XSUB(j)  (1280 + 64 * (j))
#define XB_XGEN(j)  (2304 + 64 * (j))
#define XB_TOP      3328
#define XB_TOPGEN   3392
#define XCD_BAR_WORDS 3456
#define XB_SPIN_CAP (1u << 20)
__device__ __forceinline__ unsigned xb_ld(unsigned* p)              { return __hip_atomic_load(p, __ATOMIC_RELAXED, __HIP_MEMORY_SCOPE_AGENT); }
__device__ __forceinline__ unsigned xb_add(unsigned* p, unsigned v) { return __hip_atomic_fetch_add(p, v, __ATOMIC_RELAXED, __HIP_MEMORY_SCOPE_AGENT); }
__device__ __forceinline__ unsigned xb_xcc_id() { return (unsigned)__builtin_amdgcn_s_getreg((3 << 11) | 20) & 0xFu; }
#define XB_SPIN(cond, bar) do { unsigned _sp = 0; while (cond) {   \
    if ((++_sp & 255u) == 0u) { if (xb_ld(&(bar)[XB_TMO])) break; if (_sp > XB_SPIN_CAP) { atomicAdd(&(bar)[XB_TMO], 1u); break; } } } } while (0)
struct XcdBarrier { unsigned* bar; unsigned x; volatile LAS unsigned* st; };
__device__ __forceinline__ XcdBarrier xcd_barrier_post(unsigned* bar, volatile LAS unsigned* st) {
    XcdBarrier b; b.bar = bar; b.x = xb_xcc_id(); b.st = st;
    if (threadIdx.x == 0) (void)xb_add(&bar[XB_XCNT(b.x)], 1u);
    return b;
}
__device__ __forceinline__ void xcd_barrier_complete(unsigned* bar, unsigned x, unsigned& nloc, unsigned& nx) {
    const unsigned G = gridDim.x * gridDim.y * gridDim.z;
    unsigned sum, cnt, mine, sp = 0u;
    for (;;) {
        sum = 0u; cnt = 0u; mine = 0u;
#pragma unroll
        for (unsigned j = 0; j < 16; ++j) { const unsigned c = xb_ld(&bar[XB_XCNT(j)]); sum += c; cnt += (c > 0u) ? 1u : 0u; mine = (j == x) ? c : mine; }
        if (sum == G) break;
        __builtin_amdgcn_s_sleep(1);
        if ((++sp & 255u) == 0u) { if (xb_ld(&bar[XB_TMO])) break; if (sp > XB_SPIN_CAP) { atomicAdd(&bar[XB_TMO], 1u); break; } }
    }
    nloc = mine > 0u ? mine : 1u; nx = cnt > 0u ? cnt : 1u;
}
__device__ __forceinline__ void xcd_barrier(const XcdBarrier& b) {
    asm volatile("s_waitcnt vmcnt(0)" ::: "memory");
    __syncthreads();
    if (threadIdx.x == 0) {
        unsigned* bar = b.bar;
        __builtin_amdgcn_s_waitcnt(0);
        unsigned nloc = b.st[0], nx = b.st[1];
        if (nloc == 0u) { xcd_barrier_complete(bar, b.x, nloc, nx); b.st[0] = nloc; b.st[1] = nx; }
        const unsigned old = xb_add(&bar[XB_XSUB(b.x)], 1u);
        const unsigned gen = old / nloc;
        if (old + 1u == (gen + 1u) * nloc) {
            __builtin_amdgcn_fence(__ATOMIC_RELEASE, "agent");
            asm volatile("s_waitcnt vmcnt(0)" ::: "memory");
            const unsigned og = xb_add(&bar[XB_TOP], 1u);
            const unsigned tg = og / nx;
            if (og + 1u == (tg + 1u) * nx) xb_add(&bar[XB_TOPGEN], 1u);
            else XB_SPIN(xb_ld(&bar[XB_TOPGEN]) == tg, bar);
            __builtin_amdgcn_fence(__ATOMIC_ACQUIRE, "agent");
            xb_add(&bar[XB_XGEN(b.x)], 1u);
            asm volatile("s_waitcnt vmcnt(0)" ::: "memory");
        } else {
            XB_SPIN(xb_ld(&bar[XB_XGEN(b.x)]) == gen, bar);
            __builtin_amdgcn_fence(__ATOMIC_ACQUIRE, "agent");
            asm volatile("s_waitcnt vmcnt(0)" ::: "memory");
        }
    }
    __syncthreads();
}

constexpr int PER = 8;
constexpr int N_PH = 1 + PER * DEPTH;
__global__ void __launch_bounds__(512, 2) fwd_kernel(Params P) {
    extern __shared__ __attribute__((aligned(16))) unsigned char shm[];
    LAS unsigned char* lds = (LAS unsigned char*)shm; float* ldsf = (float*)shm;
    const int G = (int)gridDim.x;
#if !MK_MULTI
    volatile LAS unsigned* xst = (volatile LAS unsigned*)(lds + 131072);
    if (threadIdx.x == 0) { xst[0] = 0u; xst[1] = 0u; }
    __syncthreads();
    const XcdBarrier xb = xcd_barrier_post((unsigned*)(P.ws + OFF_BAR), xst);
#endif
    for (int ph = P.ph_lo; ph < P.ph_hi; ++ph) {
        int tid = threadIdx.x; asm volatile("" : "+v"(tid));
        int c = blockIdx.x; asm volatile("" : "+s"(c));
        size_t wz = 0; asm volatile("" : "+s"(wz)); const Params& PP = *(const Params*)((const char*)&P + wz); unsigned char* ws = PP.ws;
        if (ph == 0) { phase_prepass(tid, c, PP, ws, ldsf); }
        else {
            const int l = (ph - 1) / PER, slot = (ph - 1) % PER, k = slot < 4 ? slot : slot + 1;
            const int rep = 0;
            switch (k) {
            case 0: {
                pg8::Gemm g{(const bf16_t*)(ws + OFF_XB), (const bf16_t*)(ws + OFF_WIN), T_TOK, NE, 1024};
                pg8::StaticOrder S; S.init(T_TOK, NE, 1024, G, c);
                pg8::EpiBias E{(bf16_t*)(ws + OFF_A), NE, (const float*)(ws + OFF_BIASP)};
                pg8::gemm_phase(tid, lds, g, S, E); } break;
            case 1: phase_prep(tid, c, PP, ws, l, ldsf, rep == 0); break;
            case 2: {
                if (!rep || MK_SUB < 0 || MK_SUB == 0) { pg8::Gemm g{(const bf16_t*)(ws + OFF_LIN), (const bf16_t*)(ws + OFF_LORA), T_TOK, 4096, 256};
                  pg8::StaticOrder S; S.init(T_TOK, 4096, 256, G, c);
                  pg8::EpiLora E{(bf16_t*)(ws + OFF_C), PP.w0 + (size_t)l * 2048, PP.a0 + (size_t)l * 2048};
                  pg8::gemm_phase(tid, lds, g, S, E); }
                {
                  pg8::Gemm g{(const bf16_t*)(ws + OFF_XB), (const bf16_t*)(ws + OFF_WIN) + (size_t)NE * 1024, T_TOK, NL, 1024};
                  pg8::StaticOrder S; S.init(T_TOK, NL, 1024, G, c);
                  pg8::EpiBias E{(bf16_t*)(ws + OFF_HL), NL, (const float*)(ws + OFF_BIASP) + NE};
                  pg8::gemm_phase(tid, lds, g, S, E); }
                if (!rep || MK_SUB < 0 || MK_SUB == 1) { pg8::Gemm g{(const bf16_t*)(ws + OFF_MIX), (const bf16_t*)(ws + OFF_POOLW), T_TOK, 768, 768};
                  pg8::StaticOrder S; S.init(T_TOK, 768, 768, G, G - 1 - c);
                  pg8::EpiPool E{(bf16_t*)(ws + OFF_O), (const bf16_t*)(ws + OFF_A), PP.pool_b + (size_t)l * 768, PP.pool_scale + (size_t)l * 768};
                  pg8::gemm_phase(tid, lds, g, S, E); }
                if (!rep || MK_SUB < 0 || MK_SUB == 2) { const int lane = tid & 63, wid = tid >> 6;
                  for (int item = c * 8 + wid; item < NB * 12 * 128; item += G * 8)
                      attn_item((const bf16_t*)(ws + OFF_QKH), (const bf16_t*)(ws + OFF_VT), (bf16_t*)(ws + OFF_AO), (float*)(ws + OFF_LSE), item, lane); }
                } break;
            case 3: phase_scan(tid, c, PP, ws, l, ldsf); break;
            case 5: phase_post(tid, c, PP, ws, l); break;
            case 6: {
                pg8::Gemm g{(const bf16_t*)(ws + OFF_O), (const bf16_t*)(ws + OFF_PROJ), T_TOK, 1024, 2048};
                pg8::MergeOrder S; S.init(G, c);
                pg8::EpiMerge E{(bf16_t*)(ws + OFF_D), (const bf16_t*)(ws + OFF_HL)};
                pg8::gemm_phase<pg8::EpiMerge, pg8::MergeOrder, true>(tid, lds, g, S, E); } break;
            case 7: {
                pg8::Gemm g{(const bf16_t*)(ws + OFF_D), (const bf16_t*)(ws + OFF_WOUT), T_TOK, 1024, 1024};
                pg8::StaticOrder S; S.init(T_TOK, 1024, 1024, G, c);
                pg8::EpiOut E{(float*)(ws + OFF_A), l == 0 ? PP.x : (const float*)PP.out, 1.681792830507429f};
                pg8::gemm_phase(tid, lds, g, S, E); } break;
            case 8: phase_ln(tid, c, PP, ws, l); if (l + 1 < DEPTH) convert_weights(tid, c, PP, ws, l + 1, ldsf); break;
            }
        }
#if !MK_MULTI
        if (ph + 1 < P.ph_hi) { if (ph == 0) cg::this_grid().sync(); else xcd_barrier(xb); }
#endif
    }
}

extern "C" void kernel_launch(void* const* d_in, const int* in_sizes, int n_in, void* d_out, int out_size, void* d_ws, size_t ws_size, hipStream_t stream) {
    constexpr size_t kDynLds = 131072 + 64;
    static int grid_blocks = 0;
    if (!grid_blocks) {
        hipFuncSetAttribute((const void*)fwd_kernel, hipFuncAttributeMaxDynamicSharedMemorySize, (int)kDynLds);
        int dev = 0, cus = 0, per_cu = 0;
        hipGetDevice(&dev);
        hipDeviceGetAttribute(&cus, hipDeviceAttributeMultiprocessorCount, dev);
        hipOccupancyMaxActiveBlocksPerMultiprocessor(&per_cu, fwd_kernel, 512, kDynLds);
        if (per_cu < 1) per_cu = 1;
        grid_blocks = cus * per_cu;
        if (grid_blocks > 256) grid_blocks = 256;
        if (ws_size < WS_TOTAL) fprintf(stderr, "workspace too small: %zu < %zu\n", ws_size, (size_t)WS_TOTAL);
    }
    Params p{};
    p.x = (const float*)d_in[0]; p.w_in = (const float*)d_in[1]; p.b_in = (const float*)d_in[2]; p.mu = (const float*)d_in[3]; p.w0 = (const float*)d_in[4];
    p.w_up = (const float*)d_in[5]; p.a0 = (const float*)d_in[6]; p.a_up = (const float*)d_in[7]; p.k_k = (const float*)d_in[8]; p.k_a = (const float*)d_in[9];
    p.r_k = (const float*)d_in[10]; p.gn_g = (const float*)d_in[11]; p.gn_b = (const float*)d_in[12]; p.pool_w = (const float*)d_in[13]; p.pool_b = (const float*)d_in[14];
    p.pool_scale = (const float*)d_in[15]; p.proj_a = (const float*)d_in[16]; p.proj_b = (const float*)d_in[17]; p.proj_c = (const float*)d_in[18]; p.w_out = (const float*)d_in[19];
    p.ln_g = (const float*)d_in[20]; p.ln_b = (const float*)d_in[21];
    p.out = (float*)d_out; p.ws = (unsigned char*)d_ws;
#if MK_MULTI
    for (int ph = 0; ph < N_PH; ++ph) { p.ph_lo = ph; p.ph_hi = ph + 1;
        hipLaunchKernelGGL(fwd_kernel, dim3(grid_blocks), dim3(512), kDynLds, stream, p); }
#else
    p.ph_lo = 0; p.ph_hi = N_PH;
    hipMemsetAsync((unsigned char*)d_ws + OFF_BAR, 0, 16384, stream);
    void* args[] = {&p};
    hipError_t e = hipLaunchCooperativeKernel((void*)fwd_kernel, dim3(grid_blocks), dim3(512), args, kDynLds, stream);
    if (e != hipSuccess) fprintf(stderr, "cooperative launch failed: %s (grid %d)\n", hipGetErrorString(e), grid_blocks);
#endif
}
```
